# Optimizing an MI355X kernel written in HIP

```python
import jax, jax.numpy as jnp
from jax import lax
import numpy as np

D_MODEL = 2048
BATCH = 16
SEQ = 256
DEPTH = 2
DEC_BATCH = 4
DEC_SEQ = 1024
PAST_LEN = 512

GRID_W = 64
CONV_WIDTH = 31
CONV_CH = D_MODEL // 2
N_HEADS_B = 8
HEAD_DK = 128
HEAD_DV = 128
KEY_DIM = N_HEADS_B * HEAD_DK
VAL_DIM = N_HEADS_B * HEAD_DV
SHORT_CONV = 3
CHUNK = 64
EPS = 1e-6
IN_SPLITS = (CONV_CH, CONV_CH, CONV_CH, KEY_DIM, KEY_DIM, VAL_DIM, VAL_DIM,
             2 * N_HEADS_B, 2 * N_HEADS_B, D_MODEL, D_MODEL)
IN_WIDTH = 3 * CONV_CH + 2 * KEY_DIM + 2 * VAL_DIM + 4 * N_HEADS_B + 2 * D_MODEL

kernel_name = "hybrid_conformer_gdn_diffusion_step"


def _rmsnorm(x, g):
    xf = x.astype(jnp.float32)
    y = xf * lax.rsqrt(jnp.mean(xf * xf, axis=-1, keepdims=True) + EPS)
    return (y * g.astype(jnp.float32)).astype(x.dtype)


def _layernorm(x, g, b):
    xf = x.astype(jnp.float32)
    mu = jnp.mean(xf, axis=-1, keepdims=True)
    var = jnp.mean(jnp.square(xf - mu), axis=-1, keepdims=True)
    y = (xf - mu) * lax.rsqrt(var + EPS)
    return (y * g.astype(jnp.float32) + b.astype(jnp.float32)).astype(x.dtype)


def _l2norm(x):
    return x * lax.rsqrt(jnp.sum(x * x, axis=-1, keepdims=True) + EPS)


def _dwconv(x, w):
    k = w.shape[0]
    return lax.conv_general_dilated(
        x, w[:, None, :].astype(x.dtype), window_strides=(1,),
        padding=[(k // 2, k // 2)], dimension_numbers=('NWC', 'WIO', 'NWC'),
        feature_group_count=x.shape[-1])


def _axial_dwconv(u, w):
    b, n, ch = u.shape
    rows = n // GRID_W
    half = ch // 2
    grid = u.reshape(b, rows, GRID_W, ch)
    horiz = _dwconv(grid[..., :half].reshape(b * rows, GRID_W, half), w[:, :half])
    horiz = horiz.reshape(b, rows, GRID_W, half)
    vert = grid[..., half:].transpose(0, 2, 1, 3).reshape(b * GRID_W, rows, ch - half)
    vert = _dwconv(vert, w[:, half:]).reshape(b, GRID_W, rows, ch - half).transpose(0, 2, 1, 3)
    return jnp.concatenate([horiz, vert], axis=-1).reshape(b, n, ch)


def _chunk_gated_delta(q, k, v, g, beta, s0):
    b, n_tok, h, dk = q.shape
    dv = v.shape[-1]
    nc = n_tok // CHUNK

    def blk(t):
        t = jnp.moveaxis(t, 2, 1)
        return t.reshape(b, h, nc, CHUNK, *t.shape[3:])

    q, k, v, g, beta = blk(q), blk(k), blk(v), blk(g), blk(beta)
    g = jnp.cumsum(g, axis=-1)
    tri = jnp.tril(jnp.ones((CHUNK, CHUNK), dtype=bool))
    strict = jnp.tril(jnp.ones((CHUNK, CHUNK), dtype=bool), -1)
    decay = jnp.exp(jnp.where(tri, g[..., :, None] - g[..., None, :], -jnp.inf))
    kb = k * beta[..., None]
    a = jnp.einsum('bhnid,bhnjd->bhnij', kb, k) * decay
    a = jnp.where(strict, a, 0.0) + jnp.eye(CHUNK, dtype=a.dtype)
    u = lax.linalg.triangular_solve(a, v * beta[..., None], left_side=True, lower=True,
                                    unit_diagonal=True)
    w = lax.linalg.triangular_solve(a, kb * jnp.exp(g)[..., None], left_side=True,
                                    lower=True, unit_diagonal=True)
    qk = jnp.einsum('bhnid,bhnjd->bhnij', q, k) * decay
    q_dec = q * jnp.exp(g)[..., None]
    g_last = g[..., -1]
    k_dec = k * jnp.exp(g_last[..., None] - g)[..., None]

    def step(s, xs):
        u_c, w_c, qk_c, qd_c, kd_c, gl_c = xs
        v_new = u_c - jnp.einsum('bhcd,bhde->bhce', w_c, s)
        o_c = jnp.einsum('bhcd,bhde->bhce', qd_c, s) + jnp.einsum('bhij,bhje->bhie', qk_c, v_new)
        s = s * jnp.exp(gl_c)[..., None, None] + jnp.einsum('bhcd,bhce->bhde', kd_c, v_new)
        return s, o_c

    xs = tuple(jnp.moveaxis(t, 2, 0) for t in (u, w, qk, q_dec, k_dec, g_last))
    s_fin, o = lax.scan(step, s0, xs)
    o = o.transpose(1, 0, 3, 2, 4).reshape(b, n_tok, h, dv)
    return o, s_fin


def _layer(x, cvec, s0, latent, w_mod, b_mod, norm_g, w_in, conv_a_w, conv_a_b, ln_a_g,
           ln_a_b, w_pa, conv_qkv_w, a_log, dt_bias, head_norm_g, w_pb, w_o):
    b, n, _ = x.shape
    mod = (jax.nn.silu(cvec) @ w_mod + b_mod)[:, None, :]
    shift, scale, gate = jnp.split(mod, 3, axis=-1)
    hn = _rmsnorm(x, norm_g) * (1.0 + scale) + shift
    proj = hn @ w_in
    idx = np.cumsum(IN_SPLITS)[:-1].tolist()
    (a_val, a_glu, a_z, q, k, v, z_b, beta_l, alpha_l, gate_a, gate_b) = jnp.split(proj, idx, axis=-1)

    ua = a_val * jax.nn.sigmoid(a_glu)
    ua = _axial_dwconv(ua, conv_a_w) if latent else _dwconv(ua, conv_a_w)
    ua = jax.nn.silu(_layernorm(ua + conv_a_b, ln_a_g, ln_a_b))
    out_a = (ua * jax.nn.silu(a_z)) @ w_pa

    qkv = jax.nn.silu(_dwconv(jnp.concatenate([q, k, v], axis=-1), conv_qkv_w))
    qkv = qkv.astype(jnp.float32)
    qf, kf, vf = jnp.split(qkv, [KEY_DIM, 2 * KEY_DIM], axis=-1)
    qf = _l2norm(qf.reshape(b, n, N_HEADS_B, HEAD_DK)) * (HEAD_DK ** -0.5)
    kf = _l2norm(kf.reshape(b, n, N_HEADS_B, HEAD_DK))
    vf = vf.reshape(b, n, N_HEADS_B, HEAD_DV)
    beta = jax.nn.sigmoid(beta_l.astype(jnp.float32)).reshape(b, n, 2, N_HEADS_B)
    g = -jnp.exp(a_log.astype(jnp.float32)) * jax.nn.softplus(
        alpha_l.astype(jnp.float32).reshape(b, n, 2, N_HEADS_B) + dt_bias.astype(jnp.float32))
    o_f, s_f = _chunk_gated_delta(qf, kf, vf, g[:, :, 0], beta[:, :, 0], s0[:, 0])
    flip = lambda t: jnp.flip(t, axis=1)
    o_b, s_b = _chunk_gated_delta(flip(qf), flip(kf), flip(vf), flip(g[:, :, 1]),
                                  flip(beta[:, :, 1]), s0[:, 1])
    o = (o_f + flip(o_b)).astype(x.dtype)
    o = _rmsnorm(o, head_norm_g).reshape(b, n, VAL_DIM)
    out_b = (o * jax.nn.silu(z_b)) @ w_pb

    merged = jax.nn.sigmoid(gate_a) * out_a + jax.nn.sigmoid(gate_b) * out_b
    x = x + gate * (merged @ w_o)
    return x, jnp.stack([s_f, s_b], axis=1)


def setup_inputs(seed: int = 0) -> dict:
    key = jax.random.key(seed)
    ks = jax.random.split(key, 24)
    f32 = jnp.float32
    nrm = lambda k, shape, s: jax.random.normal(k, shape, f32) * s
    dt = jnp.exp(jax.random.uniform(ks[15], (DEPTH, 2, N_HEADS_B), f32,
                                    np.log(1e-3), np.log(1e-1)))
    return {
        "x_prompt": nrm(ks[0], (BATCH, SEQ, D_MODEL), 1.0),
        "x_sample": nrm(ks[1], (DEC_BATCH, DEC_SEQ, D_MODEL), 1.0),
        "state_delta": nrm(ks[2], (DEC_BATCH, DEPTH, 2, N_HEADS_B, HEAD_DK, HEAD_DV), 0.5),
        "c": nrm(ks[3], (DEC_BATCH, D_MODEL), 1.0),
        "c_ctx": nrm(ks[4], (D_MODEL,), 1.0),
        "w_mod": nrm(ks[5], (DEPTH, D_MODEL, 3 * D_MODEL), 0.5 * D_MODEL ** -0.5),
        "b_mod": nrm(ks[6], (DEPTH, 3 * D_MODEL), 0.01),
        "norm_g": 1.0 + nrm(ks[7], (DEPTH, D_MODEL), 0.01),
        "w_in": nrm(ks[8], (DEPTH, D_MODEL, IN_WIDTH), D_MODEL ** -0.5),
        "conv_a_w": nrm(ks[9], (DEPTH, CONV_WIDTH, CONV_CH), CONV_WIDTH ** -0.5),
        "conv_a_b": nrm(ks[10], (DEPTH, CONV_CH), 0.01),
        "ln_a_g": 1.0 + nrm(ks[11], (DEPTH, CONV_CH), 0.01),
        "ln_a_b": nrm(ks[12], (DEPTH, CONV_CH), 0.01),
        "w_pa": nrm(ks[13], (DEPTH, CONV_CH, D_MODEL), CONV_CH ** -0.5),
        "conv_qkv_w": nrm(ks[14], (DEPTH, SHORT_CONV, 2 * KEY_DIM + VAL_DIM), SHORT_CONV ** -0.5),
        "a_log": jnp.log(jax.random.uniform(ks[16], (DEPTH, 2, N_HEADS_B), f32, 1.0, 16.0)),
        "dt_bias": dt + jnp.log(-jnp.expm1(-dt)),
        "head_norm_g": 1.0 + nrm(ks[17], (DEPTH, HEAD_DV), 0.01),
        "w_pb": nrm(ks[18], (DEPTH, VAL_DIM, D_MODEL), VAL_DIM ** -0.5),
        "w_o": nrm(ks[19], (DEPTH, D_MODEL, D_MODEL), D_MODEL ** -0.5),
        "final_norm_g": 1.0 + nrm(ks[20], (D_MODEL,), 0.01),
    }


def reference(x_prompt, x_sample, state_delta, c, c_ctx, w_mod, b_mod, norm_g, w_in,
              conv_a_w, conv_a_b, ln_a_g, ln_a_b, w_pa, conv_qkv_w, a_log, dt_bias,
              head_norm_g, w_pb, w_o, final_norm_g):
    def layer_params(l):
        return (w_mod[l], b_mod[l], norm_g[l], w_in[l], conv_a_w[l], conv_a_b[l], ln_a_g[l],
                ln_a_b[l], w_pa[l], conv_qkv_w[l], a_log[l], dt_bias[l], head_norm_g[l],
                w_pb[l], w_o[l])

    zero_state = jnp.zeros((x_prompt.shape[0], 2, N_HEADS_B, HEAD_DK, HEAD_DV), jnp.float32)
    cvec_ctx = c_ctx[None, :]
    h = x_prompt
    ctx_states = []
    for l in range(DEPTH):
        h, st = _layer(h, cvec_ctx, zero_state, False, *layer_params(l))
        ctx_states.append(st)
    y_prompt = _rmsnorm(h, final_norm_g)
    state_delta_new = jnp.stack(ctx_states, axis=1).astype(x_prompt.dtype)

    hs = x_sample
    for l in range(DEPTH):
        hs, _ = _layer(hs, c, state_delta[:, l].astype(jnp.float32), True, *layer_params(l))
    y_sample = _rmsnorm(hs, final_norm_g)
    return (y_prompt, y_sample, state_delta_new)
```

```cpp
#include <hip/hip_runtime.h>
#include <hip/hip_cooperative_groups.h>
#include <cstdio>
#include <cstdint>
namespace cg = cooperative_groups;
namespace pg8 {
#define PG8_LAS __attribute__((address_space(3)))
typedef unsigned short bf16_t;
typedef short bf16x8 __attribute__((ext_vector_type(8)));
typedef float f32x4 __attribute__((ext_vector_type(4)));
typedef unsigned u32x4 __attribute__((ext_vector_type(4)));
constexpr int BM = 256, BK = 64, HALF = 128, HTB = HALF * BK * 2  , STAGE_BYTES = 8 * HTB, NXCD = 8, WGM = 8;

__host__ __device__ __forceinline__ int lds_byte(int r, int c) { const int st = (r >> 4) * 2 + (c >> 5), rr = r & 15, cc = c & 31, ob = rr * 64 + cc * 2; return st * 1024 + (ob ^ (((ob >> 9) & 1) << 5)); }
__host__ __device__ __forceinline__ void stage_rc(int b, int& R, int& C) { const int st = b / 1024, sb = b % 1024, swz = sb ^ (((sb >> 9) & 1) << 5); R = (st >> 1) * 16 + swz / 64; C = (st & 1) * 32 + (swz % 64) / 2; }
__host__ __device__ __forceinline__ int perm32(int rho) { const int n = rho >> 4, i = rho & 15; return 8 * (i >> 2) + 4 * n + (i & 3); }

struct Unit { int pm, pn, kh; };
struct Gemm { const bf16_t* A; const bf16_t* Bt; int M, N, K, lda; };

struct StaticOrder {
    int nM, nN, nwg, G, c;
    __host__ __device__ void init(int M, int N, int G_, int c_) { nM = M / BM; nN = N / BM; nwg = nM * nN; G = G_; c = c_; }
    __host__ __device__ bool next(int i, Unit& u) const {
        const long L = (long)i * G + c; if (L >= nwg) return false;
        int wgid = (int)L; { const int q = nwg / NXCD, r = nwg % NXCD, xcd = wgid % NXCD, off = wgid / NXCD; wgid = (xcd < r ? xcd * (q + 1) : r * (q + 1) + (xcd - r) * q) + off; }
        const int nig = WGM * nN, gid = wgid / nig, fm = gid * WGM, gsz = (nM - fm) < WGM ? (nM - fm) : WGM;
        u.pm = fm + ((wgid % nig) % gsz); u.pn = (wgid % nig) / gsz; u.kh = 0; return true;
    }
    __device__ __forceinline__ void a_ready(const Unit&) const {}
    __device__ __forceinline__ void done(const Unit&) const {}
};
__device__ __forceinline__ unsigned cvt_pk_bf16(float lo, float hi) { unsigned r; asm volatile("v_cvt_pk_bf16_f32 %0, %1, %2" : "=v"(r) : "v"(lo), "v"(hi)); return r; }
template <class Epi, class Sched, bool STAMP = false>
__device__ __forceinline__ void gemm_phase(PG8_LAS unsigned char* lds, const Gemm g, const Sched& S, const Epi& E, unsigned long long* stamps) {
    int tid_ = threadIdx.x; asm volatile("" : "+v"(tid_)); const int tid = tid_, wid = __builtin_amdgcn_readfirstlane(tid >> 6), lane = tid & 63, wr = wid >> 2, wc = wid & 3, fr = lane & 15, fq = lane >> 4;
    const int K = g.K, nt = K / BK;
    int ts_lo = 0, ts_hi = 0, nts = 0; const unsigned long long rt_entry = STAMP ? (unsigned long long)wall_clock64() : 0ull;
#define PG8_STAMP() do { if (STAMP && wid == 0 && nts < 64) { const unsigned long long _c = (unsigned long long)clock64(); \
        ts_lo = (lane == nts) ? (int)(unsigned)_c : ts_lo; ts_hi = (lane == nts) ? (int)(unsigned)(_c >> 32) : ts_hi; ++nts; } } while (0)
    PG8_STAMP();
    unsigned voffA[2], voffB[2];
#pragma unroll
    for (int i = 0; i < 2; ++i) { int R, C; stage_rc(tid * 16 + i * 8192, R, C); const int Rb = Epi::PERM ? ((R & ~31) + perm32(R & 31)) : R;
        voffA[i] = (unsigned)(R * g.lda + C) * 2u; voffB[i] = (unsigned)(Rb * g.lda + C) * 2u; }
    const size_t kstep = (size_t)(BK * 2);
    const size_t hstep = (size_t)HALF * g.lda * 2; const size_t khstep = (size_t)K * 2;
    const size_t tstep = 2 * hstep;
    const unsigned ldsw = (unsigned)wid * 1024u;
    const int aoff = lds_byte(wr * 64 + fr, fq * 8), boff = lds_byte(wc * 32 + fr, fq * 8);
#define PG8_SA(b, h) (((b) * 2 + (h)) * HTB)
#define PG8_SB(b, h) ((4 + (b) * 2 + (h)) * HTB)
#define PG8_STAGE(bufoff, gbase, voff) do { _Pragma("unroll") for (int _i = 0; _i < 2; ++_i) \
        __builtin_amdgcn_global_load_lds((const unsigned*)((const char*)(gbase) + (voff)[_i]), (PG8_LAS unsigned*)(lds + (bufoff) + ldsw + _i * 8192), 16, 0, 0); } while (0)
#define PG8_LDA(dst, b, h) do { _Pragma("unroll") for (int m = 0; m < 4; ++m) _Pragma("unroll") for (int k = 0; k < 2; ++k) dst[m][k] = *(const PG8_LAS bf16x8*)(lds + PG8_SA(b, h) + aoff + m * 2048 + k * 1024); } while (0)
#define PG8_LDB(dst, b, h) do { _Pragma("unroll") for (int n = 0; n < 2; ++n) _Pragma("unroll") for (int k = 0; k < 2; ++k) dst[n][k] = *(const PG8_LAS bf16x8*)(lds + PG8_SB(b, h) + boff + n * 2048 + k * 1024); } while (0)
#define PG8_MMA(ai, bj, At, Bt) do { __builtin_amdgcn_s_setprio(1); _Pragma("unroll") for (int m = 0; m < 4; ++m) _Pragma("unroll") for (int n = 0; n < 2; ++n) _Pragma("unroll") for (int k = 0; k < 2; ++k) \
        acc[ai][bj][m][n] = __builtin_amdgcn_mfma_f32_16x16x32_bf16(Bt[n][k], At[m][k], acc[ai][bj][m][n], 0, 0, 0); __builtin_amdgcn_s_setprio(0); } while (0)
#define PG8_WAIT_V(n) asm volatile("s_waitcnt vmcnt(" #n ")" ::: "memory")
#define PG8_WAIT_L(n) asm volatile("s_waitcnt lgkmcnt(" #n ")" ::: "memory")
#define PG8_BAR __builtin_amdgcn_s_barrier()
#define PG8_SCHED __builtin_amdgcn_sched_barrier(0)
    Unit cur, nxt; int ui = 0;
    if (!S.next(0, cur)) return;
    f32x4 acc[2][2][4][2];
#pragma unroll
    for (int a = 0; a < 2; ++a)
#pragma unroll
        for (int b = 0; b < 2; ++b)
#pragma unroll
            for (int m = 0; m < 4; ++m)
#pragma unroll
                for (int n = 0; n < 2; ++n) acc[a][b][m][n] = (f32x4){0.f, 0.f, 0.f, 0.f};
    bf16x8 At[4][2], B0[2][2], B1[2][2];
    const char* cA = (const char*)g.A + (size_t)cur.pm * tstep + cur.kh * khstep; const char* cB = (const char*)g.Bt + (size_t)cur.pn * tstep + cur.kh * khstep;
    S.a_ready(cur);
    PG8_STAGE(PG8_SB(0, 0), cB, voffB); PG8_STAGE(PG8_SA(0, 0), cA, voffA); PG8_STAGE(PG8_SB(0, 1), cB + hstep, voffB); PG8_STAGE(PG8_SA(0, 1), cA + hstep, voffA);
    if (wr == 1) PG8_BAR;
    PG8_WAIT_V(4); PG8_BAR;
    PG8_STAGE(PG8_SB(1, 0), cB + kstep, voffB); PG8_STAGE(PG8_SA(1, 0), cA + kstep, voffA); PG8_STAGE(PG8_SB(1, 1), cB + hstep + kstep, voffB);
    PG8_WAIT_V(6); PG8_BAR;
    PG8_STAMP();
    for (;;) {
        const bool has_next = S.next(ui + 1, nxt);
        const char* nA = has_next ? (const char*)g.A + (size_t)nxt.pm * tstep + nxt.kh * khstep : cA; const char* nB = has_next ? (const char*)g.Bt + (size_t)nxt.pn * tstep + nxt.kh * khstep : cB;
        for (int t = 0; t < nt; t += 2) {
            const bool last = (t == nt - 2);
            const char* a1 = cA + (size_t)(t + 1) * kstep;
            const char* a2 = last ? nA : cA + (size_t)(t + 2) * kstep; const char* b2 = last ? nB : cB + (size_t)(t + 2) * kstep;
            const char* a3 = a2 + kstep; const char* b3 = b2 + kstep;
            if (last && has_next) S.a_ready(nxt);
            PG8_LDB(B0, 0, 0); PG8_SCHED; PG8_LDA(At, 0, 0); PG8_STAGE(PG8_SA(1, 1), a1 + hstep, voffA);
            PG8_WAIT_L(8); PG8_BAR; PG8_WAIT_L(0); PG8_MMA(0, 0, At, B0); PG8_BAR; PG8_SCHED;
            PG8_LDB(B1, 0, 1); PG8_STAGE(PG8_SB(0, 0), b2, voffB);
            PG8_BAR; PG8_WAIT_L(0); PG8_MMA(0, 1, At, B1); PG8_BAR;
            PG8_LDA(At, 0, 1); PG8_STAGE(PG8_SA(0, 0), a2, voffA);
            PG8_BAR; PG8_WAIT_L(0); PG8_MMA(1, 0, At, B0); PG8_BAR; PG8_SCHED;
            PG8_STAGE(PG8_SB(0, 1), b2 + hstep, voffB);
            PG8_WAIT_V(6); PG8_BAR; PG8_MMA(1, 1, At, B1); PG8_BAR;
            PG8_LDB(B0, 1, 0); PG8_SCHED; PG8_LDA(At, 1, 0); PG8_STAGE(PG8_SA(0, 1), a2 + hstep, voffA);
            PG8_WAIT_L(8); PG8_BAR; PG8_WAIT_L(0); PG8_MMA(0, 0, At, B0); PG8_BAR; PG8_SCHED;
            PG8_LDB(B1, 1, 1); PG8_STAGE(PG8_SB(1, 0), b3, voffB);
            PG8_BAR; PG8_WAIT_L(0); PG8_MMA(0, 1, At, B1); PG8_BAR;
            PG8_LDA(At, 1, 1); PG8_STAGE(PG8_SA(1, 0), a3, voffA);
            PG8_BAR; PG8_WAIT_L(0); PG8_MMA(1, 0, At, B0); PG8_BAR; PG8_SCHED;
            PG8_STAGE(PG8_SB(1, 1), b3 + hstep, voffB);
            PG8_WAIT_V(6); PG8_BAR; PG8_MMA(1, 1, At, B1); PG8_BAR;
        }
        PG8_STAMP();
        if constexpr (!Epi::AFTER_DRAIN) { E(acc, cur, wr, wc, fr, fq); S.done(cur); }
        PG8_STAMP();
        if (!has_next) break;
        if (!(Epi::CHAIN && cur.kh == 0))
#pragma unroll
        for (int a = 0; a < 2; ++a)
#pragma unroll
            for (int b = 0; b < 2; ++b)
#pragma unroll
                for (int m = 0; m < 4; ++m)
#pragma unroll
                    for (int n = 0; n < 2; ++n) acc[a][b][m][n] = (f32x4){0.f, 0.f, 0.f, 0.f};
        cur = nxt; cA = nA; cB = nB; ++ui;
    }
    PG8_WAIT_V(0);
    if (wr == 0) PG8_BAR;
    PG8_BAR;
    if constexpr (Epi::AFTER_DRAIN) { E.fused(acc, cur, wr, wc, fr, fq, lds, wid, lane); S.done(cur); }
    PG8_STAMP();
    if (STAMP && wid == 0) { stamps[lane] = lane < nts ? (((unsigned long long)(unsigned)ts_hi << 32) | (unsigned)ts_lo) : 0ull;
        if (lane == 62) stamps[62] = rt_entry; if (lane == 63) stamps[63] = (unsigned long long)wall_clock64(); }
#undef PG8_STAMP
#undef PG8_SA
#undef PG8_SB
#undef PG8_STAGE
#undef PG8_LDA
#undef PG8_LDB
#undef PG8_MMA
#undef PG8_WAIT_V
#undef PG8_WAIT_L
#undef PG8_BAR
#undef PG8_SCHED
}
}

#define LAS __attribute__((address_space(3)))
typedef unsigned short bf16_t;
typedef short bf16x8 __attribute__((ext_vector_type(8)));
typedef float f32x4 __attribute__((ext_vector_type(4)));
typedef unsigned u32x4 __attribute__((ext_vector_type(4)));
typedef unsigned u32x2 __attribute__((ext_vector_type(2)));

constexpr int NTOK = 8192, DM = 2048, NCTX = 4096, NP = 11520, NTHR = 512;
constexpr int C_AVAL = 0, C_AGLU = 1024, C_AZ = 2048, C_Q = 3072, C_ZB = 6144, C_GA = 7168, C_GB = 9216, C_BA = 11264;
constexpr float EPS = 1e-6f;
constexpr int LDS_BYTES = 139264;

constexpr size_t WS_WIN = 256;
constexpr size_t SZ_WIN1 = (size_t)NP * DM * 2;
constexpr size_t WS_WP2 = WS_WIN + 2 * SZ_WIN1;
constexpr size_t SZ_SQ = (size_t)DM * DM * 2;
constexpr size_t WS_WO = WS_WP2 + 2 * SZ_SQ;
constexpr size_t WS_MOD = WS_WO + 2 * SZ_SQ;
constexpr size_t WS_R1 = WS_MOD + 2 * 5 * 6144 * 4;
constexpr size_t WS_P = WS_R1 + (size_t)2 * NTOK * 1024 * 4;
constexpr size_t WS_BA = WS_P + (size_t)NTOK * NP * 2;
constexpr size_t WS_Y = WS_BA + (size_t)NTOK * 32 * 4;
constexpr size_t WS_U = WS_Y + (size_t)NTOK * 1024 * 4;
constexpr size_t WS_DN = WS_U + (size_t)NTOK * 2048 * 2;
constexpr int DN_NEGW = 0, DN_QDEC = 16384, DN_KDT = 32768, DN_QKM = 49152, DN_UT = 57344, DN_EGL = 90112, DN_REC = 90368;
constexpr size_t WS_X1 = WS_DN + (size_t)2048 * DN_REC;
constexpr size_t WS_END = WS_X1 + (size_t)NTOK * DM * 4;
static_assert(WS_END <= 740294656ull, "workspace");

__device__ __forceinline__ int opaque_tid() { int t = threadIdx.x; asm volatile("" : "+v"(t)); return t; }
struct Params { const float* in[21]; float* out; unsigned char* ws; int ph_lo, ph_hi; };
#define KA_ __attribute__((address_space(4)))
__device__ __forceinline__ const float* pin(const Params&, int k) { const KA_ char* ka = (const KA_ char*)__builtin_amdgcn_kernarg_segment_ptr(); return *(const float* const volatile KA_*)(ka + 8 * k); }
__device__ __forceinline__ unsigned char* pws(const Params&) { const KA_ char* ka = (const KA_ char*)__builtin_amdgcn_kernarg_segment_ptr(); return *(unsigned char* const volatile KA_*)(ka + 8 * 22); }
__device__ __forceinline__ float* pout(const Params&) { const KA_ char* ka = (const KA_ char*)__builtin_amdgcn_kernarg_segment_ptr(); return *(float* const volatile KA_*)(ka + 8 * 21); }

__device__ __forceinline__ float bf2f(unsigned short b) { return __uint_as_float(((unsigned)b) << 16); }
__device__ __forceinline__ unsigned f2bf(float f) { unsigned u = __float_as_uint(f); u += 0x7fffu + ((u >> 16) & 1u); return u >> 16; }
__device__ __forceinline__ unsigned pk2(float lo, float hi) { return f2bf(lo) | (f2bf(hi) << 16); }
__device__ __forceinline__ float sigmoidf_(float x) { return 1.0f / (1.0f + __expf(-x)); }
__device__ __forceinline__ float siluf_(float x) { return x / (1.0f + __expf(-x)); }
__device__ __forceinline__ float wave_sum(float v) {
#pragma unroll
    for (int o = 32; o > 0; o >>= 1) v += __shfl_xor(v, o);
    return v;
}
__device__ __forceinline__ const float* xrow0(const Params& p, int tok) { return tok < NCTX ? pin(p, 0) + (size_t)tok * DM : pin(p, 1) + (size_t)(tok - NCTX) * DM; }
__device__ __forceinline__ int cvec_of(int tok) { return tok < NCTX ? 0 : 1 + ((tok - NCTX) >> 10); }

__device__ __forceinline__ void tr_tile(const float* __restrict__ src, int ldsrc, int k0, int n0, int mode, bf16_t* __restrict__ dst, int lddst, int koff, float* lds) {
    const int tid = opaque_tid();
    {
        const int c = tid & 63; const int np = n0 + c; int sc = np;
        if (mode == 1) { sc = np < 7168 ? np : (np < 11264 ? np + 32 : (np < 11296 ? np - 11264 + 7168 : -1)); }
#pragma unroll
        for (int i = 0; i < 8; ++i) { const int r = (tid >> 6) + 8 * i; lds[r * 65 + c] = sc >= 0 ? src[(size_t)(k0 + r) * ldsrc + sc] : 0.f; }
    }
    __syncthreads();
#pragma unroll
    for (int i = 0; i < 4; ++i) { const int n = (tid >> 5) + 16 * i, k2 = (tid & 31) * 2;
        *(unsigned*)(dst + (size_t)(n0 + n) * lddst + koff + k0 + k2) = pk2(lds[k2 * 65 + n], lds[(k2 + 1) * 65 + n]); }
    __syncthreads();
}

__device__ __forceinline__ void p0_prologue(const Params& p, float* lds) {
    const int tid = opaque_tid(), G = gridDim.x, b = blockIdx.x;
    unsigned char* ws = pws(p);
    for (int it = b; it < 2 * 7808; it += G) {
        const int l = it / 7808; int r = it % 7808;
        const float* src; int ldsrc, kt, ntile, mode = 0, koff = 0; bf16_t* dst;
        if (r < 5760) { kt = r / 180; ntile = r % 180; src = pin(p, 8) + (size_t)l * 2048 * 11296; ldsrc = 11296; mode = 1; dst = (bf16_t*)(ws + WS_WIN + l * SZ_WIN1); }
        else if (r < 5760 + 1024) { r -= 5760; const int which = r / 512; r %= 512; kt = r / 32; ntile = r % 32;
            src = pin(p, which ? 18 : 13) + (size_t)l * 1024 * 2048; ldsrc = 2048; dst = (bf16_t*)(ws + WS_WP2 + l * SZ_SQ); koff = which * 1024; }
        else { r -= 6784; kt = r / 32; ntile = r % 32; src = pin(p, 19) + (size_t)l * 2048 * 2048; ldsrc = 2048; dst = (bf16_t*)(ws + WS_WO + l * SZ_SQ); }
        tr_tile(src, ldsrc, kt * 64, ntile * 64, mode, dst, 2048, koff, lds);
    }
    float* sc = lds;
    float* red = lds + 5 * 2048;
    __syncthreads();
    for (int i = tid; i < 5 * 2048; i += NTHR) { const int v = i >> 11, k = i & 2047; const float x = v == 0 ? pin(p, 4)[k] : pin(p, 3)[(v - 1) * 2048 + k]; sc[i] = siluf_(x); }
    __syncthreads();
    for (int it = b; it < 192; it += G) {
        const int l = it / 96, col0 = (it % 96) * 64;
        const int kq = tid >> 4, c4 = tid & 15;
        f32x4 acc[5];
#pragma unroll
        for (int v = 0; v < 5; ++v) acc[v] = (f32x4){0.f, 0.f, 0.f, 0.f};
        const float* wp = pin(p, 5) + (size_t)l * 2048 * 6144 + col0 + c4 * 4;
        for (int i = 0; i < 64; ++i) { const int k = kq + 32 * i; const f32x4 w = *(const f32x4*)(wp + (size_t)k * 6144);
#pragma unroll
            for (int v = 0; v < 5; ++v) acc[v] += w * sc[v * 2048 + k]; }
#pragma unroll
        for (int v = 0; v < 5; ++v) *(f32x4*)(red + (kq * 5 + v) * 64 + c4 * 4) = acc[v];
        __syncthreads();
        if (tid < 320) { const int v = tid >> 6, c = tid & 63; float s = 0.f;
            for (int q = 0; q < 32; ++q) s += red[(q * 5 + v) * 64 + c];
            ((float*)(ws + WS_MOD))[(size_t)(l * 5 + v) * 6144 + col0 + c] = s + pin(p, 6)[l * 6144 + col0 + c]; }
        __syncthreads();
    }
}

__device__ __forceinline__ void pn_norm(const Params& p, int l) {
    const int tid = opaque_tid(), lane = tid & 63, wid = tid >> 6;
    bf16_t* XN = (bf16_t*)(pws(p) + WS_R1);
    const float* MOD = (const float*)(pws(p) + WS_MOD);
    const float* ng = pin(p, 7) + l * DM;
    for (int tok = blockIdx.x * 8 + wid; tok < NTOK; tok += gridDim.x * 8) {
        const float* xr = l == 0 ? xrow0(p, tok) : (const float*)(pws(p) + WS_X1) + (size_t)tok * DM;
        f32x4 v[8]; float ss = 0.f;
#pragma unroll
        for (int i = 0; i < 8; ++i) { v[i] = *(const f32x4*)(xr + (lane + 64 * i) * 4); ss += v[i][0] * v[i][0] + v[i][1] * v[i][1] + v[i][2] * v[i][2] + v[i][3] * v[i][3]; }
        ss = wave_sum(ss);
        const float rstd = rsqrtf(ss * (1.0f / DM) + EPS);
        const float* md = MOD + (size_t)(l * 5 + cvec_of(tok)) * 6144;
#pragma unroll
        for (int i = 0; i < 8; ++i) { const int c = (lane + 64 * i) * 4;
            const f32x4 g = *(const f32x4*)(ng + c), sh = *(const f32x4*)(md + c), scl = *(const f32x4*)(md + 2048 + c);
            const f32x4 h = (v[i] * rstd * g) * (scl + 1.0f) + sh;
            u32x2 o; o[0] = pk2(h[0], h[1]); o[1] = pk2(h[2], h[3]);
            *(u32x2*)(XN + (size_t)tok * DM + c) = o; }
    }
}
__device__ __forceinline__ void pf_final(const Params& p) {
    const int tid = opaque_tid(), lane = tid & 63, wid = tid >> 6;
    const float* X2 = (const float*)(pws(p) + WS_P);
    const float* fg = pin(p, 20);
    for (int tok = blockIdx.x * 8 + wid; tok < NTOK; tok += gridDim.x * 8) {
        const float* xr = X2 + (size_t)tok * DM;
        f32x4 v[8]; float ss = 0.f;
#pragma unroll
        for (int i = 0; i < 8; ++i) { v[i] = *(const f32x4*)(xr + (lane + 64 * i) * 4); ss += v[i][0] * v[i][0] + v[i][1] * v[i][1] + v[i][2] * v[i][2] + v[i][3] * v[i][3]; }
        ss = wave_sum(ss);
        const float rstd = rsqrtf(ss * (1.0f / DM) + EPS);
#pragma unroll
        for (int i = 0; i < 8; ++i) { const int c = (lane + 64 * i) * 4; const f32x4 g = *(const f32x4*)(fg + c);
            *(f32x4*)(pout(p) + (size_t)tok * DM + c) = v[i] * rstd * g; }
    }
}

struct ChainOrder : pg8::StaticOrder {
    __device__ bool next(int i, pg8::Unit& u) const { const bool ok = pg8::StaticOrder::next(i >> 1, u); u.kh = i & 1; return ok; }
};
struct EpiP {
    static constexpr bool PERM = true, AFTER_DRAIN = false, CHAIN = false;
    bf16_t* P; float* BA;
    __device__ __forceinline__ void operator()(f32x4 (&acc)[2][2][4][2], const pg8::Unit& u, int wr, int wc, int fr, int fq) const {
        const int row0 = u.pm * 256 + wr * 64 + fr, col0 = u.pn * 256 + wc * 32 + 8 * fq;
#pragma unroll
        for (int ai = 0; ai < 2; ++ai)
#pragma unroll
            for (int m = 0; m < 4; ++m) { const int row = row0 + ai * 128 + m * 16; bf16_t* rowp = P + (size_t)row * NP + col0;
#pragma unroll
                for (int bj = 0; bj < 2; ++bj) { const f32x4 v0 = acc[ai][bj][m][0], v1 = acc[ai][bj][m][1];
                    u32x4 o; o[0] = pg8::cvt_pk_bf16(v0[0], v0[1]); o[1] = pg8::cvt_pk_bf16(v0[2], v0[3]); o[2] = pg8::cvt_pk_bf16(v1[0], v1[1]); o[3] = pg8::cvt_pk_bf16(v1[2], v1[3]);
                    *(u32x4*)(rowp + bj * 128) = o; }
                if (u.pn == 44 && wc == 0) { *(f32x4*)(BA + (size_t)row * 32 + 8 * fq) = acc[ai][0][m][0]; *(f32x4*)(BA + (size_t)row * 32 + 8 * fq + 4) = acc[ai][0][m][1]; }
            }
    }
};
struct EpiMG {
    static constexpr bool PERM = true, AFTER_DRAIN = false, CHAIN = true;
    const bf16_t* P; bf16_t* MG;
    __device__ __forceinline__ void mid(f32x4 (&acc)[2][2][4][2], const pg8::Unit& u, int wr, int wc, int fr, int fq) const {
        const int row0 = u.pm * 256 + wr * 64 + fr, col0 = u.pn * 256 + wc * 32 + 8 * fq;
#pragma unroll
        for (int ai = 0; ai < 2; ++ai)
#pragma unroll
            for (int m = 0; m < 4; ++m) { const int row = row0 + ai * 128 + m * 16; const bf16_t* rowp = P + (size_t)row * NP + col0;
#pragma unroll
                for (int bj = 0; bj < 2; ++bj) { const u32x4 ga = *(const u32x4*)(rowp + C_GA + bj * 128), gb = *(const u32x4*)(rowp + C_GB + bj * 128);
#pragma unroll
                    for (int e = 0; e < 8; ++e) { const float a = __uint_as_float((e & 1) ? (ga[e >> 1] & 0xffff0000u) : (ga[e >> 1] << 16)), bq = __uint_as_float((e & 1) ? (gb[e >> 1] & 0xffff0000u) : (gb[e >> 1] << 16));
                        const float ratio = (1.0f + __expf(-bq)) / (1.0f + __expf(-a));
                        acc[ai][bj][m][e >> 2][e & 3] *= ratio; }
                    __builtin_amdgcn_sched_barrier(0); }
            }
    }
    __device__ __forceinline__ void operator()(f32x4 (&acc)[2][2][4][2], const pg8::Unit& u, int wr, int wc, int fr, int fq) const {
        if (u.kh == 0) { mid(acc, u, wr, wc, fr, fq); return; }
        const int row0 = u.pm * 256 + wr * 64 + fr, col0 = u.pn * 256 + wc * 32 + 8 * fq;
#pragma unroll
        for (int ai = 0; ai < 2; ++ai)
#pragma unroll
            for (int m = 0; m < 4; ++m) { const int row = row0 + ai * 128 + m * 16; const bf16_t* rowp = P + (size_t)row * NP + col0;
#pragma unroll
                for (int bj = 0; bj < 2; ++bj) { const u32x4 gb = *(const u32x4*)(rowp + C_GB + bj * 128);
                    float o[8];
#pragma unroll
                    for (int e = 0; e < 8; ++e) { const float bq = __uint_as_float((e & 1) ? (gb[e >> 1] & 0xffff0000u) : (gb[e >> 1] << 16));
                        o[e] = acc[ai][bj][m][e >> 2][e & 3] * sigmoidf_(bq); }
                    u32x4 ov; ov[0] = pg8::cvt_pk_bf16(o[0], o[1]); ov[1] = pg8::cvt_pk_bf16(o[2], o[3]); ov[2] = pg8::cvt_pk_bf16(o[4], o[5]); ov[3] = pg8::cvt_pk_bf16(o[6], o[7]);
                    *(u32x4*)(MG + (size_t)row * DM + col0 + bj * 128) = ov; }
            }
    }
};
struct EpiX {
    static constexpr bool PERM = false, AFTER_DRAIN = false, CHAIN = false;
    const float* x0a; const float* x0b; const float* x1; const float* gate; float* out;
    __device__ __forceinline__ void operator()(f32x4 (&acc)[2][2][4][2], const pg8::Unit& u, int wr, int wc, int fr, int fq) const {
        const int row0 = u.pm * 256 + wr * 64 + fr, col0 = u.pn * 256 + wc * 32 + 4 * fq;
#pragma unroll
        for (int ai = 0; ai < 2; ++ai)
#pragma unroll
            for (int m = 0; m < 4; ++m) { const int row = row0 + ai * 128 + m * 16;
                const float* xr = x1 ? x1 + (size_t)row * DM : (row < NCTX ? x0a + (size_t)row * DM : x0b + (size_t)(row - NCTX) * DM);
                const float* gr = gate + (size_t)cvec_of(row) * 6144;
#pragma unroll
                for (int bj = 0; bj < 2; ++bj)
#pragma unroll
                    for (int n = 0; n < 2; ++n) { const int col = col0 + bj * 128 + n * 16;
                        const f32x4 xv = *(const f32x4*)(xr + col), gv = *(const f32x4*)(gr + col);
                        *(f32x4*)(out + (size_t)row * DM + col) = xv + gv * acc[ai][bj][m][n]; }
            }
    }
};

template <int T>
__device__ __forceinline__ void conv_line(const bf16_t* __restrict__ P, float* __restrict__ Y, int base, int stride, int L, int p0, int ch, const float* __restrict__ w, float bias) {
    float ua[T + 30];
#pragma unroll
    for (int i = 0; i < T + 30; ++i) { const int pos = p0 - 15 + i; float v = 0.f;
        if (pos >= 0 && pos < L) { const bf16_t* pr = P + (size_t)(base + pos * stride) * NP; v = bf2f(pr[C_AVAL + ch]) * sigmoidf_(bf2f(pr[C_AGLU + ch])); }
        ua[i] = v; }
    float wk[31];
#pragma unroll
    for (int k = 0; k < 31; ++k) wk[k] = w[k * 1024 + ch];
#pragma unroll
    for (int j = 0; j < T; ++j) { float a = bias;
#pragma unroll
        for (int k = 0; k < 31; ++k) a += wk[k] * ua[j + k];
        Y[(size_t)(base + (p0 + j) * stride) * 1024 + ch] = a; }
}

__device__ __forceinline__ void dn_precompute(const Params& p, int l, int gc, int h, float* lds) {
    const int tid = opaque_tid(), lane = tid & 63, wid = tid >> 6;
    float* qs = lds;
    float* ks = lds + 8448;
    float* vs = lds + 2 * 8448;
    float* Gm = lds + 3 * 8448;
    float* QKm = Gm + 4160;
    float* betaS = QKm + 4160;
    float* gcS = betaS + 128;
    const bf16_t* P = (const bf16_t*)(pws(p) + WS_P);
    const float* BA = (const float*)(pws(p) + WS_BA);
    int n, nc; if (gc < 64) { n = gc & 3; nc = 4; } else { n = (gc - 64) & 15; nc = 16; }
    const int tok0 = gc * 64;
    const float* cw = pin(p, 14) + (size_t)l * 3 * 3072;
    for (int idx = tid; idx < 64 * 384; idx += NTHR) { const int t = idx / 384, cc = idx % 384, which = cc >> 7, d = cc & 127;
        const int wch = which * 1024 + h * 128 + d; const bf16_t* pc = P + (size_t)(tok0 + t) * NP + C_Q + wch;
        const float x0 = bf2f(pc[0]);
        const float xm = (t > 0 || n > 0) ? bf2f(*(pc - NP)) : 0.f;
        const float xp = (t < 63 || n < nc - 1) ? bf2f(*(pc + NP)) : 0.f;
        const float val = siluf_(cw[wch] * xm + cw[3072 + wch] * x0 + cw[2 * 3072 + wch] * xp);
        (which == 0 ? qs : (which == 1 ? ks : vs))[t * 132 + d] = val; }
    if (tid < 128) { const int dir = tid >> 6, i = tid & 63, tl = dir ? 63 - i : i;
        const float* ba = BA + (size_t)(tok0 + tl) * 32;
        const float bl = ba[dir * 8 + h], al = ba[16 + dir * 8 + h];
        const float xx = al + pin(p, 16)[(l * 2 + dir) * 8 + h];
        const float sp = xx > 20.f ? xx : log1pf(__expf(xx));
        float g = -__expf(pin(p, 15)[(l * 2 + dir) * 8 + h]) * sp;
#pragma unroll
        for (int o = 1; o < 64; o <<= 1) { const float t2 = __shfl_up(g, o); if (i >= o) g += t2; }
        betaS[dir * 64 + i] = sigmoidf_(bl); gcS[dir * 64 + i] = g; }
    __syncthreads();
    for (int r = wid; r < 128; r += 8) { float* row = (r < 64 ? qs + r * 132 : ks + (r - 64) * 132);
        const float a = row[lane], b2 = row[lane + 64]; const float ss = wave_sum(a * a + b2 * b2);
        const float sc = rsqrtf(ss + EPS) * (r < 64 ? 0.08838834764831845f : 1.0f);
        row[lane] = a * sc; row[lane + 64] = b2 * sc; }
    __syncthreads();
    { const int mat = tid >> 8, blk = tid & 255, bi = blk >> 4, bj = blk & 15;
        const float* Ar = mat ? qs : ks;
        float a[4][4];
#pragma unroll
        for (int x = 0; x < 4; ++x)
#pragma unroll
            for (int y = 0; y < 4; ++y) a[x][y] = 0.f;
        for (int d = 0; d < 128; d += 4) { f32x4 ra[4], rb[4];
#pragma unroll
            for (int x = 0; x < 4; ++x) { ra[x] = *(const f32x4*)(Ar + (bi + 16 * x) * 132 + d); rb[x] = *(const f32x4*)(ks + (bj + 16 * x) * 132 + d); }
#pragma unroll
            for (int x = 0; x < 4; ++x)
#pragma unroll
                for (int y = 0; y < 4; ++y) a[x][y] += ra[x][0] * rb[y][0] + ra[x][1] * rb[y][1] + ra[x][2] * rb[y][2] + ra[x][3] * rb[y][3]; }
        float* M = mat ? QKm : Gm;
#pragma unroll
        for (int x = 0; x < 4; ++x)
#pragma unroll
            for (int y = 0; y < 4; ++y) M[(bi + 16 * x) * 65 + bj + 16 * y] = a[x][y]; }
    __syncthreads();
    const int dir = tid >> 8, tl = tid & 255;
    unsigned char* rec = pws(p) + WS_DN + (size_t)((gc * 8 + h) * 2 + dir) * DN_REC;
    const float* gcd = gcS + dir * 64; const float* btd = betaS + dir * 64;
    const float gl = gcd[63];
    { bf16_t* qd = (bf16_t*)(rec + DN_QDEC);
        for (int e = tl; e < 64 * 64; e += 256) { const int i = e >> 6, d2 = (e & 63) * 2; const int t = dir ? 63 - i : i; const float eg = __expf(gcd[i]);
            *(unsigned*)(qd + i * 128 + d2) = pk2(qs[t * 132 + d2] * eg, qs[t * 132 + d2 + 1] * eg); }
        bf16_t* kd = (bf16_t*)(rec + DN_KDT);
        for (int e = tl; e < 128 * 32; e += 256) { const int dk = e >> 5, j2 = (e & 31) * 2; const int t0 = dir ? 63 - j2 : j2, t1 = dir ? 62 - j2 : j2 + 1;
            *(unsigned*)(kd + dk * 64 + j2) = pk2(ks[t0 * 132 + dk] * __expf(gl - gcd[j2]), ks[t1 * 132 + dk] * __expf(gl - gcd[j2 + 1])); }
        bf16_t* qk = (bf16_t*)(rec + DN_QKM);
        for (int e = tl; e < 64 * 32; e += 256) { const int i = e >> 5, j2 = (e & 31) * 2; const int ti = dir ? 63 - i : i, t0 = dir ? 63 - j2 : j2, t1 = dir ? 62 - j2 : j2 + 1;
            const float v0 = j2 <= i ? QKm[ti * 65 + t0] * __expf(gcd[i] - gcd[j2]) : 0.f;
            const float v1 = j2 + 1 <= i ? QKm[ti * 65 + t1] * __expf(gcd[i] - gcd[j2 + 1]) : 0.f;
            *(unsigned*)(qk + i * 64 + j2) = pk2(v0, v1); }
        if (tl == 0) *(float*)(rec + DN_EGL) = __expf(gl);
    }
    __syncthreads();
    float* Am = qs + dir * 4096;
    for (int e = tl; e < 4096; e += 256) { const int j = e >> 6, i = e & 63; const int ti = dir ? 63 - i : i, tj = dir ? 63 - j : j;
        Am[e] = j < i ? btd[i] * Gm[ti * 65 + tj] * __expf(gcd[i] - gcd[j]) : 0.f; }
    __syncthreads();
    { const int c = tl; const bool isu = c < 128;
        int rstep = dir ? -132 : 132; asm volatile("" : "+v"(rstep));
        const float* src = (isu ? vs + c : ks + (c - 128)) + (dir ? 63 * 132 : 0);
        float U[64];
#pragma unroll
        for (int i = 0; i < 64; ++i) { float r = src[i * rstep] * btd[i]; if (!isu) r *= __expf(gcd[i]); U[i] = r; }
        __builtin_amdgcn_sched_barrier(0);
#pragma unroll
        for (int j = 0; j < 63; ++j) {
#pragma unroll
            for (int i4 = (j + 1) / 4; i4 < 16; ++i4) { const f32x4 av = *(const f32x4*)(Am + j * 64 + i4 * 4);
#pragma unroll
                for (int ii = 0; ii < 4; ++ii) if (i4 * 4 + ii > j) U[i4 * 4 + ii] -= av[ii] * U[j]; }
            __builtin_amdgcn_sched_barrier(0); }
        if (isu) { float* ut = (float*)(rec + DN_UT) + c * 64;
#pragma unroll
            for (int i = 0; i < 64; i += 4) *(f32x4*)(ut + i) = (f32x4){U[i], U[i + 1], U[i + 2], U[i + 3]};
        } else { bf16_t* nw = (bf16_t*)(rec + DN_NEGW) + (c - 128);
#pragma unroll
            for (int i = 0; i < 64; ++i) nw[i * 128] = (bf16_t)f2bf(-U[i]); }
    }
    __syncthreads();
}

__device__ __forceinline__ void pc_phase(const Params& p, int l, float* lds) {
    const int tid = opaque_tid();
    const bf16_t* P = (const bf16_t*)(pws(p) + WS_P);
    float* Y = (float*)(pws(p) + WS_Y);
    const float* cw = pin(p, 9) + (size_t)l * 31 * 1024;
    const float* cb = pin(p, 10) + l * 1024;
    for (int it = blockIdx.x; it < 1024 + 640; it += gridDim.x) {
#ifndef NO_DN
        if (it < 1024) { dn_precompute(p, l, it >> 3, it & 7, lds); continue; }
#endif
#ifndef NO_CONV
        int r = it - 1024;
        int tl = opaque_tid();
        if (r < 384) { int base, L, p0, ch;
            if (r < 256) { const int hh = r & 1, tile = (r >> 1) & 7, bb = r >> 4; ch = hh * 512 + tl; base = bb * 256; L = 256; p0 = tile * 32; }
            else { r -= 256; const int tile = r & 1, row = (r >> 1) & 15, bb = r >> 5; ch = tl; base = NCTX + bb * 1024 + row * 64; L = 64; p0 = tile * 32; }
            int st = 1; asm volatile("" : "+s"(st));
            conv_line<32>(P, Y, base, st, L, p0, ch, cw, cb[ch]);
        } else {
            r -= 384; const int col = r & 63, bb = r >> 6; const int ch = 512 + tl;
            int st = 64; asm volatile("" : "+s"(st));
            conv_line<16>(P, Y, NCTX + bb * 1024 + col, st, 16, 0, ch, cw, cb[ch]);
        }
#endif
    }
}

__device__ __forceinline__ bf16x8 pack8(const f32x4& a, const f32x4& b) {
    u32x4 r; r[0] = pk2(a[0], a[1]); r[1] = pk2(a[2], a[3]); r[2] = pk2(b[0], b[1]); r[3] = pk2(b[2], b[3]);
    return __builtin_bit_cast(bf16x8, r);
}
__device__ __forceinline__ bf16x8 lds_afrag(const unsigned char* base) {
    const u32x2 lo = *(const u32x2*)base, hi = *(const u32x2*)(base + 32);
    u32x4 r; r[0] = lo[0]; r[1] = lo[1]; r[2] = hi[0]; r[3] = hi[1];
    return __builtin_bit_cast(bf16x8, r);
}
#define MFMA16(a, b, c) __builtin_amdgcn_mfma_f32_16x16x32_bf16((a), (b), (c), 0, 0, 0)

__device__ __forceinline__ void scan_item(const Params& p, int l, int sq, int h, int dir, unsigned char* lds) {
    const int tid = opaque_tid(), lane = tid & 63, wid = tid >> 6, c = lane & 15, q = lane >> 4;
    const int dv0 = wid * 16;
    const bool ctx = sq < 16;
    const int nc = ctx ? 4 : 16, gc0 = ctx ? sq * 4 : 64 + (sq - 16) * 16;
    unsigned char* L_negw = lds;
    unsigned char* L_qdec = lds + 18432;
    unsigned char* L_kdt = lds + 36864;
    unsigned char* L_qkm = lds + 57344;
    float* O = (float*)(pws(p) + WS_R1) + (size_t)dir * NTOK * 1024;
    f32x4 S[8];
    if (ctx) {
#pragma unroll
        for (int m = 0; m < 8; ++m) S[m] = (f32x4){0.f, 0.f, 0.f, 0.f};
    } else { const float* sd = pin(p, 2) + ((size_t)(((sq - 16) * 2 + l) * 2 + dir) * 8 + h) * 16384;
#pragma unroll
        for (int m = 0; m < 8; ++m)
#pragma unroll
            for (int j = 0; j < 4; ++j) S[m][j] = sd[(16 * m + 4 * q + j) * 128 + dv0 + c]; }
    for (int s = 0; s < nc; ++s) {
        const int gc = gc0 + (dir ? nc - 1 - s : s);
        const unsigned char* rec = pws(p) + WS_DN + (size_t)((gc * 8 + h) * 2 + dir) * DN_REC;
        __syncthreads();
        for (int ch = tid; ch < 3584; ch += NTHR) { const u32x4 v = *(const u32x4*)(rec + (size_t)ch * 16);
            unsigned char* dst;
            if (ch < 1024) dst = L_negw + (ch >> 4) * 288 + (ch & 15) * 16;
            else if (ch < 2048) { const int x = ch - 1024; dst = L_qdec + (x >> 4) * 288 + (x & 15) * 16; }
            else if (ch < 3072) { const int x = ch - 2048; dst = L_kdt + (x >> 3) * 160 + (x & 7) * 16; }
            else { const int x = ch - 3072; dst = L_qkm + (x >> 3) * 160 + (x & 7) * 16; }
            *(u32x4*)dst = v; }
        const float egl = *(const float*)(rec + DN_EGL);
        const float* uT = (const float*)(rec + DN_UT);
        __syncthreads();
        bf16x8 Bs[4];
#pragma unroll
        for (int kb = 0; kb < 4; ++kb) Bs[kb] = pack8(S[2 * kb], S[2 * kb + 1]);
        f32x4 vn[4];
#pragma unroll
        for (int m = 0; m < 4; ++m) { f32x4 a = *(const f32x4*)(uT + (dv0 + c) * 64 + 16 * m + 4 * q);
#pragma unroll
            for (int kb = 0; kb < 4; ++kb) a = MFMA16(lds_afrag(L_negw + (16 * m + c) * 288 + (32 * kb + 4 * q) * 2), Bs[kb], a);
            vn[m] = a; }
        bf16x8 Bv[2];
#pragma unroll
        for (int kb = 0; kb < 2; ++kb) Bv[kb] = pack8(vn[2 * kb], vn[2 * kb + 1]);
#pragma unroll
        for (int m = 0; m < 4; ++m) { f32x4 a = (f32x4){0.f, 0.f, 0.f, 0.f};
#pragma unroll
            for (int kb = 0; kb < 4; ++kb) a = MFMA16(lds_afrag(L_qdec + (16 * m + c) * 288 + (32 * kb + 4 * q) * 2), Bs[kb], a);
#pragma unroll
            for (int kb = 0; kb < 2; ++kb) a = MFMA16(lds_afrag(L_qkm + (16 * m + c) * 160 + (32 * kb + 4 * q) * 2), Bv[kb], a);
#pragma unroll
            for (int j = 0; j < 4; ++j) { const int i = 16 * m + 4 * q + j; const int tok = gc * 64 + (dir ? 63 - i : i);
                O[(size_t)tok * 1024 + h * 128 + dv0 + c] = a[j]; } }
#pragma unroll
        for (int m = 0; m < 8; ++m) { f32x4 a = S[m] * egl;
#pragma unroll
            for (int kb = 0; kb < 2; ++kb) a = MFMA16(lds_afrag(L_kdt + (16 * m + c) * 160 + (32 * kb + 4 * q) * 2), Bv[kb], a);
            S[m] = a; }
    }
    if (ctx) { float* so = pout(p) + (size_t)NTOK * DM + ((size_t)((sq * 2 + l) * 2 + dir) * 8 + h) * 16384;
#pragma unroll
        for (int m = 0; m < 8; ++m)
#pragma unroll
            for (int j = 0; j < 4; ++j) so[(16 * m + 4 * q + j) * 128 + dv0 + c] = S[m][j]; }
}

__device__ __forceinline__ void lna_group(const Params& p, int l, int grp) {
    const int tid = opaque_tid(), lane = tid & 63, wid = tid >> 6;
    const int tok = grp * 8 + wid;
    const float* y = (const float*)(pws(p) + WS_Y) + (size_t)tok * 1024;
    const bf16_t* az = (const bf16_t*)(pws(p) + WS_P) + (size_t)tok * NP + C_AZ;
    bf16_t* U = (bf16_t*)(pws(p) + WS_U) + (size_t)tok * 2048;
    const float* lg = pin(p, 11) + l * 1024; const float* lb = pin(p, 12) + l * 1024;
    f32x4 v[4]; float s = 0.f;
#pragma unroll
    for (int i = 0; i < 4; ++i) { v[i] = *(const f32x4*)(y + (lane + 64 * i) * 4); s += v[i][0] + v[i][1] + v[i][2] + v[i][3]; }
    const float mu = wave_sum(s) * (1.0f / 1024.0f);
    float s2 = 0.f;
#pragma unroll
    for (int i = 0; i < 4; ++i) { v[i] -= mu; s2 += v[i][0] * v[i][0] + v[i][1] * v[i][1] + v[i][2] * v[i][2] + v[i][3] * v[i][3]; }
    const float rstd = rsqrtf(wave_sum(s2) * (1.0f / 1024.0f) + EPS);
#pragma unroll
    for (int i = 0; i < 4; ++i) { const int cc = (lane + 64 * i) * 4; const f32x4 g = *(const f32x4*)(lg + cc), bb = *(const f32x4*)(lb + cc);
        const u32x2 zz = *(const u32x2*)(az + cc);
        f32x4 o = v[i] * rstd * g + bb;
        const float z0 = __uint_as_float(zz[0] << 16), z1 = __uint_as_float(zz[0] & 0xffff0000u), z2 = __uint_as_float(zz[1] << 16), z3 = __uint_as_float(zz[1] & 0xffff0000u);
        u32x2 ov; ov[0] = pk2(siluf_(o[0]) * siluf_(z0), siluf_(o[1]) * siluf_(z1)); ov[1] = pk2(siluf_(o[2]) * siluf_(z2), siluf_(o[3]) * siluf_(z3));
        *(u32x2*)(U + cc) = ov; }
}

__device__ __forceinline__ void ps_phase(const Params& p, int l, unsigned char* lds) {
    const int b = blockIdx.x, G = gridDim.x;
    for (int r = 0;; ++r) { const int id = r * G + (r == 0 ? b : (b + 64 * G - 64) % G); if (id >= 320) break;
        const int sq = id < 64 ? 16 + (id >> 4) : ((id - 64) >> 4);
        scan_item(p, l, sq, (id >> 1) & 7, id & 1, lds); }
    const int gs = G == 256 ? (b >= 64 ? b - 64 : 1024) : b, gst = G == 256 ? 192 : G;
    for (int g = gs; g < 1024; g += gst) lna_group(p, l, g);
}

__device__ __forceinline__ void pnb_phase(const Params& p, int l) {
    const int tid = opaque_tid(), lane = tid & 63, wid = tid >> 6;
    const float* Of = (const float*)(pws(p) + WS_R1); const float* Ob = Of + (size_t)NTOK * 1024;
    const float* hg = pin(p, 17) + l * 128;
    for (int tok = blockIdx.x * 8 + wid; tok < NTOK; tok += gridDim.x * 8) {
        const int cb = lane * 16;
        f32x4 v[4]; float ss = 0.f;
#pragma unroll
        for (int i = 0; i < 4; ++i) { v[i] = *(const f32x4*)(Of + (size_t)tok * 1024 + cb + 4 * i) + *(const f32x4*)(Ob + (size_t)tok * 1024 + cb + 4 * i);
            ss += v[i][0] * v[i][0] + v[i][1] * v[i][1] + v[i][2] * v[i][2] + v[i][3] * v[i][3]; }
        ss += __shfl_xor(ss, 1); ss += __shfl_xor(ss, 2); ss += __shfl_xor(ss, 4);
        const float rstd = rsqrtf(ss * (1.0f / 128.0f) + EPS);
        const bf16_t* zb = (const bf16_t*)(pws(p) + WS_P) + (size_t)tok * NP + C_ZB + cb;
        bf16_t* U = (bf16_t*)(pws(p) + WS_U) + (size_t)tok * 2048 + 1024 + cb;
        const u32x4 z0 = *(const u32x4*)zb, z1 = *(const u32x4*)(zb + 8);
        float o[16];
#pragma unroll
        for (int i = 0; i < 4; ++i) { const f32x4 g = *(const f32x4*)(hg + ((cb + 4 * i) & 127));
#pragma unroll
            for (int e = 0; e < 4; ++e) o[4 * i + e] = v[i][e] * rstd * g[e]; }
        u32x4 r0, r1;
#pragma unroll
        for (int w2 = 0; w2 < 4; ++w2) { const unsigned za = z0[w2], zc = z1[w2];
            r0[w2] = pk2(o[2 * w2] * siluf_(__uint_as_float(za << 16)), o[2 * w2 + 1] * siluf_(__uint_as_float(za & 0xffff0000u)));
            r1[w2] = pk2(o[8 + 2 * w2] * siluf_(__uint_as_float(zc << 16)), o[8 + 2 * w2 + 1] * siluf_(__uint_as_float(zc & 0xffff0000u))); }
        *(u32x4*)U = r0; *(u32x4*)(U + 8) = r1;
    }
}

__global__ void __launch_bounds__(NTHR) fwd_megakernel(Params p) {
    extern __shared__ __attribute__((aligned(16))) unsigned char lds[];
    cg::grid_group grid = cg::this_grid();
    const int lo = p.ph_lo, hi = p.ph_hi;
#define IN(k) (lo <= (k) && (k) < hi)
#define SEAM(k) do { if (IN(k) && IN((k) + 1)) grid.sync(); } while (0)
#if (!defined(ONLY) || ONLY == 0) && !defined(SKIP0)
    if (IN(0)) p0_prologue(p, (float*)lds);
#endif
    SEAM(0);
    for (int l = 0; l < 2; ++l) {
        const int pb = 1 + 7 * l;
        unsigned char* ws = pws(p);
#if (!defined(ONLY) || ONLY == 1) && !defined(SKIP1)
        if (IN(pb)) pn_norm(p, l);
#endif
        SEAM(pb);
#if (!defined(ONLY) || ONLY == 2) && !defined(SKIP2)
        if (IN(pb + 1)) {
            pg8::Gemm g{(const bf16_t*)(ws + WS_R1), (const bf16_t*)(ws + WS_WIN + l * SZ_WIN1), NTOK, NP, DM, DM};
            pg8::StaticOrder S; S.init(NTOK, NP, (int)gridDim.x, (int)blockIdx.x);
            EpiP E{(bf16_t*)(ws + WS_P), (float*)(ws + WS_BA)};
            pg8::gemm_phase<EpiP, pg8::StaticOrder>((LAS unsigned char*)lds, g, S, E, nullptr);
        }
#endif
        SEAM(pb + 1);
#if (!defined(ONLY) || ONLY == 3) && !defined(SKIP3)
        if (IN(pb + 2)) pc_phase(p, l, (float*)lds);
#endif
        SEAM(pb + 2);
#if (!defined(ONLY) || ONLY == 4) && !defined(SKIP4)
        if (IN(pb + 3)) ps_phase(p, l, lds);
#endif
        SEAM(pb + 3);
#if (!defined(ONLY) || ONLY == 5) && !defined(SKIP5)
        if (IN(pb + 4)) pnb_phase(p, l);
#endif
        SEAM(pb + 4);
#if (!defined(ONLY) || ONLY == 6) && !defined(SKIP6)
        if (IN(pb + 5)) {
            pg8::Gemm g{(const bf16_t*)(ws + WS_U), (const bf16_t*)(ws + WS_WP2 + l * SZ_SQ), NTOK, DM, 1024, DM};
            ChainOrder S; S.init(NTOK, DM, (int)gridDim.x, (int)blockIdx.x);
            EpiMG E{(const bf16_t*)(ws + WS_P), (bf16_t*)(ws + WS_R1)};
            pg8::gemm_phase<EpiMG, ChainOrder>((LAS unsigned char*)lds, g, S, E, nullptr);
        }
#endif
        SEAM(pb + 5);
#if (!defined(ONLY) || ONLY == 7) && !defined(SKIP7)
        if (IN(pb + 6)) {
            pg8::Gemm g{(const bf16_t*)(ws + WS_R1), (const bf16_t*)(ws + WS_WO + l * SZ_SQ), NTOK, DM, DM, DM};
            pg8::StaticOrder S; S.init(NTOK, DM, (int)gridDim.x, (int)blockIdx.x);
            EpiX E{pin(p, 0), pin(p, 1), l == 0 ? nullptr : (const float*)(ws + WS_X1), (const float*)(ws + WS_MOD) + (size_t)l * 5 * 6144 + 4096, l == 0 ? (float*)(ws + WS_X1) : (float*)(ws + WS_P)};
            pg8::gemm_phase<EpiX, pg8::StaticOrder>((LAS unsigned char*)lds, g, S, E, nullptr);
        }
#endif
        SEAM(pb + 6);
    }
#if (!defined(ONLY) || ONLY == 8) && !defined(SKIP8)
    if (IN(15)) pf_final(p);
#endif
}

#ifndef MK_N_LAUNCHES
#define MK_N_LAUNCHES 1
#endif
extern "C" void kernel_launch(void* const* d_in, const int* in_sizes, int n_in, void* d_out, int out_size, void* d_ws, size_t ws_size, hipStream_t stream) {
    static int grid = 0;
    if (grid == 0) {
        int dev = 0, cus = 0, per_cu = 0;
        hipGetDevice(&dev);
        hipDeviceGetAttribute(&cus, hipDeviceAttributeMultiprocessorCount, dev);
        if (hipFuncSetAttribute((const void*)fwd_megakernel, hipFuncAttributeMaxDynamicSharedMemorySize, LDS_BYTES) != hipSuccess) { fprintf(stderr, "kernel_launch: hipFuncSetAttribute failed\n"); grid = -1; return; }
        if (hipOccupancyMaxActiveBlocksPerMultiprocessor(&per_cu, (const void*)fwd_megakernel, NTHR, LDS_BYTES) != hipSuccess || per_cu < 1) { fprintf(stderr, "kernel_launch: occupancy query says %d blocks per CU\n", per_cu); grid = -1; return; }
        grid = cus * 1;
        if (n_in != 21 || ws_size < WS_END) { fprintf(stderr, "kernel_launch: unexpected n_in %d / ws %zu\n", n_in, ws_size); grid = -1; return; }
    }
    if (grid < 0) return;
    Params p{};
    for (int i = 0; i < 21; ++i) p.in[i] = (const float*)d_in[i];
    p.out = (float*)d_out; p.ws = (unsigned char*)d_ws;
#if MK_N_LAUNCHES == 1
    p.ph_lo = 0; p.ph_hi = 16;
    void* args[] = {&p};
    hipError_t e = hipLaunchCooperativeKernel((const void*)fwd_megakernel, dim3(grid), dim3(NTHR), args, LDS_BYTES, stream);
    if (e != hipSuccess) fprintf(stderr, "cooperative launch failed: %s (grid %d)\n", hipGetErrorString(e), grid);
#else
    for (int ph = 0; ph < 16; ++ph) { p.ph_lo = ph; p.ph_hi = ph + 1;
        hipLaunchKernelGGL(fwd_megakernel, dim3(grid), dim3(NTHR), LDS_BYTES, stream, p); }
#endif
}
```

```cpp
#include <hip/hip_runtime.h>
#include <hip/hip_cooperative_groups.h>
#include <cstdio>
#include <cstdint>
namespace cg = cooperative_groups;
namespace pg8 {
#define PG8_LAS __attribute__((address_space(3)))
typedef unsigned short bf16_t;
typedef short bf16x8 __attribute__((ext_vector_type(8)));
typedef float f32x4 __attribute__((ext_vector_type(4)));
typedef unsigned u32x4 __attribute__((ext_vector_type(4)));
constexpr int BM = 256, BK = 64, HALF = 128, HTB = HALF * BK * 2  , STAGE_BYTES = 8 * HTB, NXCD = 8, WGM = 8;

__host__ __device__ __forceinline__ int lds_byte(int r, int c) { const int st = (r >> 4) * 2 + (c >> 5), rr = r & 15, cc = c & 31, ob = rr * 64 + cc * 2; return st * 1024 + (ob ^ (((ob >> 9) & 1) << 5)); }
__host__ __device__ __forceinline__ void stage_rc(int b, int& R, int& C) { const int st = b / 1024, sb = b % 1024, swz = sb ^ (((sb >> 9) & 1) << 5); R = (st >> 1) * 16 + swz / 64; C = (st & 1) * 32 + (swz % 64) / 2; }
__host__ __device__ __forceinline__ int perm32(int rho) { const int n = rho >> 4, i = rho & 15; return 8 * (i >> 2) + 4 * n + (i & 3); }

struct Unit { int pm, pn, kh; };
struct Gemm { const bf16_t* A; const bf16_t* Bt; int M, N, K, lda; };

struct StaticOrder {
    int nM, nN, nwg, G, c;
    __host__ __device__ void init(int M, int N, int G_, int c_) { nM = M / BM; nN = N / BM; nwg = nM * nN; G = G_; c = c_; }
    __host__ __device__ bool next(int i, Unit& u) const {
        const long L = (long)i * G + c; if (L >= nwg) return false;
        int wgid = (int)L; { const int q = nwg / NXCD, r = nwg % NXCD, xcd = wgid % NXCD, off = wgid / NXCD; wgid = (xcd < r ? xcd * (q + 1) : r * (q + 1) + (xcd - r) * q) + off; }
        const int nig = WGM * nN, gid = wgid / nig, fm = gid * WGM, gsz = (nM - fm) < WGM ? (nM - fm) : WGM;
        u.pm = fm + ((wgid % nig) % gsz); u.pn = (wgid % nig) / gsz; u.kh = 0; return true;
    }
    __device__ __forceinline__ void a_ready(const Unit&) const {}
    __device__ __forceinline__ void done(const Unit&) const {}
};
__device__ __forceinline__ unsigned cvt_pk_bf16(float lo, float hi) { unsigned r; asm volatile("v_cvt_pk_bf16_f32 %0, %1, %2" : "=v"(r) : "v"(lo), "v"(hi)); return r; }
template <class Epi, class Sched, bool STAMP = false, bool ALIGN_EPI = false, bool SP2 = false>
__device__ __forceinline__ void gemm_phase(PG8_LAS unsigned char* lds, const Gemm g, const Sched& S, const Epi& E, unsigned long long* stamps) {
    int tid_ = threadIdx.x; asm volatile("" : "+v"(tid_)); const int tid = tid_, wid = __builtin_amdgcn_readfirstlane(tid >> 6), lane = tid & 63, wr = wid >> 2, wc = wid & 3, fr = lane & 15, fq = lane >> 4;
    const int K = g.K, nt = K / BK;
    int ts_lo = 0, ts_hi = 0, nts = 0; const unsigned long long rt_entry = STAMP ? (unsigned long long)wall_clock64() : 0ull;
#define PG8_STAMP() do { if (STAMP && wid == 0 && nts < 64) { const unsigned long long _c = (unsigned long long)clock64(); \
        ts_lo = (lane == nts) ? (int)(unsigned)_c : ts_lo; ts_hi = (lane == nts) ? (int)(unsigned)(_c >> 32) : ts_hi; ++nts; } } while (0)
    PG8_STAMP();
    unsigned voffA[2], voffB[2];
#pragma unroll
    for (int i = 0; i < 2; ++i) { int R, C; stage_rc(tid * 16 + i * 8192, R, C); const int Rb = Epi::PERM ? ((R & ~31) + perm32(R & 31)) : R;
        voffA[i] = (unsigned)(R * g.lda + C) * 2u; voffB[i] = (unsigned)(Rb * g.lda + C) * 2u; }
    const size_t kstep = (size_t)(BK * 2);
    const size_t hstep = (size_t)HALF * g.lda * 2; const size_t khstep = (size_t)K * 2;
    const size_t tstep = 2 * hstep;
    const unsigned ldsw = (unsigned)wid * 1024u;
    const int aoff = lds_byte(wr * 64 + fr, fq * 8), boff = lds_byte(wc * 32 + fr, fq * 8);
#define PG8_SA(b, h) (((b) * 2 + (h)) * HTB)
#define PG8_SB(b, h) ((4 + (b) * 2 + (h)) * HTB)
#define PG8_STAGE(bufoff, gbase, voff) do { _Pragma("unroll") for (int _i = 0; _i < 2; ++_i) \
        __builtin_amdgcn_global_load_lds((const unsigned*)((const char*)(gbase) + (voff)[_i]), (PG8_LAS unsigned*)(lds + (bufoff) + ldsw + _i * 8192), 16, 0, 0); } while (0)
#define PG8_LDA(dst, b, h) do { _Pragma("unroll") for (int m = 0; m < 4; ++m) _Pragma("unroll") for (int k = 0; k < 2; ++k) dst[m][k] = *(const PG8_LAS bf16x8*)(lds + PG8_SA(b, h) + aoff + m * 2048 + k * 1024); } while (0)
#define PG8_LDB(dst, b, h) do { _Pragma("unroll") for (int n = 0; n < 2; ++n) _Pragma("unroll") for (int k = 0; k < 2; ++k) dst[n][k] = *(const PG8_LAS bf16x8*)(lds + PG8_SB(b, h) + boff + n * 2048 + k * 1024); } while (0)
#define PG8_MMA(ai, bj, At, Bt) do { __builtin_amdgcn_s_setprio(1); _Pragma("unroll") for (int m = 0; m < 4; ++m) _Pragma("unroll") for (int n = 0; n < 2; ++n) _Pragma("unroll") for (int k = 0; k < 2; ++k) \
        acc[ai][bj][m][n] = __builtin_amdgcn_mfma_f32_16x16x32_bf16(Bt[n][k], At[m][k], acc[ai][bj][m][n], 0, 0, 0); __builtin_amdgcn_s_setprio(0); } while (0)
#define PG8_WAIT_V(n) asm volatile("s_waitcnt vmcnt(" #n ")" ::: "memory")
#define PG8_WAIT_L(n) asm volatile("s_waitcnt lgkmcnt(" #n ")" ::: "memory")
#define PG8_BAR __builtin_amdgcn_s_barrier()
#define PG8_SCHED __builtin_amdgcn_sched_barrier(0)
    Unit cur, nxt; int ui = 0;
    if (!S.next(0, cur)) return;
    f32x4 acc[2][2][4][2];
#pragma unroll
    for (int a = 0; a < 2; ++a)
#pragma unroll
        for (int b = 0; b < 2; ++b)
#pragma unroll
            for (int m = 0; m < 4; ++m)
#pragma unroll
                for (int n = 0; n < 2; ++n) acc[a][b][m][n] = (f32x4){0.f, 0.f, 0.f, 0.f};
    bf16x8 At[4][2], B0[2][2], B1[2][2];
    const char* cA = (const char*)g.A + (size_t)cur.pm * tstep + cur.kh * khstep; const char* cB = (const char*)g.Bt + (size_t)cur.pn * tstep + cur.kh * khstep;
    S.a_ready(cur);
    if constexpr (SP2) {
        PG8_STAGE(PG8_SB(0, 0), cB, voffB); PG8_STAGE(PG8_SB(0, 1), cB + hstep, voffB); PG8_STAGE(PG8_SA(0, 0), cA, voffA); PG8_STAGE(PG8_SA(0, 1), cA + hstep, voffA);
        if (wr == 1) PG8_BAR;
        PG8_WAIT_V(2); PG8_BAR;
        PG8_STAGE(PG8_SB(1, 0), cB + kstep, voffB); PG8_STAGE(PG8_SA(1, 0), cA + kstep, voffA); PG8_STAGE(PG8_SB(1, 1), cB + hstep + kstep, voffB);
        PG8_WAIT_V(6); PG8_BAR;
    } else {
    PG8_STAGE(PG8_SB(0, 0), cB, voffB); PG8_STAGE(PG8_SA(0, 0), cA, voffA); PG8_STAGE(PG8_SB(0, 1), cB + hstep, voffB); PG8_STAGE(PG8_SA(0, 1), cA + hstep, voffA);
    if (wr == 1) PG8_BAR;
    PG8_WAIT_V(4); PG8_BAR;
    PG8_STAGE(PG8_SB(1, 0), cB + kstep, voffB); PG8_STAGE(PG8_SA(1, 0), cA + kstep, voffA); PG8_STAGE(PG8_SB(1, 1), cB + hstep + kstep, voffB);
    PG8_WAIT_V(6); PG8_BAR;
    }
    PG8_STAMP();
    for (;;) {
        const bool has_next = S.next(ui + 1, nxt);
        const char* nA = has_next ? (const char*)g.A + (size_t)nxt.pm * tstep + nxt.kh * khstep : cA; const char* nB = has_next ? (const char*)g.Bt + (size_t)nxt.pn * tstep + nxt.kh * khstep : cB;
        for (int t = 0; t < nt; t += 2) {
            const bool last = (t == nt - 2);
            const char* a1 = cA + (size_t)(t + 1) * kstep;
            const char* a2 = last ? nA : cA + (size_t)(t + 2) * kstep; const char* b2 = last ? nB : cB + (size_t)(t + 2) * kstep;
            const char* a3 = a2 + kstep; const char* b3 = b2 + kstep;
            if (last && has_next) S.a_ready(nxt);
            if constexpr (SP2) {
            PG8_LDB(B0, 0, 0); PG8_LDB(B1, 0, 1); PG8_SCHED; PG8_LDA(At, 0, 0); PG8_STAGE(PG8_SA(1, 1), a1 + hstep, voffA);
            PG8_WAIT_V(8); PG8_WAIT_L(0); PG8_BAR; PG8_MMA(0, 0, At, B0); PG8_MMA(0, 1, At, B1); PG8_BAR; PG8_SCHED;
            PG8_LDA(At, 0, 1); PG8_STAGE(PG8_SB(0, 0), b2, voffB); PG8_STAGE(PG8_SB(0, 1), b2 + hstep, voffB); PG8_STAGE(PG8_SA(0, 0), a2, voffA);
            PG8_WAIT_V(8); PG8_WAIT_L(0); PG8_BAR; PG8_MMA(1, 0, At, B0); PG8_MMA(1, 1, At, B1); PG8_BAR; PG8_SCHED;
            PG8_LDB(B0, 1, 0); PG8_LDB(B1, 1, 1); PG8_SCHED; PG8_LDA(At, 1, 0); PG8_STAGE(PG8_SA(0, 1), a2 + hstep, voffA);
            PG8_WAIT_V(8); PG8_WAIT_L(0); PG8_BAR; PG8_MMA(0, 0, At, B0); PG8_MMA(0, 1, At, B1); PG8_BAR; PG8_SCHED;
            PG8_LDA(At, 1, 1); PG8_STAGE(PG8_SB(1, 0), b3, voffB); PG8_STAGE(PG8_SB(1, 1), b3 + hstep, voffB); PG8_STAGE(PG8_SA(1, 0), a3, voffA);
            PG8_WAIT_V(8); PG8_WAIT_L(0); PG8_BAR; PG8_MMA(1, 0, At, B0); PG8_MMA(1, 1, At, B1); PG8_BAR; PG8_SCHED;
            } else {
            PG8_LDB(B0, 0, 0); PG8_SCHED; PG8_LDA(At, 0, 0); PG8_STAGE(PG8_SA(1, 1), a1 + hstep, voffA);
            PG8_WAIT_L(8); PG8_BAR; PG8_WAIT_L(0); PG8_MMA(0, 0, At, B0); PG8_BAR; PG8_SCHED;
            PG8_LDB(B1, 0, 1); PG8_STAGE(PG8_SB(0, 0), b2, voffB);
            PG8_BAR; PG8_WAIT_L(0); PG8_MMA(0, 1, At, B1); PG8_BAR;
            PG8_LDA(At, 0, 1); PG8_STAGE(PG8_SA(0, 0), a2, voffA);
            PG8_BAR; PG8_WAIT_L(0); PG8_MMA(1, 0, At, B0); PG8_BAR; PG8_SCHED;
            PG8_STAGE(PG8_SB(0, 1), b2 + hstep, voffB);
            PG8_WAIT_V(6); PG8_BAR; PG8_MMA(1, 1, At, B1); PG8_BAR;
            PG8_LDB(B0, 1, 0); PG8_SCHED; PG8_LDA(At, 1, 0); PG8_STAGE(PG8_SA(0, 1), a2 + hstep, voffA);
            PG8_WAIT_L(8); PG8_BAR; PG8_WAIT_L(0); PG8_MMA(0, 0, At, B0); PG8_BAR; PG8_SCHED;
            PG8_LDB(B1, 1, 1); PG8_STAGE(PG8_SB(1, 0), b3, voffB);
            PG8_BAR; PG8_WAIT_L(0); PG8_MMA(0, 1, At, B1); PG8_BAR;
            PG8_LDA(At, 1, 1); PG8_STAGE(PG8_SA(1, 0), a3, voffA);
            PG8_BAR; PG8_WAIT_L(0); PG8_MMA(1, 0, At, B0); PG8_BAR; PG8_SCHED;
            PG8_STAGE(PG8_SB(1, 1), b3 + hstep, voffB);
            PG8_WAIT_V(6); PG8_BAR; PG8_MMA(1, 1, At, B1); PG8_BAR;
            }
        }
        PG8_STAMP();
        if constexpr (ALIGN_EPI) { if (wr == 0) PG8_BAR; }
        if constexpr (!Epi::AFTER_DRAIN) { E(acc, cur, wr, wc, fr, fq); S.done(cur); }
        PG8_STAMP();
        if (!has_next) break;
        if (!(Epi::CHAIN && cur.kh == 0))
#pragma unroll
        for (int a = 0; a < 2; ++a)
#pragma unroll
            for (int b = 0; b < 2; ++b)
#pragma unroll
                for (int m = 0; m < 4; ++m)
#pragma unroll
                    for (int n = 0; n < 2; ++n) acc[a][b][m][n] = (f32x4){0.f, 0.f, 0.f, 0.f};
        cur = nxt; cA = nA; cB = nB; ++ui;
        if constexpr (ALIGN_EPI) { if (wr == 1) PG8_BAR; }
    }
    PG8_WAIT_V(0);
    if constexpr (!ALIGN_EPI) { if (wr == 0) PG8_BAR; }
    PG8_BAR;
    if constexpr (Epi::AFTER_DRAIN) { E.fused(acc, cur, wr, wc, fr, fq, lds, wid, lane); S.done(cur); }
    PG8_STAMP();
    if (STAMP && wid == 0) { stamps[lane] = lane < nts ? (((unsigned long long)(unsigned)ts_hi << 32) | (unsigned)ts_lo) : 0ull;
        if (lane == 62) stamps[62] = rt_entry; if (lane == 63) stamps[63] = (unsigned long long)wall_clock64(); }
#undef PG8_STAMP
#undef PG8_SA
#undef PG8_SB
#undef PG8_STAGE
#undef PG8_LDA
#undef PG8_LDB
#undef PG8_MMA
#undef PG8_WAIT_V
#undef PG8_WAIT_L
#undef PG8_BAR
#undef PG8_SCHED
}
}
#ifndef GEMM_SP2
#define GEMM_SP2 true
#endif
#ifndef GEMM_ALIGN
#define GEMM_ALIGN true
#endif
#ifndef REP_DN
#define REP_DN 1
#endif
#ifndef REP_CONV
#define REP_CONV 1
#endif
#ifndef PG1_TILES
#define PG1_TILES 6
#endif
#ifndef REP_SCAN
#define REP_SCAN 1
#endif
#ifndef REP_TILES
#define REP_TILES 1
#endif
#ifndef REP_LNA
#define REP_LNA 1
#endif
#ifndef REP_GRAM
#define REP_GRAM 1
#endif
#ifndef REP_E
#define REP_E 1
#endif
#ifndef REP_SOLVE
#define REP_SOLVE 1
#endif

#define LAS __attribute__((address_space(3)))
typedef unsigned short bf16_t;
typedef short bf16x8 __attribute__((ext_vector_type(8)));
typedef float f32x4 __attribute__((ext_vector_type(4)));
typedef unsigned u32x4 __attribute__((ext_vector_type(4)));
typedef unsigned u32x2 __attribute__((ext_vector_type(2)));

constexpr int NTOK = 8192, DM = 2048, NCTX = 4096, NP = 11520, NTHR = 512;
constexpr int C_AVAL = 0, C_AGLU = 1024, C_AZ = 2048, C_Q = 3072, C_ZB = 6144, C_GA = 7168, C_GB = 9216, C_BA = 11264;
constexpr float EPS = 1e-6f;
constexpr int LDS_BYTES = 139264;
constexpr int LDS_TQ = LDS_BYTES - 8;
constexpr int LDS_BARST = LDS_BYTES - 16;
constexpr int XCD_BAR_BYTES = 3456 * 4;

constexpr size_t WS_WIN = 256;
constexpr size_t SZ_WIN1 = (size_t)NP * DM * 2;
constexpr size_t WS_WP2 = WS_WIN + 2 * SZ_WIN1;
constexpr size_t SZ_SQ = (size_t)DM * DM * 2;
constexpr size_t WS_WO = WS_WP2 + 2 * SZ_SQ;
constexpr size_t WS_MOD = WS_WO + 2 * SZ_SQ;
constexpr size_t WS_R1 = WS_MOD + 2 * 5 * 6144 * 4;
constexpr size_t WS_P = WS_R1 + (size_t)2 * NTOK * 1024 * 4;
constexpr size_t WS_BA = WS_P + (size_t)NTOK * NP * 2;
constexpr size_t WS_Y = WS_BA + (size_t)NTOK * 32 * 4;
constexpr size_t WS_U = WS_Y + (size_t)NTOK * 1024 * 4;
constexpr size_t WS_DN = WS_U + (size_t)NTOK * 2048 * 2;
constexpr int DN_NEGW = 0, DN_QDEC = 16384, DN_KDT = 32768, DN_QKM = 49152, DN_UT = 57344, DN_EGL = 90112, DN_REC = 90368;
constexpr size_t WS_X1 = WS_DN + (size_t)2048 * DN_REC;
constexpr size_t WS_END = WS_X1 + (size_t)NTOK * DM * 4;
constexpr size_t WS_BARW = WS_END;
constexpr size_t WS_TQ = WS_BARW + 15360;
constexpr size_t WS_END2 = WS_BARW + 16384;
static_assert(WS_END2 <= 740294656ull && XCD_BAR_BYTES <= 16384, "workspace");

__device__ __forceinline__ int opaque_tid() { int t = threadIdx.x; asm volatile("" : "+v"(t)); return t; }
struct Params { const float* in[21]; float* out; unsigned char* ws; int ph_lo, ph_hi; };
#define KA_ __attribute__((address_space(4)))
__device__ __forceinline__ const float* pin(const Params&, int k) { const KA_ char* ka = (const KA_ char*)__builtin_amdgcn_kernarg_segment_ptr(); return *(const float* const volatile KA_*)(ka + 8 * k); }
__device__ __forceinline__ unsigned char* pws(const Params&) { const KA_ char* ka = (const KA_ char*)__builtin_amdgcn_kernarg_segment_ptr(); return *(unsigned char* const volatile KA_*)(ka + 8 * 22); }
__device__ __forceinline__ float* pout(const Params&) { const KA_ char* ka = (const KA_ char*)__builtin_amdgcn_kernarg_segment_ptr(); return *(float* const volatile KA_*)(ka + 8 * 21); }

__device__ __forceinline__ float bf2f(unsigned short b) { return __uint_as_float(((unsigned)b) << 16); }
__device__ __forceinline__ unsigned f2bf(float f) { unsigned u = __float_as_uint(f); u += 0x7fffu + ((u >> 16) & 1u); return u >> 16; }
typedef float f32x2_t __attribute__((ext_vector_type(2)));
typedef __bf16 bf16x2_t __attribute__((ext_vector_type(2)));
__device__ __forceinline__ unsigned pk2(float lo, float hi) { const f32x2_t v = {lo, hi}; return __builtin_bit_cast(unsigned, __builtin_convertvector(v, bf16x2_t)); }
__device__ __forceinline__ float sigmoidf_(float x) { return __builtin_amdgcn_rcpf(1.0f + __expf(-x)); }
__device__ __forceinline__ float siluf_(float x) { return x * __builtin_amdgcn_rcpf(1.0f + __expf(-x)); }
__device__ __forceinline__ f32x4 bf4_to_f32(u32x2 w) { return (f32x4){__uint_as_float(w[0] << 16), __uint_as_float(w[0] & 0xffff0000u), __uint_as_float(w[1] << 16), __uint_as_float(w[1] & 0xffff0000u)}; }
__device__ __forceinline__ float wave_sum(float v) {
#pragma unroll
    for (int o = 32; o > 0; o >>= 1) v += __shfl_xor(v, o);
    return v;
}
__device__ __forceinline__ const float* xrow0(const Params& p, int tok) { return tok < NCTX ? pin(p, 0) + (size_t)tok * DM : pin(p, 1) + (size_t)(tok - NCTX) * DM; }
__device__ __forceinline__ int cvec_of(int tok) { return tok < NCTX ? 0 : 1 + ((tok - NCTX) >> 10); }

__device__ __forceinline__ void tr_tile(const float* __restrict__ src, int ldsrc, int k0, int n0, int mode, bf16_t* __restrict__ dst, int lddst, int koff, float* lds) {
    const int tid = opaque_tid();
    { const int c4 = tid & 31, rr = tid >> 5; const int np = n0 + c4 * 4; int sc = np;
        if (mode == 1) { sc = np < 7168 ? np : (np < 11264 ? np + 32 : (np < 11296 ? np - 11264 + 7168 : -1)); }
#pragma unroll
        for (int i = 0; i < 8; ++i) { const int r = rr + 16 * i;
            *(f32x4*)(lds + r * 132 + c4 * 4) = sc >= 0 ? *(const f32x4*)(src + (size_t)(k0 + r) * ldsrc + sc) : (f32x4){0.f, 0.f, 0.f, 0.f}; } }
    __syncthreads();
#pragma unroll
    for (int i = 0; i < 4; ++i) { const int u = tid + 512 * i, nn = u & 127, kg = u >> 7;
        u32x4 o;
#pragma unroll
        for (int j = 0; j < 4; ++j) o[j] = pk2(lds[(kg * 8 + 2 * j) * 132 + nn], lds[(kg * 8 + 2 * j + 1) * 132 + nn]);
        *(u32x4*)(dst + (size_t)(n0 + nn) * lddst + koff + k0 + kg * 8) = o; }
    __syncthreads();
}
__device__ __forceinline__ void weight_tile(const Params& p, int it, float* lds) {
    unsigned char* ws = pws(p);
    const int l = it / 1952; int r = it % 1952;
    const float* src; int ldsrc, kt, ntile, mode = 0, koff = 0; bf16_t* dst;
    if (r < 1440) { kt = r / 90; ntile = r % 90; src = pin(p, 8) + (size_t)l * 2048 * 11296; ldsrc = 11296; mode = 1; dst = (bf16_t*)(ws + WS_WIN + l * SZ_WIN1); }
    else if (r < 1440 + 256) { r -= 1440; const int which = r / 128; r %= 128; kt = r / 16; ntile = r % 16;
        src = pin(p, which ? 18 : 13) + (size_t)l * 1024 * 2048; ldsrc = 2048; dst = (bf16_t*)(ws + WS_WP2 + l * SZ_SQ); koff = which * 1024; }
    else { r -= 1696; kt = r / 16; ntile = r % 16; src = pin(p, 19) + (size_t)l * 2048 * 2048; ldsrc = 2048; dst = (bf16_t*)(ws + WS_WO + l * SZ_SQ); }
    tr_tile(src, ldsrc, kt * 128, ntile * 128, mode, dst, 2048, koff, lds);
}

__device__ __forceinline__ void drain_tiles(const Params& p, int max_tiles, unsigned char* lds) {
    volatile LAS unsigned* slot = (volatile LAS unsigned*)((LAS unsigned char*)lds + LDS_TQ);
    __syncthreads();
    for (int n = 0; n < max_tiles; ++n) {
        if (threadIdx.x == 0) *slot = __hip_atomic_fetch_add((unsigned*)(pws(p) + WS_TQ), 1u, __ATOMIC_RELAXED, __HIP_MEMORY_SCOPE_AGENT);
        __syncthreads();
        const unsigned it = *slot;
        if (it >= 2u * 1952u - 1440u) break;
        weight_tile(p, 1440 + (int)it, (float*)lds);
    }
}
__device__ __forceinline__ void p0_prologue(const Params& p, float* lds) {
    const int tid = opaque_tid(), G = gridDim.x, b = blockIdx.x;
    unsigned char* ws = pws(p);
    for (int it = b; it < 1440; it += G) weight_tile(p, it, lds);
    float* sc = lds;
    float* red = lds + 5 * 2048;
    __syncthreads();
    for (int i = tid; i < 5 * 2048; i += NTHR) { const int v = i >> 11, k = i & 2047; const float x = v == 0 ? pin(p, 4)[k] : pin(p, 3)[(v - 1) * 2048 + k]; sc[i] = siluf_(x); }
    __syncthreads();
    for (int it = b; it < 192; it += G) {
        const int l = it / 96, col0 = (it % 96) * 64;
        const int kq = tid >> 4, c4 = tid & 15;
        f32x4 acc[5];
#pragma unroll
        for (int v = 0; v < 5; ++v) acc[v] = (f32x4){0.f, 0.f, 0.f, 0.f};
        const float* wp = pin(p, 5) + (size_t)l * 2048 * 6144 + col0 + c4 * 4;
#pragma unroll 8
        for (int i = 0; i < 64; ++i) { const int k = kq + 32 * i; const f32x4 w = *(const f32x4*)(wp + (size_t)k * 6144);
#pragma unroll
            for (int v = 0; v < 5; ++v) acc[v] += w * sc[v * 2048 + k]; }
#pragma unroll
        for (int v = 0; v < 5; ++v) *(f32x4*)(red + (kq * 5 + v) * 64 + c4 * 4) = acc[v];
        __syncthreads();
        if (tid < 320) { const int v = tid >> 6, c = tid & 63; float s = 0.f;
            for (int q = 0; q < 32; ++q) s += red[(q * 5 + v) * 64 + c];
            ((float*)(ws + WS_MOD))[(size_t)(l * 5 + v) * 6144 + col0 + c] = s + pin(p, 6)[l * 6144 + col0 + c]; }
        __syncthreads();
    }
}

__device__ __forceinline__ void pn_norm(const Params& p, int l) {
    const int tid = opaque_tid(), lane = tid & 63, wid = tid >> 6;
    bf16_t* XN = (bf16_t*)(pws(p) + WS_R1);
    const float* MOD = (const float*)(pws(p) + WS_MOD);
    const float* ng = pin(p, 7) + l * DM;
    for (int tok = blockIdx.x * 8 + wid; tok < NTOK; tok += gridDim.x * 8) {
        const float* xr = l == 0 ? xrow0(p, tok) : (const float*)(pws(p) + WS_X1) + (size_t)tok * DM;
        f32x4 v[8]; float ss = 0.f;
#pragma unroll
        for (int i = 0; i < 8; ++i) { v[i] = *(const f32x4*)(xr + (lane + 64 * i) * 4); ss += v[i][0] * v[i][0] + v[i][1] * v[i][1] + v[i][2] * v[i][2] + v[i][3] * v[i][3]; }
        ss = wave_sum(ss);
        const float rstd = rsqrtf(ss * (1.0f / DM) + EPS);
        const float* md = MOD + (size_t)(l * 5 + cvec_of(tok)) * 6144;
#pragma unroll
        for (int i = 0; i < 8; ++i) { const int c = (lane + 64 * i) * 4;
            const f32x4 g = *(const f32x4*)(ng + c), sh = *(const f32x4*)(md + c), scl = *(const f32x4*)(md + 2048 + c);
            const f32x4 h = (v[i] * rstd * g) * (scl + 1.0f) + sh;
            u32x2 o; o[0] = pk2(h[0], h[1]); o[1] = pk2(h[2], h[3]);
            *(u32x2*)(XN + (size_t)tok * DM + c) = o; }
    }
}
__device__ __forceinline__ void pf_final(const Params& p) {
    const int tid = opaque_tid(), lane = tid & 63, wid = tid >> 6;
    const float* X2 = (const float*)(pws(p) + WS_P);
    const float* fg = pin(p, 20);
    for (int tok = blockIdx.x * 8 + wid; tok < NTOK; tok += gridDim.x * 8) {
        const float* xr = X2 + (size_t)tok * DM;
        f32x4 v[8]; float ss = 0.f;
#pragma unroll
        for (int i = 0; i < 8; ++i) { v[i] = *(const f32x4*)(xr + (lane + 64 * i) * 4); ss += v[i][0] * v[i][0] + v[i][1] * v[i][1] + v[i][2] * v[i][2] + v[i][3] * v[i][3]; }
        ss = wave_sum(ss);
        const float rstd = rsqrtf(ss * (1.0f / DM) + EPS);
#pragma unroll
        for (int i = 0; i < 8; ++i) { const int c = (lane + 64 * i) * 4; const f32x4 g = *(const f32x4*)(fg + c);
            *(f32x4*)(pout(p) + (size_t)tok * DM + c) = v[i] * rstd * g; }
    }
}

struct ChainOrder : pg8::StaticOrder {
    __device__ bool next(int i, pg8::Unit& u) const { const bool ok = pg8::StaticOrder::next(i >> 1, u); u.kh = i & 1; return ok; }
};
struct EpiP {
    static constexpr bool PERM = true, AFTER_DRAIN = false, CHAIN = false;
    bf16_t* P; float* BA;
    __device__ __forceinline__ void operator()(f32x4 (&acc)[2][2][4][2], const pg8::Unit& u, int wr, int wc, int fr, int fq) const {
        const int row0 = u.pm * 256 + wr * 64 + fr, col0 = u.pn * 256 + wc * 32 + 8 * fq;
#pragma unroll
        for (int ai = 0; ai < 2; ++ai)
#pragma unroll
            for (int m = 0; m < 4; ++m) { const int row = row0 + ai * 128 + m * 16; bf16_t* rowp = P + (size_t)row * NP + col0;
#pragma unroll
                for (int bj = 0; bj < 2; ++bj) { const f32x4 v0 = acc[ai][bj][m][0], v1 = acc[ai][bj][m][1];
                    u32x4 o; o[0] = pg8::cvt_pk_bf16(v0[0], v0[1]); o[1] = pg8::cvt_pk_bf16(v0[2], v0[3]); o[2] = pg8::cvt_pk_bf16(v1[0], v1[1]); o[3] = pg8::cvt_pk_bf16(v1[2], v1[3]);
                    *(u32x4*)(rowp + bj * 128) = o; }
                if (u.pn == 44 && wc == 0) { *(f32x4*)(BA + (size_t)row * 32 + 8 * fq) = acc[ai][0][m][0]; *(f32x4*)(BA + (size_t)row * 32 + 8 * fq + 4) = acc[ai][0][m][1]; }
            }
    }
};
struct EpiMG {
    static constexpr bool PERM = true, AFTER_DRAIN = false, CHAIN = true;
    const bf16_t* P; bf16_t* MG;
    __device__ __forceinline__ void mid(f32x4 (&acc)[2][2][4][2], const pg8::Unit& u, int wr, int wc, int fr, int fq) const {
        const int row0 = u.pm * 256 + wr * 64 + fr, col0 = u.pn * 256 + wc * 32 + 8 * fq;
#pragma unroll
        for (int ai = 0; ai < 2; ++ai)
#pragma unroll
            for (int m = 0; m < 4; ++m) { const int row = row0 + ai * 128 + m * 16; const bf16_t* rowp = P + (size_t)row * NP + col0;
#pragma unroll
                for (int bj = 0; bj < 2; ++bj) { const u32x4 ga = *(const u32x4*)(rowp + C_GA + bj * 128), gb = *(const u32x4*)(rowp + C_GB + bj * 128);
#pragma unroll
                    for (int e = 0; e < 8; ++e) { const float a = __uint_as_float((e & 1) ? (ga[e >> 1] & 0xffff0000u) : (ga[e >> 1] << 16)), bq = __uint_as_float((e & 1) ? (gb[e >> 1] & 0xffff0000u) : (gb[e >> 1] << 16));
                        const float ratio = (1.0f + __expf(-bq)) * __builtin_amdgcn_rcpf(1.0f + __expf(-a));
                        acc[ai][bj][m][e >> 2][e & 3] *= ratio; }
                    __builtin_amdgcn_sched_barrier(0); }
            }
    }
    __device__ __forceinline__ void operator()(f32x4 (&acc)[2][2][4][2], const pg8::Unit& u, int wr, int wc, int fr, int fq) const {
        if (u.kh == 0) { mid(acc, u, wr, wc, fr, fq); return; }
        const int row0 = u.pm * 256 + wr * 64 + fr, col0 = u.pn * 256 + wc * 32 + 8 * fq;
#pragma unroll
        for (int ai = 0; ai < 2; ++ai)
#pragma unroll
            for (int m = 0; m < 4; ++m) { const int row = row0 + ai * 128 + m * 16; const bf16_t* rowp = P + (size_t)row * NP + col0;
#pragma unroll
                for (int bj = 0; bj < 2; ++bj) { const u32x4 gb = *(const u32x4*)(rowp + C_GB + bj * 128);
                    float o[8];
#pragma unroll
                    for (int e = 0; e < 8; ++e) { const float bq = __uint_as_float((e & 1) ? (gb[e >> 1] & 0xffff0000u) : (gb[e >> 1] << 16));
                        o[e] = acc[ai][bj][m][e >> 2][e & 3] * sigmoidf_(bq); }
                    u32x4 ov; ov[0] = pg8::cvt_pk_bf16(o[0], o[1]); ov[1] = pg8::cvt_pk_bf16(o[2], o[3]); ov[2] = pg8::cvt_pk_bf16(o[4], o[5]); ov[3] = pg8::cvt_pk_bf16(o[6], o[7]);
                    *(u32x4*)(MG + (size_t)row * DM + col0 + bj * 128) = ov; }
            }
    }
};
struct EpiX {
    static constexpr bool PERM = false, AFTER_DRAIN = false, CHAIN = false;
    const float* x0a; const float* x0b; const float* x1; const float* gate; float* out;
    __device__ __forceinline__ void operator()(f32x4 (&acc)[2][2][4][2], const pg8::Unit& u, int wr, int wc, int fr, int fq) const {
        const int row0 = u.pm * 256 + wr * 64 + fr, col0 = u.pn * 256 + wc * 32 + 4 * fq;
#pragma unroll
        for (int ai = 0; ai < 2; ++ai)
#pragma unroll
            for (int m = 0; m < 4; ++m) { const int row = row0 + ai * 128 + m * 16;
                const float* xr = x1 ? x1 + (size_t)row * DM : (row < NCTX ? x0a + (size_t)row * DM : x0b + (size_t)(row - NCTX) * DM);
                const float* gr = gate + (size_t)cvec_of(row) * 6144;
#pragma unroll
                for (int bj = 0; bj < 2; ++bj)
#pragma unroll
                    for (int n = 0; n < 2; ++n) { const int col = col0 + bj * 128 + n * 16;
                        const f32x4 xv = *(const f32x4*)(xr + col), gv = *(const f32x4*)(gr + col);
                        *(f32x4*)(out + (size_t)row * DM + col) = xv + gv * acc[ai][bj][m][n]; }
            }
    }
};

template <int T>
__device__ __forceinline__ void conv_line(const bf16_t* __restrict__ P, bf16_t* __restrict__ Y, int base, int stride, int L, int p0, int ch, const float* __restrict__ w, const float* __restrict__ cb) {
    f32x2_t ua[T + 30];
#pragma unroll
    for (int i = 0; i < T + 30; ++i) { const int pos = p0 - 15 + i; f32x2_t v = {0.f, 0.f};
        if (pos >= 0 && pos < L) { const bf16_t* pr = P + (size_t)(base + pos * stride) * NP + ch; const unsigned a = *(const unsigned*)(pr + C_AVAL), g = *(const unsigned*)(pr + C_AGLU);
            v[0] = __uint_as_float(a << 16) * sigmoidf_(__uint_as_float(g << 16)); v[1] = __uint_as_float(a & 0xffff0000u) * sigmoidf_(__uint_as_float(g & 0xffff0000u)); }
        ua[i] = v; }
    f32x2_t wk[31];
#pragma unroll
    for (int k = 0; k < 31; ++k) wk[k] = *(const f32x2_t*)(w + k * 1024 + ch);
    const f32x2_t bias = *(const f32x2_t*)(cb + ch);
#pragma unroll
    for (int j = 0; j < T; ++j) { f32x2_t a = bias;
#pragma unroll
        for (int k = 0; k < 31; ++k) a += wk[k] * ua[j + k];
        *(unsigned*)(Y + (size_t)(base + (p0 + j) * stride) * 1024 + ch) = pk2(a[0], a[1]); }
}

__device__ __forceinline__ void split8(const float* p, bf16x8& hi, bf16x8& lo) {
    const f32x4 a = *(const f32x4*)p, b2 = *(const f32x4*)(p + 4);
    u32x4 h, l2;
    h[0] = pk2(a[0], a[1]); h[1] = pk2(a[2], a[3]); h[2] = pk2(b2[0], b2[1]); h[3] = pk2(b2[2], b2[3]);
    l2[0] = pk2(a[0] - __uint_as_float(h[0] << 16), a[1] - __uint_as_float(h[0] & 0xffff0000u));
    l2[1] = pk2(a[2] - __uint_as_float(h[1] << 16), a[3] - __uint_as_float(h[1] & 0xffff0000u));
    l2[2] = pk2(b2[0] - __uint_as_float(h[2] << 16), b2[1] - __uint_as_float(h[2] & 0xffff0000u));
    l2[3] = pk2(b2[2] - __uint_as_float(h[3] << 16), b2[3] - __uint_as_float(h[3] & 0xffff0000u));
    hi = __builtin_bit_cast(bf16x8, h); lo = __builtin_bit_cast(bf16x8, l2);
}
__device__ __forceinline__ void dn_precompute(const Params& p, int l, int gc, int h, float* lds) {
    const int tid = opaque_tid(), lane = tid & 63, wid = tid >> 6;
    float* qs = lds;
    float* ks = lds + 8448;
    float* vs = lds + 2 * 8448;
    float* Gm = lds + 3 * 8448;
    float* QKm = Gm + 4160;
    float* betaS = QKm + 4160;
    float* gcS = betaS + 128;
    float* wscS = gcS + 128;
    const bf16_t* P = (const bf16_t*)(pws(p) + WS_P);
    const float* BA = (const float*)(pws(p) + WS_BA);
    int n, nc; if (gc < 64) { n = gc & 3; nc = 4; } else { n = (gc - 64) & 15; nc = 16; }
    const int tok0 = gc * 64;
    const float* cw = pin(p, 14) + (size_t)l * 3 * 3072;
    if (tid < 384) { const int cg = tid % 48, run = tid / 48, which = cg >> 4, d0 = (cg & 15) * 8;
        const int wch = which * 1024 + h * 128 + d0;
        const bf16_t* pc = P + (long)(tok0 + run * 8 - 1) * NP + C_Q + wch;
        u32x4 rows[10];
#pragma unroll
        for (int r = 0; r < 10; ++r) { const int t = run * 8 - 1 + r; const bool valid = (t >= 0 || n > 0) && (t < 64 || n < nc - 1);
            rows[r] = valid ? *(const u32x4*)(pc + (long)r * NP) : (u32x4){0u, 0u, 0u, 0u}; }
        f32x4 w[3][2];
#pragma unroll
        for (int j = 0; j < 3; ++j) { w[j][0] = *(const f32x4*)(cw + j * 3072 + wch); w[j][1] = *(const f32x4*)(cw + j * 3072 + wch + 4); }
        float* dst = (which == 0 ? qs : (which == 1 ? ks : vs)) + d0;
#pragma unroll
        for (int o = 0; o < 8; ++o) { f32x4 r2[2];
#pragma unroll
            for (int e = 0; e < 8; ++e) { const unsigned a = rows[o][e >> 1], bq = rows[o + 1][e >> 1], cq = rows[o + 2][e >> 1];
                const float xm = __uint_as_float((e & 1) ? (a & 0xffff0000u) : (a << 16)), x0 = __uint_as_float((e & 1) ? (bq & 0xffff0000u) : (bq << 16)), xp = __uint_as_float((e & 1) ? (cq & 0xffff0000u) : (cq << 16));
                r2[e >> 2][e & 3] = siluf_(w[0][e >> 2][e & 3] * xm + w[1][e >> 2][e & 3] * x0 + w[2][e >> 2][e & 3] * xp); }
            *(f32x4*)(dst + (run * 8 + o) * 132) = r2[0]; *(f32x4*)(dst + (run * 8 + o) * 132 + 4) = r2[1]; }
    }
    if (tid < 128) { const int dir = tid >> 6, i = tid & 63, tl = dir ? 63 - i : i;
        const float* ba = BA + (size_t)(tok0 + tl) * 32;
        const float bl = ba[dir * 8 + h], al = ba[16 + dir * 8 + h];
        const float xx = al + pin(p, 16)[(l * 2 + dir) * 8 + h];
        const float sp = xx > 20.f ? xx : log1pf(__expf(xx));
        float g = -__expf(pin(p, 15)[(l * 2 + dir) * 8 + h]) * sp;
#pragma unroll
        for (int o = 1; o < 64; o <<= 1) { const float t2 = __shfl_up(g, o); if (i >= o) g += t2; }
        const float bt = sigmoidf_(bl); betaS[dir * 64 + i] = bt; gcS[dir * 64 + i] = g; wscS[dir * 64 + i] = bt * __expf(g); }
    __syncthreads();
    { float a[16], b2[16], ss[16];
#pragma unroll
        for (int k = 0; k < 16; ++k) { const int r = wid + 8 * k; const float* row = (r < 64 ? qs + r * 132 : ks + (r - 64) * 132); a[k] = row[lane]; b2[k] = row[lane + 64]; ss[k] = a[k] * a[k] + b2[k] * b2[k]; }
#pragma unroll
        for (int o = 32; o > 0; o >>= 1) {
#pragma unroll
            for (int k = 0; k < 16; ++k) ss[k] += __shfl_xor(ss[k], o); }
#pragma unroll
        for (int k = 0; k < 16; ++k) { const int r = wid + 8 * k; float* row = (r < 64 ? qs + r * 132 : ks + (r - 64) * 132);
            const float sc = rsqrtf(ss[k] + EPS) * (r < 64 ? 0.08838834764831845f : 1.0f); row[lane] = a[k] * sc; row[lane + 64] = b2[k] * sc; } }
    __syncthreads();
    for (int rg = 0; rg < REP_GRAM; ++rg) { const int mat = wid >> 2, ti = wid & 3, r = lane & 15, q4 = lane >> 4;
        const float* Ar = mat ? qs : ks;
        bf16x8 Ahi[4], Alo[4];
#pragma unroll
        for (int k4 = 0; k4 < 4; ++k4) split8(Ar + (16 * ti + r) * 132 + 32 * k4 + 8 * q4, Ahi[k4], Alo[k4]);
        float* M = mat ? QKm : Gm;
#pragma unroll
        for (int tj = 0; tj < 4; ++tj) { f32x4 acc = (f32x4){0.f, 0.f, 0.f, 0.f};
#pragma unroll
            for (int k4 = 0; k4 < 4; ++k4) { bf16x8 Bhi, Blo; split8(ks + (16 * tj + r) * 132 + 32 * k4 + 8 * q4, Bhi, Blo);
                acc = __builtin_amdgcn_mfma_f32_16x16x32_bf16(Ahi[k4], Bhi, acc, 0, 0, 0);
                acc = __builtin_amdgcn_mfma_f32_16x16x32_bf16(Ahi[k4], Blo, acc, 0, 0, 0);
                acc = __builtin_amdgcn_mfma_f32_16x16x32_bf16(Alo[k4], Bhi, acc, 0, 0, 0); }
#pragma unroll
            for (int j = 0; j < 4; ++j) M[(16 * ti + 4 * q4 + j) * 65 + 16 * tj + r] = acc[j]; } }
    __syncthreads();
    const int dir = tid >> 8, tl = tid & 255;
    unsigned char* rec = pws(p) + WS_DN + (size_t)((gc * 8 + h) * 2 + dir) * DN_REC;
    const float* gcd = gcS + dir * 64; const float* btd = betaS + dir * 64;
    const float gl = gcd[63];
    { bf16_t* qd = (bf16_t*)(rec + DN_QDEC);
        for (int e = tl; e < 64 * 64; e += 256) { const int i = e >> 6, d2 = (e & 63) * 2; const int t = dir ? 63 - i : i; const float eg = __expf(gcd[i]);
            *(unsigned*)(qd + i * 128 + d2) = pk2(qs[t * 132 + d2] * eg, qs[t * 132 + d2 + 1] * eg); } }
    __syncthreads();
    float* Am = qs + dir * 4096;
    for (int e = tl; e < 4096; e += 256) { const int j = e >> 6, i = e & 63; const int ti = dir ? 63 - i : i, tj = dir ? 63 - j : j;
        Am[e] = j < i ? btd[i] * Gm[ti * 65 + tj] * __expf(gcd[i] - gcd[j]) : 0.f; }
    __syncthreads();
    if (tl >= 64) { const int t2 = tl - 64;
        bf16_t* kd = (bf16_t*)(rec + DN_KDT);
        for (int e = t2; e < 128 * 32; e += 192) { const int dk = e >> 5, j2 = (e & 31) * 2; const int t0 = dir ? 63 - j2 : j2, t1 = dir ? 62 - j2 : j2 + 1;
            *(unsigned*)(kd + dk * 64 + j2) = pk2(ks[t0 * 132 + dk] * __expf(gl - gcd[j2]), ks[t1 * 132 + dk] * __expf(gl - gcd[j2 + 1])); }
        bf16_t* qk = (bf16_t*)(rec + DN_QKM);
        for (int e = t2; e < 64 * 32; e += 192) { const int i = e >> 5, j2 = (e & 31) * 2; const int ti = dir ? 63 - i : i, t0 = dir ? 63 - j2 : j2, t1 = dir ? 62 - j2 : j2 + 1;
            const float v0 = j2 <= i ? QKm[ti * 65 + t0] * __expf(gcd[i] - gcd[j2]) : 0.f;
            const float v1 = j2 + 1 <= i ? QKm[ti * 65 + t1] * __expf(gcd[i] - gcd[j2 + 1]) : 0.f;
            *(unsigned*)(qk + i * 64 + j2) = pk2(v0, v1); }
        if (t2 == 0) *(float*)(rec + DN_EGL) = __expf(gl);
    }
    float* Tm = Am;
    if (tl < 64) { const int c = tl;
        f32x2_t U2[32];
#pragma unroll
        for (int i = 0; i < 64; ++i) U2[i >> 1][i & 1] = (i == c) ? 1.f : 0.f;
        f32x4 av[2][16];
#pragma unroll
        for (int i4 = 0; i4 < 16; ++i4) av[0][i4] = *(const f32x4*)(Am + i4 * 4);
        __builtin_amdgcn_sched_barrier(0);
#pragma unroll
        for (int j = 0; j < 63; ++j) {
            if (j + 1 < 63) {
#pragma unroll
                for (int i4 = (j + 2) / 4; i4 < 16; ++i4) av[(j + 1) & 1][i4] = *(const f32x4*)(Am + (j + 1) * 64 + i4 * 4); }
            const float uj = U2[j >> 1][j & 1]; const f32x2_t ujj = {uj, uj};
#pragma unroll
            for (int pr = (j + 1) / 2; pr < 32; ++pr) { const f32x4 a4 = av[j & 1][pr >> 1]; const f32x2_t a2 = (pr & 1) ? (f32x2_t){a4[2], a4[3]} : (f32x2_t){a4[0], a4[1]};
                if (2 * pr > j) U2[pr] = U2[pr] - a2 * ujj; else U2[pr][1] -= a2[1] * uj; }
            __builtin_amdgcn_sched_barrier(0); }
#pragma unroll
        for (int i = 0; i < 64; ++i) Tm[i * 64 + c] = U2[i >> 1][i & 1];
    }
    __syncthreads();
    { const int wq = wid & 3, r = lane & 15, kg = lane >> 4; const bool isu = wq < 2;
        int rstep = dir ? -132 : 132; asm volatile("" : "+v"(rstep));
        const float* src = (isu ? vs + wq * 64 : ks + (wq - 2) * 64) + (dir ? 63 * 132 : 0) + r;
        const float* scl = isu ? btd : wscS + dir * 64;
        bf16x8 Ahi[4][2], Alo[4][2];
#pragma unroll
        for (int m = 0; m < 4; ++m)
#pragma unroll
            for (int kx = 0; kx < 2; ++kx) split8(Tm + (16 * m + r) * 64 + 32 * kx + 8 * kg, Ahi[m][kx], Alo[m][kx]);
        float* ut = (float*)(rec + DN_UT); bf16_t* nw = (bf16_t*)(rec + DN_NEGW);
#pragma unroll
        for (int nt = 0; nt < 4; ++nt) { bf16x8 Bf[2];
#pragma unroll
            for (int kx = 0; kx < 2; ++kx) { const int j0 = 32 * kx + 8 * kg; const f32x4 s0 = *(const f32x4*)(scl + j0), s1 = *(const f32x4*)(scl + j0 + 4);
                u32x4 o;
#pragma unroll
                for (int e2 = 0; e2 < 4; ++e2) { const float x0 = src[(j0 + 2 * e2) * rstep + 16 * nt] * (e2 < 2 ? s0[2 * e2] : s1[2 * e2 - 4]), x1 = src[(j0 + 2 * e2 + 1) * rstep + 16 * nt] * (e2 < 2 ? s0[2 * e2 + 1] : s1[2 * e2 - 3]);
                    o[e2] = pk2(x0, x1); }
                Bf[kx] = __builtin_bit_cast(bf16x8, o); }
#pragma unroll
            for (int m = 0; m < 4; ++m) { f32x4 acc = (f32x4){0.f, 0.f, 0.f, 0.f};
#pragma unroll
                for (int kx = 0; kx < 2; ++kx) { acc = __builtin_amdgcn_mfma_f32_16x16x32_bf16(Ahi[m][kx], Bf[kx], acc, 0, 0, 0); acc = __builtin_amdgcn_mfma_f32_16x16x32_bf16(Alo[m][kx], Bf[kx], acc, 0, 0, 0); }
                const int i0 = 16 * m + 4 * kg, cc = 16 * nt + r;
                if (isu) { u32x2 o2; o2[0] = pk2(acc[0], acc[1]); o2[1] = pk2(acc[2], acc[3]); *(u32x2*)((bf16_t*)ut + (wq * 64 + cc) * 64 + i0) = o2; }
                else {
#pragma unroll
                    for (int jj = 0; jj < 4; ++jj) nw[(i0 + jj) * 128 + (wq - 2) * 64 + cc] = (bf16_t)f2bf(-acc[jj]); } }
        }
    }
    __syncthreads();
}

__device__ __forceinline__ void pc_phase(const Params& p, int l, float* lds) {
    const int tid = opaque_tid();
    const bf16_t* P = (const bf16_t*)(pws(p) + WS_P);
    bf16_t* Y = (bf16_t*)(pws(p) + WS_Y);
    const float* cw = pin(p, 9) + (size_t)l * 31 * 1024;
    const float* cb = pin(p, 10) + l * 1024;
    const bool g256 = (int)gridDim.x == 256;
    for (int kk = 0;; ++kk) {
        int it = (int)blockIdx.x + kk * (int)gridDim.x;
        if (g256 && kk == 5) it = (int)blockIdx.x >= 192 ? 1280 + (int)blockIdx.x - 192 : (1 << 30);
        if (it >= 1024 + 320) break;
#ifndef NO_DN
        if (it < 1024) { for (int rd = 0; rd < REP_DN; ++rd) dn_precompute(p, l, it >> 3, it & 7, lds); continue; }
#endif
#ifndef NO_CONV
        for (int rcv = 0; rcv < REP_CONV; ++rcv) {
        int r = it - 1024;
        int tl = opaque_tid();
        if (r < 192) { int base, L, p0, ch;
            if (r < 128) { const int tile = r & 7, bb = r >> 3; ch = 2 * tl; base = bb * 256; L = 256; p0 = tile * 32; }
            else { r -= 128; const int row = r & 15, bb = r >> 4; ch = 2 * (tl & 255); base = NCTX + bb * 1024 + row * 64; L = 64; p0 = (tl >> 8) * 32; }
            int st = 1; asm volatile("" : "+s"(st));
            conv_line<32>(P, Y, base, st, L, p0, ch, cw, cb);
        } else {
            r -= 192; const int col = 2 * (r & 31) + (tl >> 8), bb = r >> 5; const int ch = 512 + 2 * (tl & 255);
            int st = 64; asm volatile("" : "+s"(st));
            conv_line<16>(P, Y, NCTX + bb * 1024 + col, st, 16, 0, ch, cw, cb);
        }
        }
#endif
    }
}

__device__ __forceinline__ bf16x8 pack8(const f32x4& a, const f32x4& b) {
    u32x4 r; r[0] = pk2(a[0], a[1]); r[1] = pk2(a[2], a[3]); r[2] = pk2(b[0], b[1]); r[3] = pk2(b[2], b[3]);
    return __builtin_bit_cast(bf16x8, r);
}
__device__ __forceinline__ bf16x8 lds_afrag(const unsigned char* base) {
    const u32x2 lo = *(const u32x2*)base, hi = *(const u32x2*)(base + 32);
    u32x4 r; r[0] = lo[0]; r[1] = lo[1]; r[2] = hi[0]; r[3] = hi[1];
    return __builtin_bit_cast(bf16x8, r);
}
#define MFMA16(a, b, c) __builtin_amdgcn_mfma_f32_16x16x32_bf16((a), (b), (c), 0, 0, 0)

#define SCAN_IMG 67584
__device__ __forceinline__ const unsigned char* dn_rec(const Params& p, int gc, int h, int dir) { return pws(p) + WS_DN + (size_t)((gc * 8 + h) * 2 + dir) * DN_REC; }
__device__ __forceinline__ void scan_item(const Params& p, int l, int sq, int h, int dir, unsigned char* lds) {
    const int tid = opaque_tid(), lane = tid & 63, wid = tid >> 6, c = lane & 15, q = lane >> 4;
    const bool ctx = sq < 16;
    const int nc = ctx ? 4 : 16, gc0 = ctx ? sq * 4 : 64 + (sq - 16) * 16;
#define SCAN_GC(s_) (gc0 + (dir ? nc - 1 - (s_) : (s_)))
    if (wid >= 4) {
        const int tl = tid - 256;
        u32x4 Ra[14], Rb[14];
#define SCAN_LOAD(R_, s_) do { const unsigned char* r_ = dn_rec(p, SCAN_GC((s_) < nc ? (s_) : nc - 1), h, dir); _Pragma("unroll") for (int k = 0; k < 14; ++k) R_[k] = *(const u32x4*)(r_ + (size_t)(tl + 256 * k) * 16); } while (0)
#define SCAN_WRITE(R_, buf_) do { unsigned char* b_ = lds + (buf_) * SCAN_IMG; _Pragma("unroll") for (int k = 0; k < 14; ++k) { const int ch = tl + 256 * k; unsigned char* dst; \
            if (k < 4) dst = b_ + (ch >> 4) * 288 + (ch & 15) * 16; \
            else if (k < 8) { const int x = ch - 1024; dst = b_ + 18432 + (x >> 4) * 288 + (x & 15) * 16; } \
            else if (k < 12) { const int x = ch - 2048; dst = b_ + 36864 + (x >> 3) * 160 + (x & 7) * 16; } \
            else { const int x = ch - 3072; dst = b_ + 57344 + (x >> 3) * 160 + (x & 7) * 16; } \
            *(u32x4*)dst = R_[k]; } } while (0)
        SCAN_LOAD(Ra, 0); SCAN_LOAD(Rb, 1);
        SCAN_WRITE(Ra, 0);
        __syncthreads();
        for (int s = 0; s < nc; s += 2) {
            SCAN_LOAD(Ra, s + 2);
            SCAN_WRITE(Rb, 1);
            __syncthreads();
            SCAN_LOAD(Rb, s + 3);
            SCAN_WRITE(Ra, 0);
            __syncthreads();
        }
#undef SCAN_LOAD
#undef SCAN_WRITE
    } else {
        const int dv0 = wid * 32;
        bf16_t* O = (bf16_t*)(pws(p) + WS_R1) + (size_t)dir * NTOK * 1024;
        f32x4 S[2][8];
#pragma unroll
        for (int t = 0; t < 2; ++t)
#pragma unroll
            for (int m = 0; m < 8; ++m) S[t][m] = (f32x4){0.f, 0.f, 0.f, 0.f};
        if (!ctx) { const float* sd = pin(p, 2) + ((size_t)(((sq - 16) * 2 + l) * 2 + dir) * 8 + h) * 16384;
#pragma unroll
            for (int t = 0; t < 2; ++t)
#pragma unroll
                for (int m = 0; m < 8; ++m)
#pragma unroll
                    for (int j = 0; j < 4; ++j) S[t][m][j] = sd[(16 * m + 4 * q + j) * 128 + dv0 + 16 * t + c]; }
        u32x2 utn[2][4]; float egl;
        { const unsigned char* rec0 = dn_rec(p, SCAN_GC(0), h, dir);
#pragma unroll
            for (int t = 0; t < 2; ++t)
#pragma unroll
                for (int m = 0; m < 4; ++m) utn[t][m] = *(const u32x2*)((const bf16_t*)(rec0 + DN_UT) + (dv0 + 16 * t + c) * 64 + 16 * m + 4 * q);
            egl = *(const float*)(rec0 + DN_EGL); }
        __syncthreads();
        for (int s = 0; s < nc; ++s) {
            const int gc = SCAN_GC(s);
            const unsigned char* recn = dn_rec(p, SCAN_GC(s + 1 < nc ? s + 1 : s), h, dir);
            const unsigned char* L_negw = lds + (s & 1) * SCAN_IMG;
            const unsigned char* L_qdec = L_negw + 18432;
            const unsigned char* L_kdt = L_negw + 36864;
            const unsigned char* L_qkm = L_negw + 57344;
            f32x4 vn[2][4];
#pragma unroll
            for (int t = 0; t < 2; ++t)
#pragma unroll
                for (int m = 0; m < 4; ++m) vn[t][m] = bf4_to_f32(utn[t][m]);
            bf16x8 Bs[2][4];
#pragma unroll
            for (int t = 0; t < 2; ++t)
#pragma unroll
                for (int kb = 0; kb < 4; ++kb) Bs[t][kb] = pack8(S[t][2 * kb], S[t][2 * kb + 1]);
            const unsigned char* aN = L_negw + c * 288 + 8 * q;
            const unsigned char* aQ = L_qdec + c * 288 + 8 * q;
            const unsigned char* aM = L_qkm + c * 160 + 8 * q;
            const unsigned char* aK = L_kdt + c * 160 + 8 * q;
#define SB_ __builtin_amdgcn_sched_barrier(0)
#define LD_N(F, m) do { _Pragma("unroll") for (int kb = 0; kb < 4; ++kb) F[kb] = lds_afrag(aN + (m) * 16 * 288 + 64 * kb); } while (0)
#define LD_Q(F, m) do { _Pragma("unroll") for (int kb = 0; kb < 4; ++kb) F[kb] = lds_afrag(aQ + (m) * 16 * 288 + 64 * kb); } while (0)
#define LD_M(F, m) do { _Pragma("unroll") for (int kb = 0; kb < 2; ++kb) F[kb] = lds_afrag(aM + (m) * 16 * 160 + 64 * kb); } while (0)
#define LD_K(F, m2) do { _Pragma("unroll") for (int mm = 0; mm < 2; ++mm) _Pragma("unroll") for (int kb = 0; kb < 2; ++kb) F[mm * 2 + kb] = lds_afrag(aK + (2 * (m2) + mm) * 16 * 160 + 64 * kb); } while (0)
#define MF_N(F, m) do { _Pragma("unroll") for (int kb = 0; kb < 4; ++kb) { vn[0][m] = MFMA16(F[kb], Bs[0][kb], vn[0][m]); vn[1][m] = MFMA16(F[kb], Bs[1][kb], vn[1][m]); } } while (0)
#define MF_Q(F, m) do { oa0 = (f32x4){0.f, 0.f, 0.f, 0.f}; oa1 = oa0; \
            _Pragma("unroll") for (int kb = 0; kb < 4; ++kb) { oa0 = MFMA16(F[kb], Bs[0][kb], oa0); oa1 = MFMA16(F[kb], Bs[1][kb], oa1); } } while (0)
#define MF_M(F, m) do { f32x4 a0 = oa0, a1 = oa1; \
            _Pragma("unroll") for (int kb = 0; kb < 2; ++kb) { a0 = MFMA16(F[kb], Bv[0][kb], a0); a1 = MFMA16(F[kb], Bv[1][kb], a1); } \
            _Pragma("unroll") for (int j = 0; j < 4; ++j) { const int i = 16 * (m) + 4 * q + j; const int tok = gc * 64 + (dir ? 63 - i : i); \
                bf16_t* op = O + (size_t)tok * 1024 + h * 128 + dv0 + c; op[0] = (bf16_t)f2bf(a0[j]); op[16] = (bf16_t)f2bf(a1[j]); } } while (0)
#define MF_K(F, m2) do { _Pragma("unroll") for (int mm = 0; mm < 2; ++mm) { f32x4 a0 = S[0][2 * (m2) + mm] * egl, a1 = S[1][2 * (m2) + mm] * egl; \
            _Pragma("unroll") for (int kb = 0; kb < 2; ++kb) { a0 = MFMA16(F[mm * 2 + kb], Bv[0][kb], a0); a1 = MFMA16(F[mm * 2 + kb], Bv[1][kb], a1); } \
            S[0][2 * (m2) + mm] = a0; S[1][2 * (m2) + mm] = a1; } } while (0)
            bf16x8 X[4], Y[4]; f32x4 oa0, oa1;
            LD_N(X, 0); SB_;
            LD_N(Y, 1); SB_; MF_N(X, 0); SB_;
            LD_N(X, 2); SB_; MF_N(Y, 1); SB_;
            LD_N(Y, 3); SB_; MF_N(X, 2); SB_;
            LD_Q(X, 0); SB_; MF_N(Y, 3); SB_;
            bf16x8 Bv[2][2];
#pragma unroll
            for (int t = 0; t < 2; ++t)
#pragma unroll
                for (int kb = 0; kb < 2; ++kb) Bv[t][kb] = pack8(vn[t][2 * kb], vn[t][2 * kb + 1]);
#pragma unroll
            for (int t = 0; t < 2; ++t)
#pragma unroll
                for (int m = 0; m < 4; ++m) utn[t][m] = *(const u32x2*)((const bf16_t*)(recn + DN_UT) + (dv0 + 16 * t + c) * 64 + 16 * m + 4 * q);
            SB_;
            LD_M(Y, 0); SB_; MF_Q(X, 0); SB_;
            LD_Q(X, 1); SB_; MF_M(Y, 0); SB_;
            LD_M(Y, 1); SB_; MF_Q(X, 1); SB_;
            LD_Q(X, 2); SB_; MF_M(Y, 1); SB_;
            LD_M(Y, 2); SB_; MF_Q(X, 2); SB_;
            LD_Q(X, 3); SB_; MF_M(Y, 2); SB_;
            LD_M(Y, 3); SB_; MF_Q(X, 3); SB_;
            LD_K(X, 0); SB_; MF_M(Y, 3); SB_;
            LD_K(Y, 1); SB_; MF_K(X, 0); SB_;
            LD_K(X, 2); SB_; MF_K(Y, 1); SB_;
            LD_K(Y, 3); SB_; MF_K(X, 2); SB_;
            MF_K(Y, 3);
#undef SB_
#undef LD_N
#undef LD_Q
#undef LD_M
#undef LD_K
#undef MF_N
#undef MF_Q
#undef MF_M
#undef MF_K
            egl = *(const float*)(recn + DN_EGL);
            __syncthreads();
        }
        if (ctx) { float* so = pout(p) + (size_t)NTOK * DM + ((size_t)((sq * 2 + l) * 2 + dir) * 8 + h) * 16384;
#pragma unroll
            for (int t = 0; t < 2; ++t)
#pragma unroll
                for (int m = 0; m < 8; ++m)
#pragma unroll
                    for (int j = 0; j < 4; ++j) so[(16 * m + 4 * q + j) * 128 + dv0 + 16 * t + c] = S[t][m][j]; }
    }
#undef SCAN_GC
}

__device__ __forceinline__ void lna_group(const Params& p, int l, int grp) {
    const int tid = opaque_tid(), lane = tid & 63, wid = tid >> 6;
    const int tok = grp * 8 + wid;
    const bf16_t* y = (const bf16_t*)(pws(p) + WS_Y) + (size_t)tok * 1024;
    const bf16_t* az = (const bf16_t*)(pws(p) + WS_P) + (size_t)tok * NP + C_AZ;
    bf16_t* U = (bf16_t*)(pws(p) + WS_U) + (size_t)tok * 2048;
    const float* lg = pin(p, 11) + l * 1024; const float* lb = pin(p, 12) + l * 1024;
    f32x4 v[4]; float s = 0.f;
#pragma unroll
    for (int i = 0; i < 4; ++i) { v[i] = bf4_to_f32(*(const u32x2*)(y + (lane + 64 * i) * 4)); s += v[i][0] + v[i][1] + v[i][2] + v[i][3]; }
    const float mu = wave_sum(s) * (1.0f / 1024.0f);
    float s2 = 0.f;
#pragma unroll
    for (int i = 0; i < 4; ++i) { v[i] -= mu; s2 += v[i][0] * v[i][0] + v[i][1] * v[i][1] + v[i][2] * v[i][2] + v[i][3] * v[i][3]; }
    const float rstd = rsqrtf(wave_sum(s2) * (1.0f / 1024.0f) + EPS);
#pragma unroll
    for (int i = 0; i < 4; ++i) { const int cc = (lane + 64 * i) * 4; const f32x4 g = *(const f32x4*)(lg + cc), bb = *(const f32x4*)(lb + cc);
        const u32x2 zz = *(const u32x2*)(az + cc);
        f32x4 o = v[i] * rstd * g + bb;
        const float z0 = __uint_as_float(zz[0] << 16), z1 = __uint_as_float(zz[0] & 0xffff0000u), z2 = __uint_as_float(zz[1] << 16), z3 = __uint_as_float(zz[1] & 0xffff0000u);
        u32x2 ov; ov[0] = pk2(siluf_(o[0]) * siluf_(z0), siluf_(o[1]) * siluf_(z1)); ov[1] = pk2(siluf_(o[2]) * siluf_(z2), siluf_(o[3]) * siluf_(z3));
        *(u32x2*)(U + cc) = ov; }
}

__device__ __forceinline__ void ps_phase(const Params& p, int l, unsigned char* lds) {
    const int b = blockIdx.x, G = gridDim.x;
    for (int r = 0;; ++r) { const int id = r * G + (r == 0 ? b : (b + 64 * G - 64) % G); if (id >= 320) break;
        const int sq = id < 64 ? 16 + (id >> 4) : ((id - 64) >> 4);
        for (int rsc = 0; rsc < REP_SCAN; ++rsc) scan_item(p, l, sq, (id >> 1) & 7, id & 1, lds); }
    const int gs = G == 256 ? (b >= 64 ? b - 64 : 1024) : b, gst = G == 256 ? 192 : G;
    for (int rl = 0; rl < REP_LNA; ++rl) for (int g = gs; g < 1024; g += gst) lna_group(p, l, g);
    if (l == 0) drain_tiles(p, 1 << 20, lds);
}

__device__ __forceinline__ void pnb_phase(const Params& p, int l) {
    const int tid = opaque_tid(), lane = tid & 63, wid = tid >> 6;
    const bf16_t* Of = (const bf16_t*)(pws(p) + WS_R1); const bf16_t* Ob = Of + (size_t)NTOK * 1024;
    const float* hg = pin(p, 17) + l * 128;
    for (int tok = blockIdx.x * 8 + wid; tok < NTOK; tok += gridDim.x * 8) {
        const int cb = lane * 16;
        f32x4 v[4]; float ss = 0.f;
#pragma unroll
        for (int i = 0; i < 4; ++i) { v[i] = bf4_to_f32(*(const u32x2*)(Of + (size_t)tok * 1024 + cb + 4 * i)) + bf4_to_f32(*(const u32x2*)(Ob + (size_t)tok * 1024 + cb + 4 * i));
            ss += v[i][0] * v[i][0] + v[i][1] * v[i][1] + v[i][2] * v[i][2] + v[i][3] * v[i][3]; }
        ss += __shfl_xor(ss, 1); ss += __shfl_xor(ss, 2); ss += __shfl_xor(ss, 4);
        const float rstd = rsqrtf(ss * (1.0f / 128.0f) + EPS);
        const bf16_t* zb = (const bf16_t*)(pws(p) + WS_P) + (size_t)tok * NP + C_ZB + cb;
        bf16_t* U = (bf16_t*)(pws(p) + WS_U) + (size_t)tok * 2048 + 1024 + cb;
        const u32x4 z0 = *(const u32x4*)zb, z1 = *(const u32x4*)(zb + 8);
        float o[16];
#pragma unroll
        for (int i = 0; i < 4; ++i) { const f32x4 g = *(const f32x4*)(hg + ((cb + 4 * i) & 127));
#pragma unroll
            for (int e = 0; e < 4; ++e) o[4 * i + e] = v[i][e] * rstd * g[e]; }
        u32x4 r0, r1;
#pragma unroll
        for (int w2 = 0; w2 < 4; ++w2) { const unsigned za = z0[w2], zc = z1[w2];
            r0[w2] = pk2(o[2 * w2] * siluf_(__uint_as_float(za << 16)), o[2 * w2 + 1] * siluf_(__uint_as_float(za & 0xffff0000u)));
            r1[w2] = pk2(o[8 + 2 * w2] * siluf_(__uint_as_float(zc << 16)), o[8 + 2 * w2 + 1] * siluf_(__uint_as_float(zc & 0xffff0000u))); }
        *(u32x4*)U = r0; *(u32x4*)(U + 8) = r1;
    }
}

#define XB_TMO      128
#define XB_XCNT(j)  (256  + 64 * (j))
#define XB_XSUB(j)  (1280 + 64 * (j))
#define XB_XGEN(j)  (2304 + 64 * (j))
#define XB_TOP      3328
#define XB_TOPGEN   3392
#define XCD_BAR_WORDS 3456
#define XB_SPIN_CAP (1u << 18)

__device__ __forceinline__ unsigned xb_ld(unsigned* p)              { return __hip_atomic_load(p, __ATOMIC_RELAXED, __HIP_MEMORY_SCOPE_AGENT); }
__device__ __forceinline__ unsigned xb_add(unsigned* p, unsigned v) { return __hip_atomic_fetch_add(p, v, __ATOMIC_RELAXED, __HIP_MEMORY_SCOPE_AGENT); }
__device__ __forceinline__ unsigned xb_xcc_id() { return (unsigned)__builtin_amdgcn_s_getreg((3 << 11) | 20) & 0xFu; }
#define XB_SPIN(cond, bar) do { unsigned _sp = 0; while (cond) { __builtin_amdgcn_s_sleep(1); \
    if ((++_sp & 255u) == 0u) { if (xb_ld(&(bar)[XB_TMO])) break; if (_sp > XB_SPIN_CAP) { atomicAdd(&(bar)[XB_TMO], 1u); break; } } } } while (0)

struct XcdBarrier {
    unsigned* bar; unsigned x;
    volatile LAS unsigned* st;
};

__device__ __forceinline__ XcdBarrier xcd_barrier_post(unsigned* bar, volatile LAS unsigned* st) {
    XcdBarrier b; b.bar = bar; b.x = xb_xcc_id(); b.st = st;
    if (threadIdx.x == 0) (void)xb_add(&bar[XB_XCNT(b.x)], 1u);
    return b;
}
__device__ __forceinline__ void xcd_barrier_complete(unsigned* bar, unsigned x, unsigned& nloc, unsigned& nx) {
    const unsigned G = gridDim.x * gridDim.y * gridDim.z;
    unsigned sum, cnt, mine, sp = 0u;
    for (;;) {
        sum = 0u; cnt = 0u; mine = 0u;
#pragma unroll
        for (unsigned j = 0; j < 16; ++j) { const unsigned c = xb_ld(&bar[XB_XCNT(j)]); sum += c; cnt += (c > 0u) ? 1u : 0u; mine = (j == x) ? c : mine; }
        if (sum == G) break;
        __builtin_amdgcn_s_sleep(1);
        if ((++sp & 255u) == 0u) { if (xb_ld(&bar[XB_TMO])) break; if (sp > XB_SPIN_CAP) { atomicAdd(&bar[XB_TMO], 1u); break; } }
    }
    nloc = mine > 0u ? mine : 1u; nx = cnt > 0u ? cnt : 1u;
}

__device__ __forceinline__ void xcd_barrier(const XcdBarrier& b) {
    asm volatile("s_waitcnt vmcnt(0)" ::: "memory");
    __syncthreads();
    if (threadIdx.x == 0) {
        unsigned* bar = b.bar;
        __builtin_amdgcn_s_waitcnt(0);
        unsigned nloc = b.st[0], nx = b.st[1];
        if (nloc == 0u) { xcd_barrier_complete(bar, b.x, nloc, nx); b.st[0] = nloc; b.st[1] = nx; }
        const unsigned old = xb_add(&bar[XB_XSUB(b.x)], 1u);
        const unsigned gen = old / nloc;
        if (old + 1u == (gen + 1u) * nloc) {
            __builtin_amdgcn_fence(__ATOMIC_RELEASE, "agent");
            asm volatile("s_waitcnt vmcnt(0)" ::: "memory");
            const unsigned og = xb_add(&bar[XB_TOP], 1u);
            const unsigned tg = og / nx;
            if (og + 1u == (tg + 1u) * nx) xb_add(&bar[XB_TOPGEN], 1u);
            else XB_SPIN(xb_ld(&bar[XB_TOPGEN]) == tg, bar);
            __builtin_amdgcn_fence(__ATOMIC_ACQUIRE, "agent");
            xb_add(&bar[XB_XGEN(b.x)], 1u);
            asm volatile("s_waitcnt vmcnt(0)" ::: "memory");
        } else {
            XB_SPIN(xb_ld(&bar[XB_XGEN(b.x)]) == gen, bar);
            __builtin_amdgcn_fence(__ATOMIC_ACQUIRE, "agent");
            asm volatile("s_waitcnt vmcnt(0)" ::: "memory");
        }
    }
    __syncthreads();
}

#ifndef REP0
#define REP0 1
#endif
#ifndef REP1
#define REP1 1
#endif
#ifndef REP2
#define REP2 1
#endif
#ifndef REP3
#define REP3 1
#endif
#ifndef REP4
#define REP4 1
#endif
#ifndef REP5
#define REP5 1
#endif
#ifndef REP6
#define REP6 1
#endif
#ifndef REP7
#define REP7 1
#endif
__global__ void __launch_bounds__(NTHR) fwd_megakernel(Params p) {
    extern __shared__ __attribute__((aligned(16))) unsigned char lds[];
    cg::grid_group grid = cg::this_grid();
    const int lo = p.ph_lo, hi = p.ph_hi;
    if (lo < 0) grid.sync();
    if (threadIdx.x < 2) ((volatile LAS unsigned*)((LAS unsigned char*)lds + LDS_BARST))[threadIdx.x] = 0u;
    __syncthreads();
    const XcdBarrier xbar = xcd_barrier_post((unsigned*)(pws(p) + WS_BARW), (volatile LAS unsigned*)((LAS unsigned char*)lds + LDS_BARST));
#define IN(k) (lo <= (k) && (k) < hi)
#ifndef SYNC_REP
#define SYNC_REP 1
#endif
#define SEAM(k) do { if (IN(k) && IN((k) + 1)) for (int sr = 0; sr < SYNC_REP; ++sr) { xcd_barrier(xbar); } } while (0)
#if (!defined(ONLY) || ONLY == 0) && !defined(SKIP0)
    if (IN(0)) for (int rp = 0; rp < REP0; ++rp) p0_prologue(p, (float*)lds);
#endif
    SEAM(0);
    for (int l = 0; l < 2; ++l) {
        const int pb = 1 + 7 * l;
        unsigned char* ws = pws(p);
#if (!defined(ONLY) || ONLY == 1) && !defined(SKIP1)
        if (IN(pb)) for (int rp = 0; rp < REP1; ++rp) pn_norm(p, l);
#endif
        SEAM(pb);
#if (!defined(ONLY) || ONLY == 2) && !defined(SKIP2)
        if (IN(pb + 1)) for (int rp = 0; rp < REP2; ++rp) {
            pg8::Gemm g{(const bf16_t*)(ws + WS_R1), (const bf16_t*)(ws + WS_WIN + l * SZ_WIN1), NTOK, NP, DM, DM};
            pg8::StaticOrder S; S.init(NTOK, NP, (int)gridDim.x, (int)blockIdx.x);
            EpiP E{(bf16_t*)(ws + WS_P), (float*)(ws + WS_BA)};
            pg8::gemm_phase<EpiP, pg8::StaticOrder, false, GEMM_ALIGN, GEMM_SP2>((LAS unsigned char*)lds, g, S, E, nullptr);
            if (l == 0 && (int)gridDim.x == 256 && (int)blockIdx.x >= 160) drain_tiles(p, PG1_TILES, lds);
        }
#endif
        SEAM(pb + 1);
#if (!defined(ONLY) || ONLY == 3) && !defined(SKIP3)
        if (IN(pb + 2)) for (int rp = 0; rp < REP3; ++rp) pc_phase(p, l, (float*)lds);
#endif
        SEAM(pb + 2);
#if (!defined(ONLY) || ONLY == 4) && !defined(SKIP4)
        if (IN(pb + 3)) for (int rp = 0; rp < REP4; ++rp) ps_phase(p, l, lds);
#endif
        SEAM(pb + 3);
#if (!defined(ONLY) || ONLY == 5) && !defined(SKIP5)
        if (IN(pb + 4)) for (int rp = 0; rp < REP5; ++rp) pnb_phase(p, l);
#endif
        SEAM(pb + 4);
#if (!defined(ONLY) || ONLY == 6) && !defined(SKIP6)
        if (IN(pb + 5)) for (int rp = 0; rp < REP6; ++rp) {
            pg8::Gemm g{(const bf16_t*)(ws + WS_U), (const bf16_t*)(ws + WS_WP2 + l * SZ_SQ), NTOK, DM, 1024, DM};
            ChainOrder S; S.init(NTOK, DM, (int)gridDim.x, (int)blockIdx.x);
            EpiMG E{(const bf16_t*)(ws + WS_P), (bf16_t*)(ws + WS_R1)};
            pg8::gemm_phase<EpiMG, ChainOrder, false, GEMM_ALIGN, GEMM_SP2>((LAS unsigned char*)lds, g, S, E, nullptr);
        }
#endif
        SEAM(pb + 5);
#if (!defined(ONLY) || ONLY == 7) && !defined(SKIP7)
        if (IN(pb + 6)) for (int rp = 0; rp < REP7; ++rp) {
            pg8::Gemm g{(const bf16_t*)(ws + WS_R1), (const bf16_t*)(ws + WS_WO + l * SZ_SQ), NTOK, DM, DM, DM};
            pg8::StaticOrder S; S.init(NTOK, DM, (int)gridDim.x, (int)blockIdx.x);
            EpiX E{pin(p, 0), pin(p, 1), l == 0 ? nullptr : (const float*)(ws + WS_X1), (const float*)(ws + WS_MOD) + (size_t)l * 5 * 6144 + 4096, l == 0 ? (float*)(ws + WS_X1) : (float*)(ws + WS_P)};
            pg8::gemm_phase<EpiX, pg8::StaticOrder, false, GEMM_ALIGN, GEMM_SP2>((LAS unsigned char*)lds, g, S, E, nullptr);
        }
#endif
        SEAM(pb + 6);
    }
#if (!defined(ONLY) || ONLY == 8) && !defined(SKIP8)
    if (IN(15)) pf_final(p);
#endif
}

#ifndef MK_N_LAUNCHES
#define MK_N_LAUNCHES 1
#endif
extern "C" void kernel_launch(void* const* d_in, const int* in_sizes, int n_in, void* d_out, int out_size, void* d_ws, size_t ws_size, hipStream_t stream) {
    static int grid = 0;
    if (grid == 0) {
        int dev = 0, cus = 0, per_cu = 0;
        hipGetDevice(&dev);
        hipDeviceGetAttribute(&cus, hipDeviceAttributeMultiprocessorCount, dev);
        if (hipFuncSetAttribute((const void*)fwd_megakernel, hipFuncAttributeMaxDynamicSharedMemorySize, LDS_BYTES) != hipSuccess) { fprintf(stderr, "kernel_launch: hipFuncSetAttribute failed\n"); grid = -1; return; }
        if (hipOccupancyMaxActiveBlocksPerMultiprocessor(&per_cu, (const void*)fwd_megakernel, NTHR, LDS_BYTES) != hipSuccess || per_cu < 1) { fprintf(stderr, "kernel_launch: occupancy query says %d blocks per CU\n", per_cu); grid = -1; return; }
        grid = cus * 1;
        if (n_in != 21 || ws_size < WS_END2) { fprintf(stderr, "kernel_launch: unexpected n_in %d / ws %zu\n", n_in, ws_size); grid = -1; return; }
    }
    if (grid < 0) return;
    if (hipMemsetAsync((char*)d_ws + WS_BARW, 0, 16384, stream) != hipSuccess) { fprintf(stderr, "kernel_launch: memset failed\n"); return; }
    Params p{};
    for (int i = 0; i < 21; ++i) p.in[i] = (const float*)d_in[i];
    p.out = (float*)d_out; p.ws = (unsigned char*)d_ws;
#if MK_N_LAUNCHES == 1
    p.ph_lo = 0; p.ph_hi = 16;
    void* args[] = {&p};
    hipError_t e = hipLaunchCooperativeKernel((const void*)fwd_megakernel, dim3(grid), dim3(NTHR), args, LDS_BYTES, stream);
    if (e != hipSuccess) fprintf(stderr, "cooperative launch failed: %s (grid %d)\n", hipGetErrorString(e), grid);
#else
    for (int ph = 0; ph < 16; ++ph) { p.ph_lo = ph; p.ph_hi = ph + 1;
        hipLaunchKernelGGL(fwd_megakernel, dim3(grid), dim3(NTHR), LDS_BYTES, stream, p); }
#endif
}
```

```cpp
#include <hip/hip_runtime.h>
#include <hip/hip_cooperative_groups.h>
#include <cstdio>
#include <cstdint>
namespace cg = cooperative_groups;
namespace pg8 {
#define PG8_LAS __attribute__((address_space(3)))
typedef unsigned short bf16_t;
typedef short bf16x8 __attribute__((ext_vector_type(8)));
typedef float f32x4 __attribute__((ext_vector_type(4)));
typedef unsigned u32x4 __attribute__((ext_vector_type(4)));
constexpr int BM = 256, BK = 64, HALF = 128, HTB = HALF * BK * 2  , STAGE_BYTES = 8 * HTB, NXCD = 8, WGM = 8;

__host__ __device__ __forceinline__ int lds_byte(int r, int c) { const int st = (r >> 4) * 2 + (c >> 5), rr = r & 15, cc = c & 31, ob = rr * 64 + cc * 2; return st * 1024 + (ob ^ (((ob >> 9) & 1) << 5)); }
__host__ __device__ __forceinline__ void stage_rc(int b, int& R, int& C) { const int st = b / 1024, sb = b % 1024, swz = sb ^ (((sb >> 9) & 1) << 5); R = (st >> 1) * 16 + swz / 64; C = (st & 1) * 32 + (swz % 64) / 2; }
__host__ __device__ __forceinline__ int perm32(int rho) { const int n = rho >> 4, i = rho & 15; return 8 * (i >> 2) + 4 * n + (i & 3); }

struct Unit { int pm, pn, kh; };
struct Gemm { const bf16_t* A; const bf16_t* Bt; int M, N, K, lda; };

struct StaticOrder {
    int nM, nN, nwg, G, c;
    __host__ __device__ void init(int M, int N, int G_, int c_) { nM = M / BM; nN = N / BM; nwg = nM * nN; G = G_; c = c_; }
    __host__ __device__ bool next(int i, Unit& u) const {
        const long L = (long)i * G + c; if (L >= nwg) return false;
        int wgid = (int)L; { const int q = nwg / NXCD, r = nwg % NXCD, xcd = wgid % NXCD, off = wgid / NXCD; wgid = (xcd < r ? xcd * (q + 1) : r * (q + 1) + (xcd - r) * q) + off; }
        const int nig = WGM * nN, gid = wgid / nig, fm = gid * WGM, gsz = (nM - fm) < WGM ? (nM - fm) : WGM;
        u.pm = fm + ((wgid % nig) % gsz); u.pn = (wgid % nig) / gsz; u.kh = 0; return true;
    }
    __device__ __forceinline__ void a_ready(const Unit&) const {}
    __device__ __forceinline__ void done(const Unit&) const {}
};
__device__ __forceinline__ unsigned cvt_pk_bf16(float lo, float hi) { unsigned r; asm volatile("v_cvt_pk_bf16_f32 %0, %1, %2" : "=v"(r) : "v"(lo), "v"(hi)); return r; }
template <class Epi, class Sched, bool STAMP = false, bool ALIGN_EPI = false, bool SP2 = false>
__device__ __forceinline__ void gemm_phase(PG8_LAS unsigned char* lds, const Gemm g, const Sched& S, const Epi& E, unsigned long long* stamps) {
    int tid_ = threadIdx.x; asm volatile("" : "+v"(tid_)); const int tid = tid_, wid = __builtin_amdgcn_readfirstlane(tid >> 6), lane = tid & 63, wr = wid >> 2, wc = wid & 3, fr = lane & 15, fq = lane >> 4;
    const int K = g.K, nt = K / BK;
    int ts_lo = 0, ts_hi = 0, nts = 0; const unsigned long long rt_entry = STAMP ? (unsigned long long)wall_clock64() : 0ull;
#define PG8_STAMP() do { if (STAMP && wid == 0 && nts < 64) { const unsigned long long _c = (unsigned long long)clock64(); \
        ts_lo = (lane == nts) ? (int)(unsigned)_c : ts_lo; ts_hi = (lane == nts) ? (int)(unsigned)(_c >> 32) : ts_hi; ++nts; } } while (0)
    PG8_STAMP();
    unsigned voffA[2], voffB[2];
#pragma unroll
    for (int i = 0; i < 2; ++i) { int R, C; stage_rc(tid * 16 + i * 8192, R, C); const int Rb = Epi::PERM ? ((R & ~31) + perm32(R & 31)) : R;
        voffA[i] = (unsigned)(R * g.lda + C) * 2u; voffB[i] = (unsigned)(Rb * g.lda + C) * 2u; }
    const size_t kstep = (size_t)(BK * 2);
    const size_t hstep = (size_t)HALF * g.lda * 2; const size_t khstep = (size_t)K * 2;
    const size_t tstep = 2 * hstep;
    const unsigned ldsw = (unsigned)wid * 1024u;
    const int aoff = lds_byte(wr * 64 + fr, fq * 8), boff = lds_byte(wc * 32 + fr, fq * 8);
#define PG8_SA(b, h) (((b) * 2 + (h)) * HTB)
#define PG8_SB(b, h) ((4 + (b) * 2 + (h)) * HTB)
#define PG8_STAGE(bufoff, gbase, voff) do { _Pragma("unroll") for (int _i = 0; _i < 2; ++_i) \
        __builtin_amdgcn_global_load_lds((const unsigned*)((const char*)(gbase) + (voff)[_i]), (PG8_LAS unsigned*)(lds + (bufoff) + ldsw + _i * 8192), 16, 0, 0); } while (0)
#define PG8_LDA(dst, b, h) do { _Pragma("unroll") for (int m = 0; m < 4; ++m) _Pragma("unroll") for (int k = 0; k < 2; ++k) dst[m][k] = *(const PG8_LAS bf16x8*)(lds + PG8_SA(b, h) + aoff + m * 2048 + k * 1024); } while (0)
#define PG8_LDB(dst, b, h) do { _Pragma("unroll") for (int n = 0; n < 2; ++n) _Pragma("unroll") for (int k = 0; k < 2; ++k) dst[n][k] = *(const PG8_LAS bf16x8*)(lds + PG8_SB(b, h) + boff + n * 2048 + k * 1024); } while (0)
#define PG8_MMA(ai, bj, At, Bt) do { __builtin_amdgcn_s_setprio(1); _Pragma("unroll") for (int m = 0; m < 4; ++m) _Pragma("unroll") for (int n = 0; n < 2; ++n) _Pragma("unroll") for (int k = 0; k < 2; ++k) \
        acc[ai][bj][m][n] = __builtin_amdgcn_mfma_f32_16x16x32_bf16(Bt[n][k], At[m][k], acc[ai][bj][m][n], 0, 0, 0); __builtin_amdgcn_s_setprio(0); } while (0)
#define PG8_WAIT_V(n) asm volatile("s_waitcnt vmcnt(" #n ")" ::: "memory")
#define PG8_WAIT_L(n) asm volatile("s_waitcnt lgkmcnt(" #n ")" ::: "memory")
#define PG8_BAR __builtin_amdgcn_s_barrier()
#define PG8_SCHED __builtin_amdgcn_sched_barrier(0)
    Unit cur, nxt; int ui = 0;
    if (!S.next(0, cur)) return;
    f32x4 acc[2][2][4][2];
#pragma unroll
    for (int a = 0; a < 2; ++a)
#pragma unroll
        for (int b = 0; b < 2; ++b)
#pragma unroll
            for (int m = 0; m < 4; ++m)
#pragma unroll
                for (int n = 0; n < 2; ++n) acc[a][b][m][n] = (f32x4){0.f, 0.f, 0.f, 0.f};
    bf16x8 At[4][2], B0[2][2], B1[2][2];
    const char* cA = (const char*)g.A + (size_t)cur.pm * tstep + cur.kh * khstep; const char* cB = (const char*)g.Bt + (size_t)cur.pn * tstep + cur.kh * khstep;
    S.a_ready(cur);
    if constexpr (SP2) {
        PG8_STAGE(PG8_SB(0, 0), cB, voffB); PG8_STAGE(PG8_SB(0, 1), cB + hstep, voffB); PG8_STAGE(PG8_SA(0, 0), cA, voffA); PG8_STAGE(PG8_SA(0, 1), cA + hstep, voffA);
        if (wr == 1) PG8_BAR;
        PG8_WAIT_V(2); PG8_BAR;
        PG8_STAGE(PG8_SB(1, 0), cB + kstep, voffB); PG8_STAGE(PG8_SA(1, 0), cA + kstep, voffA); PG8_STAGE(PG8_SB(1, 1), cB + hstep + kstep, voffB);
        PG8_WAIT_V(6); PG8_BAR;
    } else {
    PG8_STAGE(PG8_SB(0, 0), cB, voffB); PG8_STAGE(PG8_SA(0, 0), cA, voffA); PG8_STAGE(PG8_SB(0, 1), cB + hstep, voffB); PG8_STAGE(PG8_SA(0, 1), cA + hstep, voffA);
    if (wr == 1) PG8_BAR;
    PG8_WAIT_V(4); PG8_BAR;
    PG8_STAGE(PG8_SB(1, 0), cB + kstep, voffB); PG8_STAGE(PG8_SA(1, 0), cA + kstep, voffA); PG8_STAGE(PG8_SB(1, 1), cB + hstep + kstep, voffB);
    PG8_WAIT_V(6); PG8_BAR;
    }
    PG8_STAMP();
    for (;;) {
        const bool has_next = S.next(ui + 1, nxt);
        const char* nA = has_next ? (const char*)g.A + (size_t)nxt.pm * tstep + nxt.kh * khstep : cA; const char* nB = has_next ? (const char*)g.Bt + (size_t)nxt.pn * tstep + nxt.kh * khstep : cB;
        for (int t = 0; t < nt; t += 2) {
            const bool last = (t == nt - 2);
            const char* a1 = cA + (size_t)(t + 1) * kstep;
            const char* a2 = last ? nA : cA + (size_t)(t + 2) * kstep; const char* b2 = last ? nB : cB + (size_t)(t + 2) * kstep;
            const char* a3 = a2 + kstep; const char* b3 = b2 + kstep;
            if (last && has_next) S.a_ready(nxt);
            if constexpr (SP2) {
            PG8_LDB(B0, 0, 0); PG8_LDB(B1, 0, 1); PG8_SCHED; PG8_LDA(At, 0, 0); PG8_STAGE(PG8_SA(1, 1), a1 + hstep, voffA);
            PG8_WAIT_V(8); PG8_WAIT_L(0); PG8_BAR; PG8_MMA(0, 0, At, B0); PG8_MMA(0, 1, At, B1); PG8_BAR; PG8_SCHED;
            PG8_LDA(At, 0, 1); PG8_STAGE(PG8_SB(0, 0), b2, voffB); PG8_STAGE(PG8_SB(0, 1), b2 + hstep, voffB); PG8_STAGE(PG8_SA(0, 0), a2, voffA);
            PG8_WAIT_V(8); PG8_WAIT_L(0); PG8_BAR; PG8_MMA(1, 0, At, B0); PG8_MMA(1, 1, At, B1); PG8_BAR; PG8_SCHED;
            PG8_LDB(B0, 1, 0); PG8_LDB(B1, 1, 1); PG8_SCHED; PG8_LDA(At, 1, 0); PG8_STAGE(PG8_SA(0, 1), a2 + hstep, voffA);
            PG8_WAIT_V(8); PG8_WAIT_L(0); PG8_BAR; PG8_MMA(0, 0, At, B0); PG8_MMA(0, 1, At, B1); PG8_BAR; PG8_SCHED;
            PG8_LDA(At, 1, 1); PG8_STAGE(PG8_SB(1, 0), b3, voffB); PG8_STAGE(PG8_SB(1, 1), b3 + hstep, voffB); PG8_STAGE(PG8_SA(1, 0), a3, voffA);
            PG8_WAIT_V(8); PG8_WAIT_L(0); PG8_BAR; PG8_MMA(1, 0, At, B0); PG8_MMA(1, 1, At, B1); PG8_BAR; PG8_SCHED;
            } else {
            PG8_LDB(B0, 0, 0); PG8_SCHED; PG8_LDA(At, 0, 0); PG8_STAGE(PG8_SA(1, 1), a1 + hstep, voffA);
            PG8_WAIT_L(8); PG8_BAR; PG8_WAIT_L(0); PG8_MMA(0, 0, At, B0); PG8_BAR; PG8_SCHED;
            PG8_LDB(B1, 0, 1); PG8_STAGE(PG8_SB(0, 0), b2, voffB);
            PG8_BAR; PG8_WAIT_L(0); PG8_MMA(0, 1, At, B1); PG8_BAR;
            PG8_LDA(At, 0, 1); PG8_STAGE(PG8_SA(0, 0), a2, voffA);
            PG8_BAR; PG8_WAIT_L(0); PG8_MMA(1, 0, At, B0); PG8_BAR; PG8_SCHED;
            PG8_STAGE(PG8_SB(0, 1), b2 + hstep, voffB);
            PG8_WAIT_V(6); PG8_BAR; PG8_MMA(1, 1, At, B1); PG8_BAR;
            PG8_LDB(B0, 1, 0); PG8_SCHED; PG8_LDA(At, 1, 0); PG8_STAGE(PG8_SA(0, 1), a2 + hstep, voffA);
            PG8_WAIT_L(8); PG8_BAR; PG8_WAIT_L(0); PG8_MMA(0, 0, At, B0); PG8_BAR; PG8_SCHED;
            PG8_LDB(B1, 1, 1); PG8_STAGE(PG8_SB(1, 0), b3, voffB);
            PG8_BAR; PG8_WAIT_L(0); PG8_MMA(0, 1, At, B1); PG8_BAR;
            PG8_LDA(At, 1, 1); PG8_STAGE(PG8_SA(1, 0), a3, voffA);
            PG8_BAR; PG8_WAIT_L(0); PG8_MMA(1, 0, At, B0); PG8_BAR; PG8_SCHED;
            PG8_STAGE(PG8_SB(1, 1), b3 + hstep, voffB);
            PG8_WAIT_V(6); PG8_BAR; PG8_MMA(1, 1, At, B1); PG8_BAR;
            }
        }
        PG8_STAMP();
        if constexpr (ALIGN_EPI) { if (wr == 0) PG8_BAR; }
        if constexpr (!Epi::AFTER_DRAIN) { E(acc, cur, wr, wc, fr, fq); S.done(cur); }
        PG8_STAMP();
        if (!has_next) break;
        if (!(Epi::CHAIN && cur.kh == 0))
#pragma unroll
        for (int a = 0; a < 2; ++a)
#pragma unroll
            for (int b = 0; b < 2; ++b)
#pragma unroll
                for (int m = 0; m < 4; ++m)
#pragma unroll
                    for (int n = 0; n < 2; ++n) acc[a][b][m][n] = (f32x4){0.f, 0.f, 0.f, 0.f};
        cur = nxt; cA = nA; cB = nB; ++ui;
        if constexpr (ALIGN_EPI) { if (wr == 1) PG8_BAR; }
    }
    PG8_WAIT_V(0);
    if constexpr (!ALIGN_EPI) { if (wr == 0) PG8_BAR; }
    PG8_BAR;
    if constexpr (Epi::AFTER_DRAIN) { E.fused(acc, cur, wr, wc, fr, fq, lds, wid, lane); S.done(cur); }
    PG8_STAMP();
    if (STAMP && wid == 0) { stamps[lane] = lane < nts ? (((unsigned long long)(unsigned)ts_hi << 32) | (unsigned)ts_lo) : 0ull;
        if (lane == 62) stamps[62] = rt_entry; if (lane == 63) stamps[63] = (unsigned long long)wall_clock64(); }
#undef PG8_STAMP
#undef PG8_SA
#undef PG8_SB
#undef PG8_STAGE
#undef PG8_LDA
#undef PG8_LDB
#undef PG8_MMA
#undef PG8_WAIT_V
#undef PG8_WAIT_L
#undef PG8_BAR
#undef PG8_SCHED
}
}
#ifndef GEMM_SP2
#define GEMM_SP2 true
#endif
#ifndef GEMM_ALIGN
#define GEMM_ALIGN true
#endif
#ifndef REP_DN
#define REP_DN 1
#endif
#ifndef REP_CONV
#define REP_CONV 1
#endif
#ifndef PG1_TILES
#define PG1_TILES 6
#endif
#ifndef REP_SCAN
#define REP_SCAN 1
#endif
#ifndef REP_TILES
#define REP_TILES 1
#endif
#ifndef REP_LNA
#define REP_LNA 1
#endif
#ifndef REP_GRAM
#define REP_GRAM 1
#endif
#ifndef REP_E
#define REP_E 1
#endif
#ifndef REP_SOLVE
#define REP_SOLVE 1
#endif

#define LAS __attribute__((address_space(3)))
typedef unsigned short bf16_t;
typedef short bf16x8 __attribute__((ext_vector_type(8)));
typedef float f32x4 __attribute__((ext_vector_type(4)));
typedef unsigned u32x4 __attribute__((ext_vector_type(4)));
typedef unsigned u32x2 __attribute__((ext_vector_type(2)));

constexpr int NTOK = 8192, DM = 2048, NCTX = 4096, NP = 11520, NTHR = 512;
constexpr int C_AVAL = 0, C_AGLU = 1024, C_AZ = 2048, C_Q = 3072, C_ZB = 6144, C_GA = 7168, C_GB = 9216, C_BA = 11264;
constexpr float EPS = 1e-6f;
constexpr int LDS_BYTES = 139264;
constexpr int LDS_TQ = LDS_BYTES - 8;
constexpr int LDS_BARST = LDS_BYTES - 16;
constexpr int XCD_BAR_BYTES = 3456 * 4;

constexpr size_t WS_WIN = 256;
constexpr size_t SZ_WIN1 = (size_t)NP * DM * 2;
constexpr size_t WS_WP2 = WS_WIN + 2 * SZ_WIN1;
constexpr size_t SZ_SQ = (size_t)DM * DM * 2;
constexpr size_t WS_WO = WS_WP2 + 2 * SZ_SQ;
constexpr size_t WS_MOD = WS_WO + 2 * SZ_SQ;
constexpr size_t WS_R1 = WS_MOD + 2 * 5 * 6144 * 4;
constexpr size_t WS_P = WS_R1 + (size_t)2 * NTOK * 1024 * 4;
constexpr size_t WS_BA = WS_P + (size_t)NTOK * NP * 2;
constexpr size_t WS_Y = WS_BA + (size_t)NTOK * 32 * 4;
constexpr size_t WS_U = WS_Y + (size_t)NTOK * 1024 * 4;
constexpr size_t WS_DN = WS_U + (size_t)NTOK * 2048 * 2;
constexpr int DN_NEGW = 0, DN_QDEC = 16384, DN_KDT = 32768, DN_QKM = 49152, DN_UT = 57344, DN_EGL = 90112, DN_REC = 90368;
constexpr size_t WS_X1 = WS_DN + (size_t)2048 * DN_REC;
constexpr size_t WS_END = WS_X1 + (size_t)NTOK * DM * 4;
constexpr size_t WS_BARW = WS_END;
constexpr size_t WS_TQ = WS_BARW + 15360;
constexpr size_t WS_END2 = WS_BARW + 16384;
static_assert(WS_END2 <= 740294656ull && XCD_BAR_BYTES <= 16384, "workspace");

__device__ __forceinline__ int opaque_tid() { int t = threadIdx.x; asm volatile("" : "+v"(t)); return t; }
struct Params { const float* in[21]; float* out; unsigned char* ws; int ph_lo, ph_hi; };
#define KA_ __attribute__((address_space(4)))
__device__ __forceinline__ const float* pin(const Params&, int k) { const KA_ char* ka = (const KA_ char*)__builtin_amdgcn_kernarg_segment_ptr(); return *(const float* const volatile KA_*)(ka + 8 * k); }
__device__ __forceinline__ unsigned char* pws(const Params&) { const KA_ char* ka = (const KA_ char*)__builtin_amdgcn_kernarg_segment_ptr(); return *(unsigned char* const volatile KA_*)(ka + 8 * 22); }
__device__ __forceinline__ float* pout(const Params&) { const KA_ char* ka = (const KA_ char*)__builtin_amdgcn_kernarg_segment_ptr(); return *(float* const volatile KA_*)(ka + 8 * 21); }

__device__ __forceinline__ float bf2f(unsigned short b) { return __uint_as_float(((unsigned)b) << 16); }
__device__ __forceinline__ unsigned f2bf(float f) { unsigned u = __float_as_uint(f); u += 0x7fffu + ((u >> 16) & 1u); return u >> 16; }
typedef float f32x2_t __attribute__((ext_vector_type(2)));
typedef __bf16 bf16x2_t __attribute__((ext_vector_type(2)));
__device__ __forceinline__ unsigned pk2(float lo, float hi) { const f32x2_t v = {lo, hi}; return __builtin_bit_cast(unsigned, __builtin_convertvector(v, bf16x2_t)); }
__device__ __forceinline__ float sigmoidf_(float x) { return __builtin_amdgcn_rcpf(1.0f + __expf(-x)); }
__device__ __forceinline__ float siluf_(float x) { return x * __builtin_amdgcn_rcpf(1.0f + __expf(-x)); }
__device__ __forceinline__ f32x4 bf4_to_f32(u32x2 w) { return (f32x4){__uint_as_float(w[0] << 16), __uint_as_float(w[0] & 0xffff0000u), __uint_as_float(w[1] << 16), __uint_as_float(w[1] & 0xffff0000u)}; }
__device__ __forceinline__ float wave_sum(float v) {
#pragma unroll
    for (int o = 32; o > 0; o >>= 1) v += __shfl_xor(v, o);
    return v;
}
__device__ __forceinline__ const float* xrow0(const Params& p, int tok) { return tok < NCTX ? pin(p, 0) + (size_t)tok * DM : pin(p, 1) + (size_t)(tok - NCTX) * DM; }
__device__ __forceinline__ int cvec_of(int tok) { return tok < NCTX ? 0 : 1 + ((tok - NCTX) >> 10); }

__device__ __forceinline__ void tr_tile(const float* __restrict__ src, int ldsrc, int k0, int n0, int mode, bf16_t* __restrict__ dst, int lddst, int koff, float* lds) {
    const int tid = opaque_tid();
    { const int c4 = tid & 31, rr = tid >> 5; const int np = n0 + c4 * 4; int sc = np;
        if (mode == 1) { sc = np < 7168 ? np : (np < 11264 ? np + 32 : (np < 11296 ? np - 11264 + 7168 : -1)); }
#pragma unroll
        for (int i = 0; i < 8; ++i) { const int r = rr + 16 * i;
            *(f32x4*)(lds + r * 132 + c4 * 4) = sc >= 0 ? *(const f32x4*)(src + (size_t)(k0 + r) * ldsrc + sc) : (f32x4){0.f, 0.f, 0.f, 0.f}; } }
    __syncthreads();
#pragma unroll
    for (int i = 0; i < 4; ++i) { const int u = tid + 512 * i, nn = u & 127, kg = u >> 7;
        u32x4 o;
#pragma unroll
        for (int j = 0; j < 4; ++j) o[j] = pk2(lds[(kg * 8 + 2 * j) * 132 + nn], lds[(kg * 8 + 2 * j + 1) * 132 + nn]);
        *(u32x4*)(dst + (size_t)(n0 + nn) * lddst + koff + k0 + kg * 8) = o; }
    __syncthreads();
}
__device__ __forceinline__ void weight_tile(const Params& p, int it, float* lds) {
    unsigned char* ws = pws(p);
    const int l = it / 1952; int r = it % 1952;
    const float* src; int ldsrc, kt, ntile, mode = 0, koff = 0; bf16_t* dst;
    if (r < 1440) { kt = r / 90; ntile = r % 90; src = pin(p, 8) + (size_t)l * 2048 * 11296; ldsrc = 11296; mode = 1; dst = (bf16_t*)(ws + WS_WIN + l * SZ_WIN1); }
    else if (r < 1440 + 256) { r -= 1440; const int which = r / 128; r %= 128; kt = r / 16; ntile = r % 16;
        src = pin(p, which ? 18 : 13) + (size_t)l * 1024 * 2048; ldsrc = 2048; dst = (bf16_t*)(ws + WS_WP2 + l * SZ_SQ); koff = which * 1024; }
    else { r -= 1696; kt = r / 16; ntile = r % 16; src = pin(p, 19) + (size_t)l * 2048 * 2048; ldsrc = 2048; dst = (bf16_t*)(ws + WS_WO + l * SZ_SQ); }
    tr_tile(src, ldsrc, kt * 128, ntile * 128, mode, dst, 2048, koff, lds);
}

__device__ __forceinline__ void drain_tiles(const Params& p, int max_tiles, unsigned char* lds) {
    volatile LAS unsigned* slot = (volatile LAS unsigned*)((LAS unsigned char*)lds + LDS_TQ);
    __syncthreads();
    for (int n = 0; n < max_tiles; ++n) {
        if (threadIdx.x == 0) *slot = __hip_atomic_fetch_add((unsigned*)(pws(p) + WS_TQ), 1u, __ATOMIC_RELAXED, __HIP_MEMORY_SCOPE_AGENT);
        __syncthreads();
        const unsigned it = *slot;
        if (it >= 2u * 1952u - 1440u) break;
        weight_tile(p, 1440 + (int)it, (float*)lds);
    }
}
__device__ __forceinline__ void p0_prologue(const Params& p, float* lds) {
    const int tid = opaque_tid(), G = gridDim.x, b = blockIdx.x;
    unsigned char* ws = pws(p);
    for (int it = b; it < 1440; it += G) weight_tile(p, it, lds);
    float* sc = lds;
    float* red = lds + 5 * 2048;
    __syncthreads();
    for (int i = tid; i < 5 * 2048; i += NTHR) { const int v = i >> 11, k = i & 2047; const float x = v == 0 ? pin(p, 4)[k] : pin(p, 3)[(v - 1) * 2048 + k]; sc[i] = siluf_(x); }
    __syncthreads();
    for (int it = b; it < 192; it += G) {
        const int l = it / 96, col0 = (it % 96) * 64;
        const int kq = tid >> 4, c4 = tid & 15;
        f32x4 acc[5];
#pragma unroll
        for (int v = 0; v < 5; ++v) acc[v] = (f32x4){0.f, 0.f, 0.f, 0.f};
        const float* wp = pin(p, 5) + (size_t)l * 2048 * 6144 + col0 + c4 * 4;
#pragma unroll 8
        for (int i = 0; i < 64; ++i) { const int k = kq + 32 * i; const f32x4 w = *(const f32x4*)(wp + (size_t)k * 6144);
#pragma unroll
            for (int v = 0; v < 5; ++v) acc[v] += w * sc[v * 2048 + k]; }
#pragma unroll
        for (int v = 0; v < 5; ++v) *(f32x4*)(red + (kq * 5 + v) * 64 + c4 * 4) = acc[v];
        __syncthreads();
        if (tid < 320) { const int v = tid >> 6, c = tid & 63; float s = 0.f;
            for (int q = 0; q < 32; ++q) s += red[(q * 5 + v) * 64 + c];
            ((float*)(ws + WS_MOD))[(size_t)(l * 5 + v) * 6144 + col0 + c] = s + pin(p, 6)[l * 6144 + col0 + c]; }
        __syncthreads();
    }
}

__device__ __forceinline__ void pn_norm(const Params& p, int l) {
    const int tid = opaque_tid(), lane = tid & 63, wid = tid >> 6;
    bf16_t* XN = (bf16_t*)(pws(p) + WS_R1);
    const float* MOD = (const float*)(pws(p) + WS_MOD);
    const float* ng = pin(p, 7) + l * DM;
    for (int tok = blockIdx.x * 8 + wid; tok < NTOK; tok += gridDim.x * 8) {
        const float* xr = l == 0 ? xrow0(p, tok) : (const float*)(pws(p) + WS_X1) + (size_t)tok * DM;
        f32x4 v[8]; float ss = 0.f;
#pragma unroll
        for (int i = 0; i < 8; ++i) { v[i] = *(const f32x4*)(xr + (lane + 64 * i) * 4); ss += v[i][0] * v[i][0] + v[i][1] * v[i][1] + v[i][2] * v[i][2] + v[i][3] * v[i][3]; }
        ss = wave_sum(ss);
        const float rstd = rsqrtf(ss * (1.0f / DM) + EPS);
        const float* md = MOD + (size_t)(l * 5 + cvec_of(tok)) * 6144;
#pragma unroll
        for (int i = 0; i < 8; ++i) { const int c = (lane + 64 * i) * 4;
            const f32x4 g = *(const f32x4*)(ng + c), sh = *(const f32x4*)(md + c), scl = *(const f32x4*)(md + 2048 + c);
            const f32x4 h = (v[i] * rstd * g) * (scl + 1.0f) + sh;
            u32x2 o; o[0] = pk2(h[0], h[1]); o[1] = pk2(h[2], h[3]);
            *(u32x2*)(XN + (size_t)tok * DM + c) = o; }
    }
}
__device__ __forceinline__ void pf_final(const Params& p) {
    const int tid = opaque_tid(), lane = tid & 63, wid = tid >> 6;
    const float* X2 = (const float*)(pws(p) + WS_P);
    const float* fg = pin(p, 20);
    for (int tok = blockIdx.x * 8 + wid; tok < NTOK; tok += gridDim.x * 8) {
        const float* xr = X2 + (size_t)tok * DM;
        f32x4 v[8]; float ss = 0.f;
#pragma unroll
        for (int i = 0; i < 8; ++i) { v[i] = *(const f32x4*)(xr + (lane + 64 * i) * 4); ss += v[i][0] * v[i][0] + v[i][1] * v[i][1] + v[i][2] * v[i][2] + v[i][3] * v[i][3]; }
        ss = wave_sum(ss);
        const float rstd = rsqrtf(ss * (1.0f / DM) + EPS);
#pragma unroll
        for (int i = 0; i < 8; ++i) { const int c = (lane + 64 * i) * 4; const f32x4 g = *(const f32x4*)(fg + c);
            *(f32x4*)(pout(p) + (size_t)tok * DM + c) = v[i] * rstd * g; }
    }
}

struct ChainOrder : pg8::StaticOrder {
    __device__ bool next(int i, pg8::Unit& u) const { const bool ok = pg8::StaticOrder::next(i >> 1, u); u.kh = i & 1; return ok; }
};
struct EpiP {
    static constexpr bool PERM = true, AFTER_DRAIN = false, CHAIN = false;
    bf16_t* P; float* BA;
    __device__ __forceinline__ void operator()(f32x4 (&acc)[2][2][4][2], const pg8::Unit& u, int wr, int wc, int fr, int fq) const {
        const int row0 = u.pm * 256 + wr * 64 + fr, col0 = u.pn * 256 + wc * 32 + 8 * fq;
#pragma unroll
        for (int ai = 0; ai < 2; ++ai)
#pragma unroll
            for (int m = 0; m < 4; ++m) { const int row = row0 + ai * 128 + m * 16; bf16_t* rowp = P + (size_t)row * NP + col0;
#pragma unroll
                for (int bj = 0; bj < 2; ++bj) { const f32x4 v0 = acc[ai][bj][m][0], v1 = acc[ai][bj][m][1];
                    u32x4 o; o[0] = pg8::cvt_pk_bf16(v0[0], v0[1]); o[1] = pg8::cvt_pk_bf16(v0[2], v0[3]); o[2] = pg8::cvt_pk_bf16(v1[0], v1[1]); o[3] = pg8::cvt_pk_bf16(v1[2], v1[3]);
                    *(u32x4*)(rowp + bj * 128) = o; }
                if (u.pn == 44 && wc == 0) { *(f32x4*)(BA + (size_t)row * 32 + 8 * fq) = acc[ai][0][m][0]; *(f32x4*)(BA + (size_t)row * 32 + 8 * fq + 4) = acc[ai][0][m][1]; }
            }
    }
};
struct EpiMG {
    static constexpr bool PERM = true, AFTER_DRAIN = false, CHAIN = true;
    const bf16_t* P; bf16_t* MG;
    __device__ __forceinline__ void mid(f32x4 (&acc)[2][2][4][2], const pg8::Unit& u, int wr, int wc, int fr, int fq) const {
        const int row0 = u.pm * 256 + wr * 64 + fr, col0 = u.pn * 256 + wc * 32 + 8 * fq;
#pragma unroll
        for (int ai = 0; ai < 2; ++ai)
#pragma unroll
            for (int m = 0; m < 4; ++m) { const int row = row0 + ai * 128 + m * 16; const bf16_t* rowp = P + (size_t)row * NP + col0;
#pragma unroll
                for (int bj = 0; bj < 2; ++bj) { const u32x4 ga = *(const u32x4*)(rowp + C_GA + bj * 128), gb = *(const u32x4*)(rowp + C_GB + bj * 128);
#pragma unroll
                    for (int e = 0; e < 8; ++e) { const float a = __uint_as_float((e & 1) ? (ga[e >> 1] & 0xffff0000u) : (ga[e >> 1] << 16)), bq = __uint_as_float((e & 1) ? (gb[e >> 1] & 0xffff0000u) : (gb[e >> 1] << 16));
                        const float ratio = (1.0f + __expf(-bq)) * __builtin_amdgcn_rcpf(1.0f + __expf(-a));
                        acc[ai][bj][m][e >> 2][e & 3] *= ratio; }
                    __builtin_amdgcn_sched_barrier(0); }
            }
    }
    __device__ __forceinline__ void operator()(f32x4 (&acc)[2][2][4][2], const pg8::Unit& u, int wr, int wc, int fr, int fq) const {
        if (u.kh == 0) { mid(acc, u, wr, wc, fr, fq); return; }
        const int row0 = u.pm * 256 + wr * 64 + fr, col0 = u.pn * 256 + wc * 32 + 8 * fq;
#pragma unroll
        for (int ai = 0; ai < 2; ++ai)
#pragma unroll
            for (int m = 0; m < 4; ++m) { const int row = row0 + ai * 128 + m * 16; const bf16_t* rowp = P + (size_t)row * NP + col0;
#pragma unroll
                for (int bj = 0; bj < 2; ++bj) { const u32x4 gb = *(const u32x4*)(rowp + C_GB + bj * 128);
                    float o[8];
#pragma unroll
                    for (int e = 0; e < 8; ++e) { const float bq = __uint_as_float((e & 1) ? (gb[e >> 1] & 0xffff0000u) : (gb[e >> 1] << 16));
                        o[e] = acc[ai][bj][m][e >> 2][e & 3] * sigmoidf_(bq); }
                    u32x4 ov; ov[0] = pg8::cvt_pk_bf16(o[0], o[1]); ov[1] = pg8::cvt_pk_bf16(o[2], o[3]); ov[2] = pg8::cvt_pk_bf16(o[4], o[5]); ov[3] = pg8::cvt_pk_bf16(o[6], o[7]);
                    *(u32x4*)(MG + (size_t)row * DM + col0 + bj * 128) = ov; }
            }
    }
};
struct EpiX {
    static constexpr bool PERM = false, AFTER_DRAIN = false, CHAIN = false;
    const float* x0a; const float* x0b; const float* x1; const float* gate; float* out;
    __device__ __forceinline__ void operator()(f32x4 (&acc)[2][2][4][2], const pg8::Unit& u, int wr, int wc, int fr, int fq) const {
        const int row0 = u.pm * 256 + wr * 64 + fr, col0 = u.pn * 256 + wc * 32 + 4 * fq;
#pragma unroll
        for (int ai = 0; ai < 2; ++ai)
#pragma unroll
            for (int m = 0; m < 4; ++m) { const int row = row0 + ai * 128 + m * 16;
                const float* xr = x1 ? x1 + (size_t)row * DM : (row < NCTX ? x0a + (size_t)row * DM : x0b + (size_t)(row - NCTX) * DM);
                const float* gr = gate + (size_t)cvec_of(row) * 6144;
#pragma unroll
                for (int bj = 0; bj < 2; ++bj)
#pragma unroll
                    for (int n = 0; n < 2; ++n) { const int col = col0 + bj * 128 + n * 16;
                        const f32x4 xv = *(const f32x4*)(xr + col), gv = *(const f32x4*)(gr + col);
                        *(f32x4*)(out + (size_t)row * DM + col) = xv + gv * acc[ai][bj][m][n]; }
            }
    }
};

template <int T>
__device__ __forceinline__ void conv_line(const bf16_t* __restrict__ P, bf16_t* __restrict__ Y, int base, int stride, int L, int p0, int ch, const float* __restrict__ w, const float* __restrict__ cb) {
    f32x2_t ua[T + 30];
#pragma unroll
    for (int i = 0; i < T + 30; ++i) { const int pos = p0 - 15 + i; f32x2_t v = {0.f, 0.f};
        if (pos >= 0 && pos < L) { const bf16_t* pr = P + (size_t)(base + pos * stride) * NP + ch; const unsigned a = *(const unsigned*)(pr + C_AVAL), g = *(const unsigned*)(pr + C_AGLU);
            v[0] = __uint_as_float(a << 16) * sigmoidf_(__uint_as_float(g << 16)); v[1] = __uint_as_float(a & 0xffff0000u) * sigmoidf_(__uint_as_float(g & 0xffff0000u)); }
        ua[i] = v; }
    f32x2_t wk[31];
#pragma unroll
    for (int k = 0; k < 31; ++k) wk[k] = *(const f32x2_t*)(w + k * 1024 + ch);
    const f32x2_t bias = *(const f32x2_t*)(cb + ch);
#pragma unroll
    for (int j = 0; j < T; ++j) { f32x2_t a = bias;
#pragma unroll
        for (int k = 0; k < 31; ++k) a += wk[k] * ua[j + k];
        *(unsigned*)(Y + (size_t)(base + (p0 + j) * stride) * 1024 + ch) = pk2(a[0], a[1]); }
}

__device__ __forceinline__ void split8(const float* p, bf16x8& hi, bf16x8& lo) {
    const f32x4 a = *(const f32x4*)p, b2 = *(const f32x4*)(p + 4);
    u32x4 h, l2;
    h[0] = pk2(a[0], a[1]); h[1] = pk2(a[2], a[3]); h[2] = pk2(b2[0], b2[1]); h[3] = pk2(b2[2], b2[3]);
    l2[0] = pk2(a[0] - __uint_as_float(h[0] << 16), a[1] - __uint_as_float(h[0] & 0xffff0000u));
    l2[1] = pk2(a[2] - __uint_as_float(h[1] << 16), a[3] - __uint_as_float(h[1] & 0xffff0000u));
    l2[2] = pk2(b2[0] - __uint_as_float(h[2] << 16), b2[1] - __uint_as_float(h[2] & 0xffff0000u));
    l2[3] = pk2(b2[2] - __uint_as_float(h[3] << 16), b2[3] - __uint_as_float(h[3] & 0xffff0000u));
    hi = __builtin_bit_cast(bf16x8, h); lo = __builtin_bit_cast(bf16x8, l2);
}
__device__ __forceinline__ void dn_precompute(const Params& p, int l, int gc, int h, float* lds) {
    const int tid = opaque_tid(), lane = tid & 63, wid = tid >> 6;
    float* qs = lds;
    float* ks = lds + 8448;
    float* vs = lds + 2 * 8448;
    float* Gm = lds + 3 * 8448;
    float* QKm = Gm + 4160;
    float* betaS = QKm + 4160;
    float* gcS = betaS + 128;
    float* wscS = gcS + 128;
    const bf16_t* P = (const bf16_t*)(pws(p) + WS_P);
    const float* BA = (const float*)(pws(p) + WS_BA);
    int n, nc; if (gc < 64) { n = gc & 3; nc = 4; } else { n = (gc - 64) & 15; nc = 16; }
    const int tok0 = gc * 64;
    const float* cw = pin(p, 14) + (size_t)l * 3 * 3072;
    if (tid < 384) { const int cg = tid % 48, run = tid / 48, which = cg >> 4, d0 = (cg & 15) * 8;
        const int wch = which * 1024 + h * 128 + d0;
        const bf16_t* pc = P + (long)(tok0 + run * 8 - 1) * NP + C_Q + wch;
        u32x4 rows[10];
#pragma unroll
        for (int r = 0; r < 10; ++r) { const int t = run * 8 - 1 + r; const bool valid = (t >= 0 || n > 0) && (t < 64 || n < nc - 1);
            rows[r] = valid ? *(const u32x4*)(pc + (long)r * NP) : (u32x4){0u, 0u, 0u, 0u}; }
        f32x4 w[3][2];
#pragma unroll
        for (int j = 0; j < 3; ++j) { w[j][0] = *(const f32x4*)(cw + j * 3072 + wch); w[j][1] = *(const f32x4*)(cw + j * 3072 + wch + 4); }
        float* dst = (which == 0 ? qs : (which == 1 ? ks : vs)) + d0;
#pragma unroll
        for (int o = 0; o < 8; ++o) { f32x4 r2[2];
#pragma unroll
            for (int e = 0; e < 8; ++e) { const unsigned a = rows[o][e >> 1], bq = rows[o + 1][e >> 1], cq = rows[o + 2][e >> 1];
                const float xm = __uint_as_float((e & 1) ? (a & 0xffff0000u) : (a << 16)), x0 = __uint_as_float((e & 1) ? (bq & 0xffff0000u) : (bq << 16)), xp = __uint_as_float((e & 1) ? (cq & 0xffff0000u) : (cq << 16));
                r2[e >> 2][e & 3] = siluf_(w[0][e >> 2][e & 3] * xm + w[1][e >> 2][e & 3] * x0 + w[2][e >> 2][e & 3] * xp); }
            *(f32x4*)(dst + (run * 8 + o) * 132) = r2[0]; *(f32x4*)(dst + (run * 8 + o) * 132 + 4) = r2[1]; }
    }
    if (tid < 128) { const int dir = tid >> 6, i = tid & 63, tl = dir ? 63 - i : i;
        const float* ba = BA + (size_t)(tok0 + tl) * 32;
        const float bl = ba[dir * 8 + h], al = ba[16 + dir * 8 + h];
        const float xx = al + pin(p, 16)[(l * 2 + dir) * 8 + h];
        const float sp = xx > 20.f ? xx : log1pf(__expf(xx));
        float g = -__expf(pin(p, 15)[(l * 2 + dir) * 8 + h]) * sp;
#pragma unroll
        for (int o = 1; o < 64; o <<= 1) { const float t2 = __shfl_up(g, o); if (i >= o) g += t2; }
        const float bt = sigmoidf_(bl); betaS[dir * 64 + i] = bt; gcS[dir * 64 + i] = g; wscS[dir * 64 + i] = bt * __expf(g); }
    __syncthreads();
    { float a[16], b2[16], ss[16];
#pragma unroll
        for (int k = 0; k < 16; ++k) { const int r = wid + 8 * k; const float* row = (r < 64 ? qs + r * 132 : ks + (r - 64) * 132); a[k] = row[lane]; b2[k] = row[lane + 64]; ss[k] = a[k] * a[k] + b2[k] * b2[k]; }
#pragma unroll
        for (int o = 32; o > 0; o >>= 1) {
#pragma unroll
            for (int k = 0; k < 16; ++k) ss[k] += __shfl_xor(ss[k], o); }
#pragma unroll
        for (int k = 0; k < 16; ++k) { const int r = wid + 8 * k; float* row = (r < 64 ? qs + r * 132 : ks + (r - 64) * 132);
            const float sc = rsqrtf(ss[k] + EPS) * (r < 64 ? 0.08838834764831845f : 1.0f); row[lane] = a[k] * sc; row[lane + 64] = b2[k] * sc; } }
    __syncthreads();
    for (int rg = 0; rg < REP_GRAM; ++rg) { const int mat = wid >> 2, ti = wid & 3, r = lane & 15, q4 = lane >> 4;
        const float* Ar = mat ? qs : ks;
        bf16x8 Ahi[4], Alo[4];
#pragma unroll
        for (int k4 = 0; k4 < 4; ++k4) split8(Ar + (16 * ti + r) * 132 + 32 * k4 + 8 * q4, Ahi[k4], Alo[k4]);
        float* M = mat ? QKm : Gm;
#pragma unroll
        for (int tj = 0; tj < 4; ++tj) { f32x4 acc = (f32x4){0.f, 0.f, 0.f, 0.f};
#pragma unroll
            for (int k4 = 0; k4 < 4; ++k4) { bf16x8 Bhi, Blo; split8(ks + (16 * tj + r) * 132 + 32 * k4 + 8 * q4, Bhi, Blo);
                acc = __builtin_amdgcn_mfma_f32_16x16x32_bf16(Ahi[k4], Bhi, acc, 0, 0, 0);
                acc = __builtin_amdgcn_mfma_f32_16x16x32_bf16(Ahi[k4], Blo, acc, 0, 0, 0);
                acc = __builtin_amdgcn_mfma_f32_16x16x32_bf16(Alo[k4], Bhi, acc, 0, 0, 0); }
#pragma unroll
            for (int j = 0; j < 4; ++j) M[(16 * ti + 4 * q4 + j) * 65 + 16 * tj + r] = acc[j]; } }
    __syncthreads();
    const int dir = tid >> 8, tl = tid & 255;
    unsigned char* rec = pws(p) + WS_DN + (size_t)((gc * 8 + h) * 2 + dir) * DN_REC;
    const float* gcd = gcS + dir * 64; const float* btd = betaS + dir * 64;
    const float gl = gcd[63];
    { bf16_t* qd = (bf16_t*)(rec + DN_QDEC);
        for (int e = tl; e < 64 * 64; e += 256) { const int i = e >> 6, d2 = (e & 63) * 2; const int t = dir ? 63 - i : i; const float eg = __expf(gcd[i]);
            *(unsigned*)(qd + i * 128 + d2) = pk2(qs[t * 132 + d2] * eg, qs[t * 132 + d2 + 1] * eg); } }
    __syncthreads();
    float* Am = qs + dir * 4096;
    for (int e = tl; e < 4096; e += 256) { const int j = e >> 6, i = e & 63; const int ti = dir ? 63 - i : i, tj = dir ? 63 - j : j;
        Am[e] = j < i ? btd[i] * Gm[ti * 65 + tj] * __expf(gcd[i] - gcd[j]) : 0.f; }
    __syncthreads();
    if (tl >= 64) { const int t2 = tl - 64;
        bf16_t* kd = (bf16_t*)(rec + DN_KDT);
        for (int e = t2; e < 128 * 32; e += 192) { const int dk = e >> 5, j2 = (e & 31) * 2; const int t0 = dir ? 63 - j2 : j2, t1 = dir ? 62 - j2 : j2 + 1;
            *(unsigned*)(kd + dk * 64 + j2) = pk2(ks[t0 * 132 + dk] * __expf(gl - gcd[j2]), ks[t1 * 132 + dk] * __expf(gl - gcd[j2 + 1])); }
        bf16_t* qk = (bf16_t*)(rec + DN_QKM);
        for (int e = t2; e < 64 * 32; e += 192) { const int i = e >> 5, j2 = (e & 31) * 2; const int ti = dir ? 63 - i : i, t0 = dir ? 63 - j2 : j2, t1 = dir ? 62 - j2 : j2 + 1;
            const float v0 = j2 <= i ? QKm[ti * 65 + t0] * __expf(gcd[i] - gcd[j2]) : 0.f;
            const float v1 = j2 + 1 <= i ? QKm[ti * 65 + t1] * __expf(gcd[i] - gcd[j2 + 1]) : 0.f;
            *(unsigned*)(qk + i * 64 + j2) = pk2(v0, v1); }
        if (t2 == 0) *(float*)(rec + DN_EGL) = __expf(gl);
    }
    float* Tm = Am;
    if (tl < 64) { const int c = tl;
        f32x2_t U2[32];
#pragma unroll
        for (int i = 0; i < 64; ++i) U2[i >> 1][i & 1] = (i == c) ? 1.f : 0.f;
        f32x4 av[2][16];
#pragma unroll
        for (int i4 = 0; i4 < 16; ++i4) av[0][i4] = *(const f32x4*)(Am + i4 * 4);
        __builtin_amdgcn_sched_barrier(0);
#pragma unroll
        for (int j = 0; j < 63; ++j) {
            if (j + 1 < 63) {
#pragma unroll
                for (int i4 = (j + 2) / 4; i4 < 16; ++i4) av[(j + 1) & 1][i4] = *(const f32x4*)(Am + (j + 1) * 64 + i4 * 4); }
            const float uj = U2[j >> 1][j & 1]; const f32x2_t ujj = {uj, uj};
#pragma unroll
            for (int pr = (j + 1) / 2; pr < 32; ++pr) { const f32x4 a4 = av[j & 1][pr >> 1]; const f32x2_t a2 = (pr & 1) ? (f32x2_t){a4[2], a4[3]} : (f32x2_t){a4[0], a4[1]};
                if (2 * pr > j) U2[pr] = U2[pr] - a2 * ujj; else U2[pr][1] -= a2[1] * uj; }
            __builtin_amdgcn_sched_barrier(0); }
#pragma unroll
        for (int i = 0; i < 64; ++i) Tm[i * 64 + c] = U2[i >> 1][i & 1];
    }
    __syncthreads();
    { const int wq = wid & 3, r = lane & 15, kg = lane >> 4; const bool isu = wq < 2;
        int rstep = dir ? -132 : 132; asm volatile("" : "+v"(rstep));
        const float* src = (isu ? vs + wq * 64 : ks + (wq - 2) * 64) + (dir ? 63 * 132 : 0) + r;
        const float* scl = isu ? btd : wscS + dir * 64;
        bf16x8 Ahi[4][2], Alo[4][2];
#pragma unroll
        for (int m = 0; m < 4; ++m)
#pragma unroll
            for (int kx = 0; kx < 2; ++kx) split8(Tm + (16 * m + r) * 64 + 32 * kx + 8 * kg, Ahi[m][kx], Alo[m][kx]);
        float* ut = (float*)(rec + DN_UT); bf16_t* nw = (bf16_t*)(rec + DN_NEGW);
#pragma unroll
        for (int nt = 0; nt < 4; ++nt) { bf16x8 Bf[2];
#pragma unroll
            for (int kx = 0; kx < 2; ++kx) { const int j0 = 32 * kx + 8 * kg; const f32x4 s0 = *(const f32x4*)(scl + j0), s1 = *(const f32x4*)(scl + j0 + 4);
                u32x4 o;
#pragma unroll
                for (int e2 = 0; e2 < 4; ++e2) { const float x0 = src[(j0 + 2 * e2) * rstep + 16 * nt] * (e2 < 2 ? s0[2 * e2] : s1[2 * e2 - 4]), x1 = src[(j0 + 2 * e2 + 1) * rstep + 16 * nt] * (e2 < 2 ? s0[2 * e2 + 1] : s1[2 * e2 - 3]);
                    o[e2] = pk2(x0, x1); }
                Bf[kx] = __builtin_bit_cast(bf16x8, o); }
#pragma unroll
            for (int m = 0; m < 4; ++m) { f32x4 acc = (f32x4){0.f, 0.f, 0.f, 0.f};
#pragma unroll
                for (int kx = 0; kx < 2; ++kx) { acc = __builtin_amdgcn_mfma_f32_16x16x32_bf16(Ahi[m][kx], Bf[kx], acc, 0, 0, 0); acc = __builtin_amdgcn_mfma_f32_16x16x32_bf16(Alo[m][kx], Bf[kx], acc, 0, 0, 0); }
                const int i0 = 16 * m + 4 * kg, cc = 16 * nt + r;
                if (isu) { u32x2 o2; o2[0] = pk2(acc[0], acc[1]); o2[1] = pk2(acc[2], acc[3]); *(u32x2*)((bf16_t*)ut + (wq * 64 + cc) * 64 + i0) = o2; }
                else {
#pragma unroll
                    for (int jj = 0; jj < 4; ++jj) nw[(i0 + jj) * 128 + (wq - 2) * 64 + cc] = (bf16_t)f2bf(-acc[jj]); } }
        }
    }
    __syncthreads();
}

__device__ __forceinline__ void pc_phase(const Params& p, int l, float* lds) {
    const int tid = opaque_tid();
    const bf16_t* P = (const bf16_t*)(pws(p) + WS_P);
    bf16_t* Y = (bf16_t*)(pws(p) + WS_Y);
    const float* cw = pin(p, 9) + (size_t)l * 31 * 1024;
    const float* cb = pin(p, 10) + l * 1024;
    const bool g256 = (int)gridDim.x == 256;
    for (int kk = 0;; ++kk) {
        int it = (int)blockIdx.x + kk * (int)gridDim.x;
        if (g256 && kk == 5) it = (int)blockIdx.x >= 192 ? 1280 + (int)blockIdx.x - 192 : (1 << 30);
        if (it >= 1024 + 320) break;
#ifndef NO_DN
        if (it < 1024) { for (int rd = 0; rd < REP_DN; ++rd) dn_precompute(p, l, it >> 3, it & 7, lds); continue; }
#endif
#ifndef NO_CONV
        for (int rcv = 0; rcv < REP_CONV; ++rcv) {
        int r = it - 1024;
        int tl = opaque_tid();
        if (r < 192) { int base, L, p0, ch;
            if (r < 128) { const int tile = r & 7, bb = r >> 3; ch = 2 * tl; base = bb * 256; L = 256; p0 = tile * 32; }
            else { r -= 128; const int row = r & 15, bb = r >> 4; ch = 2 * (tl & 255); base = NCTX + bb * 1024 + row * 64; L = 64; p0 = (tl >> 8) * 32; }
            int st = 1; asm volatile("" : "+s"(st));
            conv_line<32>(P, Y, base, st, L, p0, ch, cw, cb);
        } else {
            r -= 192; const int col = 2 * (r & 31) + (tl >> 8), bb = r >> 5; const int ch = 512 + 2 * (tl & 255);
            int st = 64; asm volatile("" : "+s"(st));
            conv_line<16>(P, Y, NCTX + bb * 1024 + col, st, 16, 0, ch, cw, cb);
        }
        }
#endif
    }
}

__device__ __forceinline__ bf16x8 pack8(const f32x4& a, const f32x4& b) {
    u32x4 r; r[0] = pk2(a[0], a[1]); r[1] = pk2(a[2], a[3]); r[2] = pk2(b[0], b[1]); r[3] = pk2(b[2], b[3]);
    return __builtin_bit_cast(bf16x8, r);
}
__device__ __forceinline__ bf16x8 lds_afrag(const unsigned char* base) {
    const u32x2 lo = *(const u32x2*)base, hi = *(const u32x2*)(base + 32);
    u32x4 r; r[0] = lo[0]; r[1] = lo[1]; r[2] = hi[0]; r[3] = hi[1];
    return __builtin_bit_cast(bf16x8, r);
}
#define MFMA16(a, b, c) __builtin_amdgcn_mfma_f32_16x16x32_bf16((a), (b), (c), 0, 0, 0)

#define SCAN_IMG 67584
__device__ __forceinline__ const unsigned char* dn_rec(const Params& p, int gc, int h, int dir) { return pws(p) + WS_DN + (size_t)((gc * 8 + h) * 2 + dir) * DN_REC; }
__device__ __forceinline__ void scan_item(const Params& p, int l, int sq, int h, int dir, unsigned char* lds) {
    const int tid = opaque_tid(), lane = tid & 63, wid = __builtin_amdgcn_readfirstlane(tid >> 6), c = lane & 15, q = lane >> 4;
    const bool ctx = sq < 16;
    const int nc = ctx ? 4 : 16, gc0 = ctx ? sq * 4 : 64 + (sq - 16) * 16;
#define SCAN_GC(s_) (gc0 + (dir ? nc - 1 - (s_) : (s_)))
    if (wid >= 4) {
        const int tl = tid - 256;
        u32x4 Ra[14], Rb[14];
#define SCAN_LOAD(R_, s_) do { const unsigned char* r_ = dn_rec(p, SCAN_GC((s_) < nc ? (s_) : nc - 1), h, dir); _Pragma("unroll") for (int k = 0; k < 14; ++k) R_[k] = *(const u32x4*)(r_ + (size_t)(tl + 256 * k) * 16); } while (0)
#define SCAN_WRITE(R_, buf_) do { unsigned char* b_ = lds + (buf_) * SCAN_IMG; _Pragma("unroll") for (int k = 0; k < 14; ++k) { const int ch = tl + 256 * k; unsigned char* dst; \
            if (k < 4) dst = b_ + (ch >> 4) * 288 + (ch & 15) * 16; \
            else if (k < 8) { const int x = ch - 1024; dst = b_ + 18432 + (x >> 4) * 288 + (x & 15) * 16; } \
            else if (k < 12) { const int x = ch - 2048; dst = b_ + 36864 + (x >> 3) * 160 + (x & 7) * 16; } \
            else { const int x = ch - 3072; dst = b_ + 57344 + (x >> 3) * 160 + (x & 7) * 16; } \
            *(u32x4*)dst = R_[k]; } } while (0)
        SCAN_LOAD(Ra, 0); SCAN_LOAD(Rb, 1);
        SCAN_WRITE(Ra, 0);
        __syncthreads();
        for (int s = 0; s < nc; s += 2) {
            SCAN_LOAD(Ra, s + 2);
            SCAN_WRITE(Rb, 1);
            __syncthreads();
            SCAN_LOAD(Rb, s + 3);
            SCAN_WRITE(Ra, 0);
            __syncthreads();
        }
#undef SCAN_LOAD
#undef SCAN_WRITE
    } else {
        const int dv0 = wid * 32;
        bf16_t* O = (bf16_t*)(pws(p) + WS_R1) + (size_t)dir * NTOK * 1024;
        f32x4 S[2][8];
#pragma unroll
        for (int t = 0; t < 2; ++t)
#pragma unroll
            for (int m = 0; m < 8; ++m) S[t][m] = (f32x4){0.f, 0.f, 0.f, 0.f};
        if (!ctx) { const float* sd = pin(p, 2) + ((size_t)(((sq - 16) * 2 + l) * 2 + dir) * 8 + h) * 16384;
#pragma unroll
            for (int t = 0; t < 2; ++t)
#pragma unroll
                for (int m = 0; m < 8; ++m)
#pragma unroll
                    for (int j = 0; j < 4; ++j) S[t][m][j] = sd[(16 * m + 4 * q + j) * 128 + dv0 + 16 * t + c]; }
        u32x2 utn[2][4]; float egl;
        { const unsigned char* rec0 = dn_rec(p, SCAN_GC(0), h, dir);
#pragma unroll
            for (int t = 0; t < 2; ++t)
#pragma unroll
                for (int m = 0; m < 4; ++m) utn[t][m] = *(const u32x2*)((const bf16_t*)(rec0 + DN_UT) + (dv0 + 16 * t + c) * 64 + 16 * m + 4 * q);
            egl = *(const float*)(rec0 + DN_EGL); }
        __syncthreads();
        for (int s = 0; s < nc; ++s) {
            const int gc = SCAN_GC(s);
            const unsigned char* recn = dn_rec(p, SCAN_GC(s + 1 < nc ? s + 1 : s), h, dir);
            const unsigned char* L_negw = lds + (s & 1) * SCAN_IMG;
            const unsigned char* L_qdec = L_negw + 18432;
            const unsigned char* L_kdt = L_negw + 36864;
            const unsigned char* L_qkm = L_negw + 57344;
            f32x4 vn[2][4];
#pragma unroll
            for (int t = 0; t < 2; ++t)
#pragma unroll
                for (int m = 0; m < 4; ++m) vn[t][m] = bf4_to_f32(utn[t][m]);
            bf16x8 Bs[2][4];
#pragma unroll
            for (int t = 0; t < 2; ++t)
#pragma unroll
                for (int kb = 0; kb < 4; ++kb) Bs[t][kb] = pack8(S[t][2 * kb], S[t][2 * kb + 1]);
            const unsigned char* aN = L_negw + c * 288 + 8 * q;
            const unsigned char* aQ = L_qdec + c * 288 + 8 * q;
            const unsigned char* aM = L_qkm + c * 160 + 8 * q;
            const unsigned char* aK = L_kdt + c * 160 + 8 * q;
#define SB_ __builtin_amdgcn_sched_barrier(0)
#define LD_N(F, m) do { _Pragma("unroll") for (int kb = 0; kb < 4; ++kb) F[kb] = lds_afrag(aN + (m) * 16 * 288 + 64 * kb); } while (0)
#define LD_Q(F, m) do { _Pragma("unroll") for (int kb = 0; kb < 4; ++kb) F[kb] = lds_afrag(aQ + (m) * 16 * 288 + 64 * kb); } while (0)
#define LD_M(F, m) do { _Pragma("unroll") for (int kb = 0; kb < 2; ++kb) F[kb] = lds_afrag(aM + (m) * 16 * 160 + 64 * kb); } while (0)
#define LD_K(F, m2) do { _Pragma("unroll") for (int mm = 0; mm < 2; ++mm) _Pragma("unroll") for (int kb = 0; kb < 2; ++kb) F[mm * 2 + kb] = lds_afrag(aK + (2 * (m2) + mm) * 16 * 160 + 64 * kb); } while (0)
#define MF_N(F, m) do { _Pragma("unroll") for (int kb = 0; kb < 4; ++kb) { vn[0][m] = MFMA16(F[kb], Bs[0][kb], vn[0][m]); vn[1][m] = MFMA16(F[kb], Bs[1][kb], vn[1][m]); } } while (0)
#define MF_Q(F, m) do { oa0 = (f32x4){0.f, 0.f, 0.f, 0.f}; oa1 = oa0; \
            _Pragma("unroll") for (int kb = 0; kb < 4; ++kb) { oa0 = MFMA16(F[kb], Bs[0][kb], oa0); oa1 = MFMA16(F[kb], Bs[1][kb], oa1); } } while (0)
#define MF_M(F, m) do { f32x4 a0 = oa0, a1 = oa1; \
            _Pragma("unroll") for (int kb = 0; kb < 2; ++kb) { a0 = MFMA16(F[kb], Bv[0][kb], a0); a1 = MFMA16(F[kb], Bv[1][kb], a1); } \
            _Pragma("unroll") for (int j = 0; j < 4; ++j) { const int i = 16 * (m) + 4 * q + j; const int tok = gc * 64 + (dir ? 63 - i : i); \
                bf16_t* op = O + (size_t)tok * 1024 + h * 128 + dv0 + c; op[0] = (bf16_t)f2bf(a0[j]); op[16] = (bf16_t)f2bf(a1[j]); } } while (0)
#define MF_K(F, m2) do { _Pragma("unroll") for (int mm = 0; mm < 2; ++mm) { f32x4 a0 = S[0][2 * (m2) + mm] * egl, a1 = S[1][2 * (m2) + mm] * egl; \
            _Pragma("unroll") for (int kb = 0; kb < 2; ++kb) { a0 = MFMA16(F[mm * 2 + kb], Bv[0][kb], a0); a1 = MFMA16(F[mm * 2 + kb], Bv[1][kb], a1); } \
            S[0][2 * (m2) + mm] = a0; S[1][2 * (m2) + mm] = a1; } } while (0)
            bf16x8 X[4], Y[4]; f32x4 oa0, oa1;
            LD_N(X, 0); SB_;
            LD_N(Y, 1); SB_; MF_N(X, 0); SB_;
            LD_N(X, 2); SB_; MF_N(Y, 1); SB_;
            LD_N(Y, 3); SB_; MF_N(X, 2); SB_;
            LD_Q(X, 0); SB_; MF_N(Y, 3); SB_;
            bf16x8 Bv[2][2];
#pragma unroll
            for (int t = 0; t < 2; ++t)
#pragma unroll
                for (int kb = 0; kb < 2; ++kb) Bv[t][kb] = pack8(vn[t][2 * kb], vn[t][2 * kb + 1]);
#pragma unroll
            for (int t = 0; t < 2; ++t)
#pragma unroll
                for (int m = 0; m < 4; ++m) utn[t][m] = *(const u32x2*)((const bf16_t*)(recn + DN_UT) + (dv0 + 16 * t + c) * 64 + 16 * m + 4 * q);
            SB_;
            LD_M(Y, 0); SB_; MF_Q(X, 0); SB_;
            LD_Q(X, 1); SB_; MF_M(Y, 0); SB_;
            LD_M(Y, 1); SB_; MF_Q(X, 1); SB_;
            LD_Q(X, 2); SB_; MF_M(Y, 1); SB_;
            LD_M(Y, 2); SB_; MF_Q(X, 2); SB_;
            LD_Q(X, 3); SB_; MF_M(Y, 2); SB_;
            LD_M(Y, 3); SB_; MF_Q(X, 3); SB_;
            LD_K(X, 0); SB_; MF_M(Y, 3); SB_;
            LD_K(Y, 1); SB_; MF_K(X, 0); SB_;
            LD_K(X, 2); SB_; MF_K(Y, 1); SB_;
            LD_K(Y, 3); SB_; MF_K(X, 2); SB_;
            MF_K(Y, 3);
#undef SB_
#undef LD_N
#undef LD_Q
#undef LD_M
#undef LD_K
#undef MF_N
#undef MF_Q
#undef MF_M
#undef MF_K
            egl = *(const float*)(recn + DN_EGL);
            __syncthreads();
        }
        if (ctx) { float* so = pout(p) + (size_t)NTOK * DM + ((size_t)((sq * 2 + l) * 2 + dir) * 8 + h) * 16384;
#pragma unroll
            for (int t = 0; t < 2; ++t)
#pragma unroll
                for (int m = 0; m < 8; ++m)
#pragma unroll
                    for (int j = 0; j < 4; ++j) so[(16 * m + 4 * q + j) * 128 + dv0 + 16 * t + c] = S[t][m][j]; }
    }
#undef SCAN_GC
}

__device__ __forceinline__ void lna_group(const Params& p, int l, int grp) {
    const int tid = opaque_tid(), lane = tid & 63, wid = tid >> 6;
    const int tok = grp * 8 + wid;
    const bf16_t* y = (const bf16_t*)(pws(p) + WS_Y) + (size_t)tok * 1024;
    const bf16_t* az = (const bf16_t*)(pws(p) + WS_P) + (size_t)tok * NP + C_AZ;
    bf16_t* U = (bf16_t*)(pws(p) + WS_U) + (size_t)tok * 2048;
    const float* lg = pin(p, 11) + l * 1024; const float* lb = pin(p, 12) + l * 1024;
    f32x4 v[4]; float s = 0.f;
#pragma unroll
    for (int i = 0; i < 4; ++i) { v[i] = bf4_to_f32(*(const u32x2*)(y + (lane + 64 * i) * 4)); s += v[i][0] + v[i][1] + v[i][2] + v[i][3]; }
    const float mu = wave_sum(s) * (1.0f / 1024.0f);
    float s2 = 0.f;
#pragma unroll
    for (int i = 0; i < 4; ++i) { v[i] -= mu; s2 += v[i][0] * v[i][0] + v[i][1] * v[i][1] + v[i][2] * v[i][2] + v[i][3] * v[i][3]; }
    const float rstd = rsqrtf(wave_sum(s2) * (1.0f / 1024.0f) + EPS);
#pragma unroll
    for (int i = 0; i < 4; ++i) { const int cc = (lane + 64 * i) * 4; const f32x4 g = *(const f32x4*)(lg + cc), bb = *(const f32x4*)(lb + cc);
        const u32x2 zz = *(const u32x2*)(az + cc);
        f32x4 o = v[i] * rstd * g + bb;
        const float z0 = __uint_as_float(zz[0] << 16), z1 = __uint_as_float(zz[0] & 0xffff0000u), z2 = __uint_as_float(zz[1] << 16), z3 = __uint_as_float(zz[1] & 0xffff0000u);
        u32x2 ov; ov[0] = pk2(siluf_(o[0]) * siluf_(z0), siluf_(o[1]) * siluf_(z1)); ov[1] = pk2(siluf_(o[2]) * siluf_(z2), siluf_(o[3]) * siluf_(z3));
        *(u32x2*)(U + cc) = ov; }
}

__device__ __forceinline__ void ps_phase(const Params& p, int l, unsigned char* lds) {
    const int b = blockIdx.x, G = gridDim.x;
    for (int r = 0;; ++r) { const int id = r * G + (r == 0 ? b : (b + 64 * G - 64) % G); if (id >= 320) break;
        const int sq = id < 64 ? 16 + (id >> 4) : ((id - 64) >> 4);
        for (int rsc = 0; rsc < REP_SCAN; ++rsc) scan_item(p, l, sq, (id >> 1) & 7, id & 1, lds); }
    const int gs = G == 256 ? (b >= 64 ? b - 64 : 1024) : b, gst = G == 256 ? 192 : G;
    for (int rl = 0; rl < REP_LNA; ++rl) for (int g = gs; g < 1024; g += gst) lna_group(p, l, g);
    if (l == 0) drain_tiles(p, 1 << 20, lds);
}

__device__ __forceinline__ void pnb_phase(const Params& p, int l) {
    const int tid = opaque_tid(), lane = tid & 63, wid = tid >> 6;
    const bf16_t* Of = (const bf16_t*)(pws(p) + WS_R1); const bf16_t* Ob = Of + (size_t)NTOK * 1024;
    const float* hg = pin(p, 17) + l * 128;
    for (int tok = blockIdx.x * 8 + wid; tok < NTOK; tok += gridDim.x * 8) {
        const int cb = lane * 16;
        f32x4 v[4]; float ss = 0.f;
#pragma unroll
        for (int i = 0; i < 4; ++i) { v[i] = bf4_to_f32(*(const u32x2*)(Of + (size_t)tok * 1024 + cb + 4 * i)) + bf4_to_f32(*(const u32x2*)(Ob + (size_t)tok * 1024 + cb + 4 * i));
            ss += v[i][0] * v[i][0] + v[i][1] * v[i][1] + v[i][2] * v[i][2] + v[i][3] * v[i][3]; }
        ss += __shfl_xor(ss, 1); ss += __shfl_xor(ss, 2); ss += __shfl_xor(ss, 4);
        const float rstd = rsqrtf(ss * (1.0f / 128.0f) + EPS);
        const bf16_t* zb = (const bf16_t*)(pws(p) + WS_P) + (size_t)tok * NP + C_ZB + cb;
        bf16_t* U = (bf16_t*)(pws(p) + WS_U) + (size_t)tok * 2048 + 1024 + cb;
        const u32x4 z0 = *(const u32x4*)zb, z1 = *(const u32x4*)(zb + 8);
        float o[16];
#pragma unroll
        for (int i = 0; i < 4; ++i) { const f32x4 g = *(const f32x4*)(hg + ((cb + 4 * i) & 127));
#pragma unroll
            for (int e = 0; e < 4; ++e) o[4 * i + e] = v[i][e] * rstd * g[e]; }
        u32x4 r0, r1;
#pragma unroll
        for (int w2 = 0; w2 < 4; ++w2) { const unsigned za = z0[w2], zc = z1[w2];
            r0[w2] = pk2(o[2 * w2] * siluf_(__uint_as_float(za << 16)), o[2 * w2 + 1] * siluf_(__uint_as_float(za & 0xffff0000u)));
            r1[w2] = pk2(o[8 + 2 * w2] * siluf_(__uint_as_float(zc << 16)), o[8 + 2 * w2 + 1] * siluf_(__uint_as_float(zc & 0xffff0000u))); }
        *(u32x4*)U = r0; *(u32x4*)(U + 8) = r1;
    }
}

#define XB_TMO      128
#define XB_XCNT(j)  (256  + 64 * (j))
#define XB_XSUB(j)  (1280 + 64 * (j))
#define XB_XGEN(j)  (2304 + 64 * (j))
#define XB_TOP      3328
#define XB_TOPGEN   3392
#define XCD_BAR_WORDS 3456
#define XB_SPIN_CAP (1u << 18)

__device__ __forceinline__ unsigned xb_ld(unsigned* p)              { return __hip_atomic_load(p, __ATOMIC_RELAXED, __HIP_MEMORY_SCOPE_AGENT); }
__device__ __forceinline__ unsigned xb_add(unsigned* p, unsigned v) { return __hip_atomic_fetch_add(p, v, __ATOMIC_RELAXED, __HIP_MEMORY_SCOPE_AGENT); }
__device__ __forceinline__ unsigned xb_xcc_id() { return (unsigned)__builtin_amdgcn_s_getreg((3 << 11) | 20) & 0xFu; }
#define XB_SPIN(cond, bar) do { unsigned _sp = 0; while (cond) { __builtin_amdgcn_s_sleep(1); \
    if ((++_sp & 255u) == 0u) { if (xb_ld(&(bar)[XB_TMO])) break; if (_sp > XB_SPIN_CAP) { atomicAdd(&(bar)[XB_TMO], 1u); break; } } } } while (0)

struct XcdBarrier {
    unsigned* bar; unsigned x;
    volatile LAS unsigned* st;
};

__device__ __forceinline__ XcdBarrier xcd_barrier_post(unsigned* bar, volatile LAS unsigned* st) {
    XcdBarrier b; b.bar = bar; b.x = xb_xcc_id(); b.st = st;
    if (threadIdx.x == 0) (void)xb_add(&bar[XB_XCNT(b.x)], 1u);
    return b;
}
__device__ __forceinline__ void xcd_barrier_complete(unsigned* bar, unsigned x, unsigned& nloc, unsigned& nx) {
    const unsigned G = gridDim.x * gridDim.y * gridDim.z;
    unsigned sum, cnt, mine, sp = 0u;
    for (;;) {
        sum = 0u; cnt = 0u; mine = 0u;
#pragma unroll
        for (unsigned j = 0; j < 16; ++j) { const unsigned c = xb_ld(&bar[XB_XCNT(j)]); sum += c; cnt += (c > 0u) ? 1u : 0u; mine = (j == x) ? c : mine; }
        if (sum == G) break;
        __builtin_amdgcn_s_sleep(1);
        if ((++sp & 255u) == 0u) { if (xb_ld(&bar[XB_TMO])) break; if (sp > XB_SPIN_CAP) { atomicAdd(&bar[XB_TMO], 1u); break; } }
    }
    nloc = mine > 0u ? mine : 1u; nx = cnt > 0u ? cnt : 1u;
}

__device__ __forceinline__ void xcd_barrier(const XcdBarrier& b) {
    asm volatile("s_waitcnt vmcnt(0)" ::: "memory");
    __syncthreads();
    if (threadIdx.x == 0) {
        unsigned* bar = b.bar;
        __builtin_amdgcn_s_waitcnt(0);
        unsigned nloc = b.st[0], nx = b.st[1];
        if (nloc == 0u) { xcd_barrier_complete(bar, b.x, nloc, nx); b.st[0] = nloc; b.st[1] = nx; }
        const unsigned old = xb_add(&bar[XB_XSUB(b.x)], 1u);
        const unsigned gen = old / nloc;
        if (old + 1u == (gen + 1u) * nloc) {
            __builtin_amdgcn_fence(__ATOMIC_RELEASE, "agent");
            asm volatile("s_waitcnt vmcnt(0)" ::: "memory");
            const unsigned og = xb_add(&bar[XB_TOP], 1u);
            const unsigned tg = og / nx;
            if (og + 1u == (tg + 1u) * nx) xb_add(&bar[XB_TOPGEN], 1u);
            else XB_SPIN(xb_ld(&bar[XB_TOPGEN]) == tg, bar);
            __builtin_amdgcn_fence(__ATOMIC_ACQUIRE, "agent");
            xb_add(&bar[XB_XGEN(b.x)], 1u);
            asm volatile("s_waitcnt vmcnt(0)" ::: "memory");
        } else {
            XB_SPIN(xb_ld(&bar[XB_XGEN(b.x)]) == gen, bar);
            __builtin_amdgcn_fence(__ATOMIC_ACQUIRE, "agent");
            asm volatile("s_waitcnt vmcnt(0)" ::: "memory");
        }
    }
    __syncthreads();
}

#ifndef REP0
#define REP0 1
#endif
#ifndef REP1
#define REP1 1
#endif
#ifndef REP2
#define REP2 1
#endif
#ifndef REP3
#define REP3 1
#endif
#ifndef REP4
#define REP4 1
#endif
#ifndef REP5
#define REP5 1
#endif
#ifndef REP6
#define REP6 1
#endif
#ifndef REP7
#define REP7 1
#endif
__global__ void __launch_bounds__(NTHR) fwd_megakernel(Params p) {
    extern __shared__ __attribute__((aligned(16))) unsigned char lds[];
    cg::grid_group grid = cg::this_grid();
    const int lo = p.ph_lo, hi = p.ph_hi;
    if (lo < 0) grid.sync();
    if (threadIdx.x < 2) ((volatile LAS unsigned*)((LAS unsigned char*)lds + LDS_BARST))[threadIdx.x] = 0u;
    __syncthreads();
    const XcdBarrier xbar = xcd_barrier_post((unsigned*)(pws(p) + WS_BARW), (volatile LAS unsigned*)((LAS unsigned char*)lds + LDS_BARST));
#define IN(k) (lo <= (k) && (k) < hi)
#ifndef SYNC_REP
#define SYNC_REP 1
#endif
#define SEAM(k) do { if (IN(k) && IN((k) + 1)) for (int sr = 0; sr < SYNC_REP; ++sr) { xcd_barrier(xbar); } } while (0)
#if (!defined(ONLY) || ONLY == 0) && !defined(SKIP0)
    if (IN(0)) for (int rp = 0; rp < REP0; ++rp) p0_prologue(p, (float*)lds);
#endif
    SEAM(0);
    for (int l = 0; l < 2; ++l) {
        const int pb = 1 + 7 * l;
        unsigned char* ws = pws(p);
#if (!defined(ONLY) || ONLY == 1) && !defined(SKIP1)
        if (IN(pb)) for (int rp = 0; rp < REP1; ++rp) pn_norm(p, l);
#endif
        SEAM(pb);
#if (!defined(ONLY) || ONLY == 2) && !defined(SKIP2)
        if (IN(pb + 1)) for (int rp = 0; rp < REP2; ++rp) {
            pg8::Gemm g{(const bf16_t*)(ws + WS_R1), (const bf16_t*)(ws + WS_WIN + l * SZ_WIN1), NTOK, NP, DM, DM};
            pg8::StaticOrder S; S.init(NTOK, NP, (int)gridDim.x, (int)blockIdx.x);
            EpiP E{(bf16_t*)(ws + WS_P), (float*)(ws + WS_BA)};
            pg8::gemm_phase<EpiP, pg8::StaticOrder, false, GEMM_ALIGN, GEMM_SP2>((LAS unsigned char*)lds, g, S, E, nullptr);
            if (l == 0 && (int)gridDim.x == 256 && (int)blockIdx.x >= 160) drain_tiles(p, PG1_TILES, lds);
        }
#endif
        SEAM(pb + 1);
#if (!defined(ONLY) || ONLY == 3) && !defined(SKIP3)
        if (IN(pb + 2)) for (int rp = 0; rp < REP3; ++rp) pc_phase(p, l, (float*)lds);
#endif
        SEAM(pb + 2);
#if (!defined(ONLY) || ONLY == 4) && !defined(SKIP4)
        if (IN(pb + 3)) for (int rp = 0; rp < REP4; ++rp) ps_phase(p, l, lds);
#endif
        SEAM(pb + 3);
#if (!defined(ONLY) || ONLY == 5) && !defined(SKIP5)
        if (IN(pb + 4)) for (int rp = 0; rp < REP5; ++rp) pnb_phase(p, l);
#endif
        SEAM(pb + 4);
#if (!defined(ONLY) || ONLY == 6) && !defined(SKIP6)
        if (IN(pb + 5)) for (int rp = 0; rp < REP6; ++rp) {
            pg8::Gemm g{(const bf16_t*)(ws + WS_U), (const bf16_t*)(ws + WS_WP2 + l * SZ_SQ), NTOK, DM, 1024, DM};
            ChainOrder S; S.init(NTOK, DM, (int)gridDim.x, (int)blockIdx.x);
            EpiMG E{(const bf16_t*)(ws + WS_P), (bf16_t*)(ws + WS_R1)};
            pg8::gemm_phase<EpiMG, ChainOrder, false, GEMM_ALIGN, GEMM_SP2>((LAS unsigned char*)lds, g, S, E, nullptr);
        }
#endif
        SEAM(pb + 5);
#if (!defined(ONLY) || ONLY == 7) && !defined(SKIP7)
        if (IN(pb + 6)) for (int rp = 0; rp < REP7; ++rp) {
            pg8::Gemm g{(const bf16_t*)(ws + WS_R1), (const bf16_t*)(ws + WS_WO + l * SZ_SQ), NTOK, DM, DM, DM};
            pg8::StaticOrder S; S.init(NTOK, DM, (int)gridDim.x, (int)blockIdx.x);
            EpiX E{pin(p, 0), pin(p, 1), l == 0 ? nullptr : (const float*)(ws + WS_X1), (const float*)(ws + WS_MOD) + (size_t)l * 5 * 6144 + 4096, l == 0 ? (float*)(ws + WS_X1) : (float*)(ws + WS_P)};
            pg8::gemm_phase<EpiX, pg8::StaticOrder, false, GEMM_ALIGN, GEMM_SP2>((LAS unsigned char*)lds, g, S, E, nullptr);
        }
#endif
        SEAM(pb + 6);
    }
#if (!defined(ONLY) || ONLY == 8) && !defined(SKIP8)
    if (IN(15)) pf_final(p);
#endif
}

#ifndef MK_N_LAUNCHES
#define MK_N_LAUNCHES 1
#endif
extern "C" void kernel_launch(void* const* d_in, const int* in_sizes, int n_in, void* d_out, int out_size, void* d_ws, size_t ws_size, hipStream_t stream) {
    static int grid = 0;
    if (grid == 0) {
        int dev = 0, cus = 0, per_cu = 0;
        hipGetDevice(&dev);
        hipDeviceGetAttribute(&cus, hipDeviceAttributeMultiprocessorCount, dev);
        if (hipFuncSetAttribute((const void*)fwd_megakernel, hipFuncAttributeMaxDynamicSharedMemorySize, LDS_BYTES) != hipSuccess) { fprintf(stderr, "kernel_launch: hipFuncSetAttribute failed\n"); grid = -1; return; }
        if (hipOccupancyMaxActiveBlocksPerMultiprocessor(&per_cu, (const void*)fwd_megakernel, NTHR, LDS_BYTES) != hipSuccess || per_cu < 1) { fprintf(stderr, "kernel_launch: occupancy query says %d blocks per CU\n", per_cu); grid = -1; return; }
        grid = cus * 1;
        if (n_in != 21 || ws_size < WS_END2) { fprintf(stderr, "kernel_launch: unexpected n_in %d / ws %zu\n", n_in, ws_size); grid = -1; return; }
    }
    if (grid < 0) return;
    if (hipMemsetAsync((char*)d_ws + WS_BARW, 0, 16384, stream) != hipSuccess) { fprintf(stderr, "kernel_launch: memset failed\n"); return; }
    Params p{};
    for (int i = 0; i < 21; ++i) p.in[i] = (const float*)d_in[i];
    p.out = (float*)d_out; p.ws = (unsigned char*)d_ws;
#if MK_N_LAUNCHES == 1
    p.ph_lo = 0; p.ph_hi = 16;
    void* args[] = {&p};
    hipError_t e = hipLaunchCooperativeKernel((const void*)fwd_megakernel, dim3(grid), dim3(NTHR), args, LDS_BYTES, stream);
    if (e != hipSuccess) fprintf(stderr, "cooperative launch failed: %s (grid %d)\n", hipGetErrorString(e), grid);
#else
    for (int ph = 0; ph < 16; ++ph) { p.ph_lo = ph; p.ph_hi = ph + 1;
        hipLaunchKernelGGL(fwd_megakernel, dim3(grid), dim3(NTHR), LDS_BYTES, stream, p); }
#endif
}
```

```cpp
#include <hip/hip_runtime.h>
#include <hip/hip_cooperative_groups.h>
#include <cstdio>
#include <cstdint>
namespace cg = cooperative_groups;
namespace pg8 {
#define PG8_LAS __attribute__((address_space(3)))
typedef unsigned short bf16_t;
typedef short bf16x8 __attribute__((ext_vector_type(8)));
typedef float f32x4 __attribute__((ext_vector_type(4)));
typedef unsigned u32x4 __attribute__((ext_vector_type(4)));
constexpr int BM = 256, BK = 64, HALF = 128, HTB = HALF * BK * 2  , STAGE_BYTES = 8 * HTB, NXCD = 8, WGM = 8;

__host__ __device__ __forceinline__ int lds_byte(int r, int c) { const int st = (r >> 4) * 2 + (c >> 5), rr = r & 15, cc = c & 31, ob = rr * 64 + cc * 2; return st * 1024 + (ob ^ (((ob >> 9) & 1) << 5)); }
__host__ __device__ __forceinline__ void stage_rc(int b, int& R, int& C) { const int st = b / 1024, sb = b % 1024, swz = sb ^ (((sb >> 9) & 1) << 5); R = (st >> 1) * 16 + swz / 64; C = (st & 1) * 32 + (swz % 64) / 2; }
__host__ __device__ __forceinline__ int perm32(int rho) { const int n = rho >> 4, i = rho & 15; return 8 * (i >> 2) + 4 * n + (i & 3); }

struct Unit { int pm, pn, kh; };
struct Gemm { const bf16_t* A; const bf16_t* Bt; int M, N, K, lda; };

struct StaticOrder {
    int nM, nN, nwg, G, c;
    __host__ __device__ void init(int M, int N, int G_, int c_) { nM = M / BM; nN = N / BM; nwg = nM * nN; G = G_; c = c_; }
    __host__ __device__ bool next(int i, Unit& u) const {
        const long L = (long)i * G + c; if (L >= nwg) return false;
        int wgid = (int)L; { const int q = nwg / NXCD, r = nwg % NXCD, xcd = wgid % NXCD, off = wgid / NXCD; wgid = (xcd < r ? xcd * (q + 1) : r * (q + 1) + (xcd - r) * q) + off; }
        const int nig = WGM * nN, gid = wgid / nig, fm = gid * WGM, gsz = (nM - fm) < WGM ? (nM - fm) : WGM;
        u.pm = fm + ((wgid % nig) % gsz); u.pn = (wgid % nig) / gsz; u.kh = 0; return true;
    }
    __device__ __forceinline__ void a_ready(const Unit&) const {}
    __device__ __forceinline__ void done(const Unit&) const {}
};
__device__ __forceinline__ unsigned cvt_pk_bf16(float lo, float hi) { unsigned r; asm volatile("v_cvt_pk_bf16_f32 %0, %1, %2" : "=v"(r) : "v"(lo), "v"(hi)); return r; }
template <class Epi, class Sched, bool STAMP = false, bool ALIGN_EPI = false, bool SP2 = false>
__device__ __forceinline__ void gemm_phase(PG8_LAS unsigned char* lds, const Gemm g, const Sched& S, const Epi& E, unsigned long long* stamps) {
    int tid_ = threadIdx.x; asm volatile("" : "+v"(tid_)); const int tid = tid_, wid = __builtin_amdgcn_readfirstlane(tid >> 6), lane = tid & 63, wr = wid >> 2, wc = wid & 3, fr = lane & 15, fq = lane >> 4;
    const int K = g.K, nt = K / BK;
    int ts_lo = 0, ts_hi = 0, nts = 0; const unsigned long long rt_entry = STAMP ? (unsigned long long)wall_clock64() : 0ull;
#define PG8_STAMP() do { if (STAMP && wid == 0 && nts < 64) { const unsigned long long _c = (unsigned long long)clock64(); \
        ts_lo = (lane == nts) ? (int)(unsigned)_c : ts_lo; ts_hi = (lane == nts) ? (int)(unsigned)(_c >> 32) : ts_hi; ++nts; } } while (0)
    PG8_STAMP();
    unsigned voffA[2], voffB[2];
#pragma unroll
    for (int i = 0; i < 2; ++i) { int R, C; stage_rc(tid * 16 + i * 8192, R, C); const int Rb = Epi::PERM ? ((R & ~31) + perm32(R & 31)) : R;
        voffA[i] = (unsigned)(R * g.lda + C) * 2u; voffB[i] = (unsigned)(Rb * g.lda + C) * 2u; }
    const size_t kstep = (size_t)(BK * 2);
    const size_t hstep = (size_t)HALF * g.lda * 2; const size_t khstep = (size_t)K * 2;
    const size_t tstep = 2 * hstep;
    const unsigned ldsw = (unsigned)wid * 1024u;
    const int aoff = lds_byte(wr * 64 + fr, fq * 8), boff = lds_byte(wc * 32 + fr, fq * 8);
#define PG8_SA(b, h) (((b) * 2 + (h)) * HTB)
#define PG8_SB(b, h) ((4 + (b) * 2 + (h)) * HTB)
#define PG8_STAGE(bufoff, gbase, voff) do { _Pragma("unroll") for (int _i = 0; _i < 2; ++_i) \
        __builtin_amdgcn_global_load_lds((const unsigned*)((const char*)(gbase) + (voff)[_i]), (PG8_LAS unsigned*)(lds + (bufoff) + ldsw + _i * 8192), 16, 0, 0); } while (0)
#define PG8_LDA(dst, b, h) do { _Pragma("unroll") for (int m = 0; m < 4; ++m) _Pragma("unroll") for (int k = 0; k < 2; ++k) dst[m][k] = *(const PG8_LAS bf16x8*)(lds + PG8_SA(b, h) + aoff + m * 2048 + k * 1024); } while (0)
#define PG8_LDB(dst, b, h) do { _Pragma("unroll") for (int n = 0; n < 2; ++n) _Pragma("unroll") for (int k = 0; k < 2; ++k) dst[n][k] = *(const PG8_LAS bf16x8*)(lds + PG8_SB(b, h) + boff + n * 2048 + k * 1024); } while (0)
#define PG8_MMA(ai, bj, At, Bt) do { __builtin_amdgcn_s_setprio(1); _Pragma("unroll") for (int m = 0; m < 4; ++m) _Pragma("unroll") for (int n = 0; n < 2; ++n) _Pragma("unroll") for (int k = 0; k < 2; ++k) \
        acc[ai][bj][m][n] = __builtin_amdgcn_mfma_f32_16x16x32_bf16(Bt[n][k], At[m][k], acc[ai][bj][m][n], 0, 0, 0); __builtin_amdgcn_s_setprio(0); } while (0)
#define PG8_WAIT_V(n) asm volatile("s_waitcnt vmcnt(" #n ")" ::: "memory")
#define PG8_WAIT_L(n) asm volatile("s_waitcnt lgkmcnt(" #n ")" ::: "memory")
#define PG8_BAR __builtin_amdgcn_s_barrier()
#define PG8_SCHED __builtin_amdgcn_sched_barrier(0)
    Unit cur, nxt; int ui = 0;
    if (!S.next(0, cur)) return;
    f32x4 acc[2][2][4][2];
#pragma unroll
    for (int a = 0; a < 2; ++a)
#pragma unroll
        for (int b = 0; b < 2; ++b)
#pragma unroll
            for (int m = 0; m < 4; ++m)
#pragma unroll
                for (int n = 0; n < 2; ++n) acc[a][b][m][n] = (f32x4){0.f, 0.f, 0.f, 0.f};
    bf16x8 At[4][2], B0[2][2], B1[2][2];
    const char* cA = (const char*)g.A + (size_t)cur.pm * tstep + cur.kh * khstep; const char* cB = (const char*)g.Bt + (size_t)cur.pn * tstep + cur.kh * khstep;
    S.a_ready(cur);
    if constexpr (SP2) {
        PG8_STAGE(PG8_SB(0, 0), cB, voffB); PG8_STAGE(PG8_SB(0, 1), cB + hstep, voffB); PG8_STAGE(PG8_SA(0, 0), cA, voffA); PG8_STAGE(PG8_SA(0, 1), cA + hstep, voffA);
        if (wr == 1) PG8_BAR;
        PG8_WAIT_V(2); PG8_BAR;
        PG8_STAGE(PG8_SB(1, 0), cB + kstep, voffB); PG8_STAGE(PG8_SA(1, 0), cA + kstep, voffA); PG8_STAGE(PG8_SB(1, 1), cB + hstep + kstep, voffB);
        PG8_WAIT_V(6); PG8_BAR;
    } else {
    PG8_STAGE(PG8_SB(0, 0), cB, voffB); PG8_STAGE(PG8_SA(0, 0), cA, voffA); PG8_STAGE(PG8_SB(0, 1), cB + hstep, voffB); PG8_STAGE(PG8_SA(0, 1), cA + hstep, voffA);
    if (wr == 1) PG8_BAR;
    PG8_WAIT_V(4); PG8_BAR;
    PG8_STAGE(PG8_SB(1, 0), cB + kstep, voffB); PG8_STAGE(PG8_SA(1, 0), cA + kstep, voffA); PG8_STAGE(PG8_SB(1, 1), cB + hstep + kstep, voffB);
    PG8_WAIT_V(6); PG8_BAR;
    }
    PG8_STAMP();
    for (;;) {
        const bool has_next = S.next(ui + 1, nxt);
        const char* nA = has_next ? (const char*)g.A + (size_t)nxt.pm * tstep + nxt.kh * khstep : cA; const char* nB = has_next ? (const char*)g.Bt + (size_t)nxt.pn * tstep + nxt.kh * khstep : cB;
        for (int t = 0; t < nt; t += 2) {
            const bool last = (t == nt - 2);
            const char* a1 = cA + (size_t)(t + 1) * kstep;
            const char* a2 = last ? nA : cA + (size_t)(t + 2) * kstep; const char* b2 = last ? nB : cB + (size_t)(t + 2) * kstep;
            const char* a3 = a2 + kstep; const char* b3 = b2 + kstep;
            if (last && has_next) S.a_ready(nxt);
            if constexpr (SP2) {
            PG8_LDB(B0, 0, 0); PG8_LDB(B1, 0, 1); PG8_SCHED; PG8_LDA(At, 0, 0); PG8_STAGE(PG8_SA(1, 1), a1 + hstep, voffA);
            PG8_WAIT_V(8); PG8_WAIT_L(0); PG8_BAR; PG8_MMA(0, 0, At, B0); PG8_MMA(0, 1, At, B1); PG8_BAR; PG8_SCHED;
            PG8_LDA(At, 0, 1); PG8_STAGE(PG8_SB(0, 0), b2, voffB); PG8_STAGE(PG8_SB(0, 1), b2 + hstep, voffB); PG8_STAGE(PG8_SA(0, 0), a2, voffA);
            PG8_WAIT_V(8); PG8_WAIT_L(0); PG8_BAR; PG8_MMA(1, 0, At, B0); PG8_MMA(1, 1, At, B1); PG8_BAR; PG8_SCHED;
            PG8_LDB(B0, 1, 0); PG8_LDB(B1, 1, 1); PG8_SCHED; PG8_LDA(At, 1, 0); PG8_STAGE(PG8_SA(0, 1), a2 + hstep, voffA);
            PG8_WAIT_V(8); PG8_WAIT_L(0); PG8_BAR; PG8_MMA(0, 0, At, B0); PG8_MMA(0, 1, At, B1); PG8_BAR; PG8_SCHED;
            PG8_LDA(At, 1, 1); PG8_STAGE(PG8_SB(1, 0), b3, voffB); PG8_STAGE(PG8_SB(1, 1), b3 + hstep, voffB); PG8_STAGE(PG8_SA(1, 0), a3, voffA);
            PG8_WAIT_V(8); PG8_WAIT_L(0); PG8_BAR; PG8_MMA(1, 0, At, B0); PG8_MMA(1, 1, At, B1); PG8_BAR; PG8_SCHED;
            } else {
            PG8_LDB(B0, 0, 0); PG8_SCHED; PG8_LDA(At, 0, 0); PG8_STAGE(PG8_SA(1, 1), a1 + hstep, voffA);
            PG8_WAIT_L(8); PG8_BAR; PG8_WAIT_L(0); PG8_MMA(0, 0, At, B0); PG8_BAR; PG8_SCHED;
            PG8_LDB(B1, 0, 1); PG8_STAGE(PG8_SB(0, 0), b2, voffB);
            PG8_BAR; PG8_WAIT_L(0); PG8_MMA(0, 1, At, B1); PG8_BAR;
            PG8_LDA(At, 0, 1); PG8_STAGE(PG8_SA(0, 0), a2, voffA);
            PG8_BAR; PG8_WAIT_L(0); PG8_MMA(1, 0, At, B0); PG8_BAR; PG8_SCHED;
            PG8_STAGE(PG8_SB(0, 1), b2 + hstep, voffB);
            PG8_WAIT_V(6); PG8_BAR; PG8_MMA(1, 1, At, B1); PG8_BAR;
            PG8_LDB(B0, 1, 0); PG8_SCHED; PG8_LDA(At, 1, 0); PG8_STAGE(PG8_SA(0, 1), a2 + hstep, voffA);
            PG8_WAIT_L(8); PG8_BAR; PG8_WAIT_L(0); PG8_MMA(0, 0, At, B0); PG8_BAR; PG8_SCHED;
            PG8_LDB(B1, 1, 1); PG8_STAGE(PG8_SB(1, 0), b3, voffB);
            PG8_BAR; PG8_WAIT_L(0); PG8_MMA(0, 1, At, B1); PG8_BAR;
            PG8_LDA(At, 1, 1); PG8_STAGE(PG8_SA(1, 0), a3, voffA);
            PG8_BAR; PG8_WAIT_L(0); PG8_MMA(1, 0, At, B0); PG8_BAR; PG8_SCHED;
            PG8_STAGE(PG8_SB(1, 1), b3 + hstep, voffB);
            PG8_WAIT_V(6); PG8_BAR; PG8_MMA(1, 1, At, B1); PG8_BAR;
            }
        }
        PG8_STAMP();
        if constexpr (ALIGN_EPI) { if (wr == 0) PG8_BAR; }
        if constexpr (!Epi::AFTER_DRAIN) { E(acc, cur, wr, wc, fr, fq); S.done(cur); }
        PG8_STAMP();
        if (!has_next) break;
        if (!(Epi::CHAIN && cur.kh == 0))
#pragma unroll
        for (int a = 0; a < 2; ++a)
#pragma unroll
            for (int b = 0; b < 2; ++b)
#pragma unroll
                for (int m = 0; m < 4; ++m)
#pragma unroll
                    for (int n = 0; n < 2; ++n) acc[a][b][m][n] = (f32x4){0.f, 0.f, 0.f, 0.f};
        cur = nxt; cA = nA; cB = nB; ++ui;
        if constexpr (ALIGN_EPI) { if (wr == 1) PG8_BAR; }
    }
    PG8_WAIT_V(0);
    if constexpr (!ALIGN_EPI) { if (wr == 0) PG8_BAR; }
    PG8_BAR;
    if constexpr (Epi::AFTER_DRAIN) { E.fused(acc, cur, wr, wc, fr, fq, lds, wid, lane); S.done(cur); }
    PG8_STAMP();
    if (STAMP && wid == 0) { stamps[lane] = lane < nts ? (((unsigned long long)(unsigned)ts_hi << 32) | (unsigned)ts_lo) : 0ull;
        if (lane == 62) stamps[62] = rt_entry; if (lane == 63) stamps[63] = (unsigned long long)wall_clock64(); }
#undef PG8_STAMP
#undef PG8_SA
#undef PG8_SB
#undef PG8_STAGE
#undef PG8_LDA
#undef PG8_LDB
#undef PG8_MMA
#undef PG8_WAIT_V
#undef PG8_WAIT_L
#undef PG8_BAR
#undef PG8_SCHED
}
}
#ifndef GEMM_SP2
#define GEMM_SP2 true
#endif
#ifndef GEMM_ALIGN
#define GEMM_ALIGN true
#endif
#ifndef REP_DN
#define REP_DN 1
#endif
#ifndef REP_CONV
#define REP_CONV 1
#endif
#ifndef PG1_TILES
#define PG1_TILES 6
#endif
#ifndef REP_SCAN
#define REP_SCAN 1
#endif
#ifndef REP_TILES
#define REP_TILES 1
#endif
#ifndef REP_LNA
#define REP_LNA 1
#endif
#ifndef REP_GRAM
#define REP_GRAM 1
#endif
#ifndef REP_E
#define REP_E 1
#endif
#ifndef REP_SOLVE
#define REP_SOLVE 1
#endif

#define LAS __attribute__((address_space(3)))
typedef unsigned short bf16_t;
typedef short bf16x8 __attribute__((ext_vector_type(8)));
typedef float f32x4 __attribute__((ext_vector_type(4)));
typedef unsigned u32x4 __attribute__((ext_vector_type(4)));
typedef unsigned u32x2 __attribute__((ext_vector_type(2)));

constexpr int NTOK = 8192, DM = 2048, NCTX = 4096, NP = 11520, NTHR = 512;
constexpr int C_AVAL = 0, C_AGLU = 1024, C_AZ = 2048, C_Q = 3072, C_ZB = 6144, C_GA = 7168, C_GB = 9216, C_BA = 11264;
constexpr float EPS = 1e-6f;
constexpr int LDS_BYTES = 139264;
constexpr int LDS_TQ = LDS_BYTES - 8;
constexpr int LDS_BARST = LDS_BYTES - 16;
constexpr int XCD_BAR_BYTES = 3456 * 4;

constexpr size_t WS_WIN = 256;
constexpr size_t SZ_WIN1 = (size_t)NP * DM * 2;
constexpr size_t WS_WP2 = WS_WIN + 2 * SZ_WIN1;
constexpr size_t SZ_SQ = (size_t)DM * DM * 2;
constexpr size_t WS_WO = WS_WP2 + 2 * SZ_SQ;
constexpr size_t WS_MOD = WS_WO + 2 * SZ_SQ;
constexpr size_t WS_R1 = WS_MOD + 2 * 5 * 6144 * 4;
constexpr size_t WS_P = WS_R1 + (size_t)2 * NTOK * 1024 * 4;
constexpr size_t WS_BA = WS_P + (size_t)NTOK * NP * 2;
constexpr size_t WS_Y = WS_BA + (size_t)NTOK * 32 * 4;
constexpr size_t WS_U = WS_Y + (size_t)NTOK * 1024 * 4;
constexpr size_t WS_DN = WS_U + (size_t)NTOK * 2048 * 2;
constexpr int DN_NEGW = 0, DN_QDEC = 16384, DN_KDT = 32768, DN_QKM = 49152, DN_UT = 57344, DN_EGL = 90112, DN_REC = 90368;
constexpr size_t WS_X1 = WS_DN + (size_t)2048 * DN_REC;
constexpr size_t WS_END = WS_X1 + (size_t)NTOK * DM * 4;
constexpr size_t WS_BARW = WS_END;
constexpr size_t WS_TQ = WS_BARW + 15360;
constexpr size_t WS_END2 = WS_BARW + 16384;
static_assert(WS_END2 <= 740294656ull && XCD_BAR_BYTES <= 16384, "workspace");

__device__ __forceinline__ int opaque_tid() { int t = threadIdx.x; asm volatile("" : "+v"(t)); return t; }
struct Params { const float* in[21]; float* out; unsigned char* ws; int ph_lo, ph_hi; };
#define KA_ __attribute__((address_space(4)))
__device__ __forceinline__ const float* pin(const Params&, int k) { const KA_ char* ka = (const KA_ char*)__builtin_amdgcn_kernarg_segment_ptr(); return *(const float* const volatile KA_*)(ka + 8 * k); }
__device__ __forceinline__ unsigned char* pws(const Params&) { const KA_ char* ka = (const KA_ char*)__builtin_amdgcn_kernarg_segment_ptr(); return *(unsigned char* const volatile KA_*)(ka + 8 * 22); }
__device__ __forceinline__ float* pout(const Params&) { const KA_ char* ka = (const KA_ char*)__builtin_amdgcn_kernarg_segment_ptr(); return *(float* const volatile KA_*)(ka + 8 * 21); }

__device__ __forceinline__ float bf2f(unsigned short b) { return __uint_as_float(((unsigned)b) << 16); }
__device__ __forceinline__ unsigned f2bf(float f) { unsigned u = __float_as_uint(f); u += 0x7fffu + ((u >> 16) & 1u); return u >> 16; }
typedef float f32x2_t __attribute__((ext_vector_type(2)));
typedef __bf16 bf16x2_t __attribute__((ext_vector_type(2)));
__device__ __forceinline__ unsigned pk2(float lo, float hi) { const f32x2_t v = {lo, hi}; return __builtin_bit_cast(unsigned, __builtin_convertvector(v, bf16x2_t)); }
__device__ __forceinline__ float sigmoidf_(float x) { return __builtin_amdgcn_rcpf(1.0f + __expf(-x)); }
__device__ __forceinline__ float siluf_(float x) { return x * __builtin_amdgcn_rcpf(1.0f + __expf(-x)); }
__device__ __forceinline__ f32x4 bf4_to_f32(u32x2 w) { return (f32x4){__uint_as_float(w[0] << 16), __uint_as_float(w[0] & 0xffff0000u), __uint_as_float(w[1] << 16), __uint_as_float(w[1] & 0xffff0000u)}; }
__device__ __forceinline__ float wave_sum(float v) {
#pragma unroll
    for (int o = 32; o > 0; o >>= 1) v += __shfl_xor(v, o);
    return v;
}
__device__ __forceinline__ const float* xrow0(const Params& p, int tok) { return tok < NCTX ? pin(p, 0) + (size_t)tok * DM : pin(p, 1) + (size_t)(tok - NCTX) * DM; }
__device__ __forceinline__ int cvec_of(int tok) { return tok < NCTX ? 0 : 1 + ((tok - NCTX) >> 10); }

__device__ __forceinline__ void tr_tile(const float* __restrict__ src, int ldsrc, int k0, int n0, int mode, bf16_t* __restrict__ dst, int lddst, int koff, float* lds) {
    const int tid = opaque_tid();
    { const int c4 = tid & 31, rr = tid >> 5; const int np = n0 + c4 * 4; int sc = np;
        if (mode == 1) {
            if (np < 7168) sc = np; else if (np < 11264) { const int off = np - 7168, T = off >> 8, w = off & 255; sc = w < 128 ? 7200 + 128 * T + w : 9248 + 128 * T + (w - 128); }
            else sc = np < 11296 ? np - 11264 + 7168 : -1; }
#pragma unroll
        for (int i = 0; i < 8; ++i) { const int r = rr + 16 * i;
            *(f32x4*)(lds + r * 132 + c4 * 4) = sc >= 0 ? *(const f32x4*)(src + (size_t)(k0 + r) * ldsrc + sc) : (f32x4){0.f, 0.f, 0.f, 0.f}; } }
    __syncthreads();
#pragma unroll
    for (int i = 0; i < 4; ++i) { const int u = tid + 512 * i, nn = u & 127, kg = u >> 7;
        u32x4 o;
#pragma unroll
        for (int j = 0; j < 4; ++j) o[j] = pk2(lds[(kg * 8 + 2 * j) * 132 + nn], lds[(kg * 8 + 2 * j + 1) * 132 + nn]);
        *(u32x4*)(dst + (size_t)(n0 + nn) * lddst + koff + k0 + kg * 8) = o; }
    __syncthreads();
}
__device__ __forceinline__ void weight_tile(const Params& p, int it, float* lds) {
    unsigned char* ws = pws(p);
    const int l = it / 1952; int r = it % 1952;
    const float* src; int ldsrc, kt, ntile, mode = 0, koff = 0; bf16_t* dst;
    if (r < 1440) { kt = r / 90; ntile = r % 90; src = pin(p, 8) + (size_t)l * 2048 * 11296; ldsrc = 11296; mode = 1; dst = (bf16_t*)(ws + WS_WIN + l * SZ_WIN1); }
    else if (r < 1440 + 256) { r -= 1440; const int which = r / 128; r %= 128; kt = r / 16; ntile = r % 16;
        src = pin(p, which ? 18 : 13) + (size_t)l * 1024 * 2048; ldsrc = 2048; dst = (bf16_t*)(ws + WS_WP2 + l * SZ_SQ); koff = which * 1024; }
    else { r -= 1696; kt = r / 16; ntile = r % 16; src = pin(p, 19) + (size_t)l * 2048 * 2048; ldsrc = 2048; dst = (bf16_t*)(ws + WS_WO + l * SZ_SQ); }
    tr_tile(src, ldsrc, kt * 128, ntile * 128, mode, dst, 2048, koff, lds);
}

__device__ __forceinline__ void drain_tiles(const Params& p, int max_tiles, unsigned char* lds) {
    volatile LAS unsigned* slot = (volatile LAS unsigned*)((LAS unsigned char*)lds + LDS_TQ);
    __syncthreads();
    for (int n = 0; n < max_tiles; ++n) {
        if (threadIdx.x == 0) *slot = __hip_atomic_fetch_add((unsigned*)(pws(p) + WS_TQ), 1u, __ATOMIC_RELAXED, __HIP_MEMORY_SCOPE_AGENT);
        __syncthreads();
        const unsigned it = *slot;
        if (it >= 2u * 1952u - 1440u) break;
        weight_tile(p, 1440 + (int)it, (float*)lds);
    }
}
__device__ __forceinline__ void p0_prologue(const Params& p, float* lds) {
    const int tid = opaque_tid(), G = gridDim.x, b = blockIdx.x;
    unsigned char* ws = pws(p);
    for (int it = b; it < 1440; it += G) weight_tile(p, it, lds);
    float* sc = lds;
    float* red = lds + 5 * 2048;
    __syncthreads();
    for (int i = tid; i < 5 * 2048; i += NTHR) { const int v = i >> 11, k = i & 2047; const float x = v == 0 ? pin(p, 4)[k] : pin(p, 3)[(v - 1) * 2048 + k]; sc[i] = siluf_(x); }
    __syncthreads();
    for (int it = b; it < 192; it += G) {
        const int l = it / 96, col0 = (it % 96) * 64;
        const int kq = tid >> 4, c4 = tid & 15;
        f32x4 acc[5];
#pragma unroll
        for (int v = 0; v < 5; ++v) acc[v] = (f32x4){0.f, 0.f, 0.f, 0.f};
        const float* wp = pin(p, 5) + (size_t)l * 2048 * 6144 + col0 + c4 * 4;
#pragma unroll 8
        for (int i = 0; i < 64; ++i) { const int k = kq + 32 * i; const f32x4 w = *(const f32x4*)(wp + (size_t)k * 6144);
#pragma unroll
            for (int v = 0; v < 5; ++v) acc[v] += w * sc[v * 2048 + k]; }
#pragma unroll
        for (int v = 0; v < 5; ++v) *(f32x4*)(red + (kq * 5 + v) * 64 + c4 * 4) = acc[v];
        __syncthreads();
        if (tid < 320) { const int v = tid >> 6, c = tid & 63; float s = 0.f;
            for (int q = 0; q < 32; ++q) s += red[(q * 5 + v) * 64 + c];
            ((float*)(ws + WS_MOD))[(size_t)(l * 5 + v) * 6144 + col0 + c] = s + pin(p, 6)[l * 6144 + col0 + c]; }
        __syncthreads();
    }
}

__device__ __forceinline__ void pn_norm(const Params& p, int l) {
    const int tid = opaque_tid(), lane = tid & 63, wid = tid >> 6;
    bf16_t* XN = (bf16_t*)(pws(p) + WS_R1);
    const float* MOD = (const float*)(pws(p) + WS_MOD);
    const float* ng = pin(p, 7) + l * DM;
    for (int tok = blockIdx.x * 8 + wid; tok < NTOK; tok += gridDim.x * 8) {
        const float* xr = l == 0 ? xrow0(p, tok) : (const float*)(pws(p) + WS_X1) + (size_t)tok * DM;
        f32x4 v[8]; float ss = 0.f;
#pragma unroll
        for (int i = 0; i < 8; ++i) { v[i] = *(const f32x4*)(xr + (lane + 64 * i) * 4); ss += v[i][0] * v[i][0] + v[i][1] * v[i][1] + v[i][2] * v[i][2] + v[i][3] * v[i][3]; }
        ss = wave_sum(ss);
        const float rstd = rsqrtf(ss * (1.0f / DM) + EPS);
        const float* md = MOD + (size_t)(l * 5 + cvec_of(tok)) * 6144;
#pragma unroll
        for (int i = 0; i < 8; ++i) { const int c = (lane + 64 * i) * 4;
            const f32x4 g = *(const f32x4*)(ng + c), sh = *(const f32x4*)(md + c), scl = *(const f32x4*)(md + 2048 + c);
            const f32x4 h = (v[i] * rstd * g) * (scl + 1.0f) + sh;
            u32x2 o; o[0] = pk2(h[0], h[1]); o[1] = pk2(h[2], h[3]);
            *(u32x2*)(XN + (size_t)tok * DM + c) = o; }
    }
}
__device__ __forceinline__ void pf_final(const Params& p) {
    const int tid = opaque_tid(), lane = tid & 63, wid = tid >> 6;
    const float* X2 = (const float*)(pws(p) + WS_P);
    const float* fg = pin(p, 20);
    for (int tok = blockIdx.x * 8 + wid; tok < NTOK; tok += gridDim.x * 8) {
        const float* xr = X2 + (size_t)tok * DM;
        f32x4 v[8]; float ss = 0.f;
#pragma unroll
        for (int i = 0; i < 8; ++i) { v[i] = *(const f32x4*)(xr + (lane + 64 * i) * 4); ss += v[i][0] * v[i][0] + v[i][1] * v[i][1] + v[i][2] * v[i][2] + v[i][3] * v[i][3]; }
        ss = wave_sum(ss);
        const float rstd = rsqrtf(ss * (1.0f / DM) + EPS);
#pragma unroll
        for (int i = 0; i < 8; ++i) { const int c = (lane + 64 * i) * 4; const f32x4 g = *(const f32x4*)(fg + c);
            *(f32x4*)(pout(p) + (size_t)tok * DM + c) = v[i] * rstd * g; }
    }
}

struct ChainOrder : pg8::StaticOrder {
    __device__ bool next(int i, pg8::Unit& u) const { const bool ok = pg8::StaticOrder::next(i >> 1, u); u.kh = i & 1; return ok; }
};
struct EpiP {
    static constexpr bool PERM = true, AFTER_DRAIN = false, CHAIN = false;
    bf16_t* P; float* BA;
    __device__ __forceinline__ void operator()(f32x4 (&acc)[2][2][4][2], const pg8::Unit& u, int wr, int wc, int fr, int fq) const {
        const int row0 = u.pm * 256 + wr * 64 + fr, col0 = u.pn * 256 + wc * 32 + 8 * fq;
#pragma unroll
        for (int ai = 0; ai < 2; ++ai)
#pragma unroll
            for (int m = 0; m < 4; ++m) { const int row = row0 + ai * 128 + m * 16; bf16_t* rowp = P + (size_t)row * NP + col0;
                if (u.pn >= 28 && u.pn < 44) {
                    f32x4 R[2], Sg[2];
#pragma unroll
                    for (int n = 0; n < 2; ++n)
#pragma unroll
                        for (int e = 0; e < 4; ++e) { const float ea = __expf(-acc[ai][0][m][n][e]), eb = __expf(-acc[ai][1][m][n][e]);
                            R[n][e] = (1.0f + eb) * __builtin_amdgcn_rcpf(1.0f + ea); Sg[n][e] = __builtin_amdgcn_rcpf(1.0f + eb); }
                    u32x4 o; o[0] = pk2(R[0][0], R[0][1]); o[1] = pk2(R[0][2], R[0][3]); o[2] = pk2(R[1][0], R[1][1]); o[3] = pk2(R[1][2], R[1][3]);
                    *(u32x4*)rowp = o;
                    o[0] = pk2(Sg[0][0], Sg[0][1]); o[1] = pk2(Sg[0][2], Sg[0][3]); o[2] = pk2(Sg[1][0], Sg[1][1]); o[3] = pk2(Sg[1][2], Sg[1][3]);
                    *(u32x4*)(rowp + 128) = o;
                } else
#pragma unroll
                for (int bj = 0; bj < 2; ++bj) { const f32x4 v0 = acc[ai][bj][m][0], v1 = acc[ai][bj][m][1];
                    u32x4 o; o[0] = pg8::cvt_pk_bf16(v0[0], v0[1]); o[1] = pg8::cvt_pk_bf16(v0[2], v0[3]); o[2] = pg8::cvt_pk_bf16(v1[0], v1[1]); o[3] = pg8::cvt_pk_bf16(v1[2], v1[3]);
                    *(u32x4*)(rowp + bj * 128) = o; }
                if (u.pn == 44 && wc == 0) { *(f32x4*)(BA + (size_t)row * 32 + 8 * fq) = acc[ai][0][m][0]; *(f32x4*)(BA + (size_t)row * 32 + 8 * fq + 4) = acc[ai][0][m][1]; }
            }
    }
};
struct EpiMG {
    static constexpr bool PERM = true, AFTER_DRAIN = false, CHAIN = true;
    const bf16_t* P; bf16_t* MG;
    __device__ __forceinline__ void operator()(f32x4 (&acc)[2][2][4][2], const pg8::Unit& u, int wr, int wc, int fr, int fq) const {
        const int row0 = u.pm * 256 + wr * 64 + fr, w0 = wc * 32 + 8 * fq, col0 = u.pn * 256 + w0;
        const int goff = u.kh == 0 ? 0 : 128;
#pragma unroll
        for (int ai = 0; ai < 2; ++ai) { u32x4 gv[4][2];
#pragma unroll
            for (int m = 0; m < 4; ++m) { const bf16_t* rowp = P + (size_t)(row0 + ai * 128 + m * 16) * NP + C_GA + w0 + goff;
#pragma unroll
                for (int bj = 0; bj < 2; ++bj) gv[m][bj] = *(const u32x4*)(rowp + (2 * u.pn + bj) * 256); }
#pragma unroll
            for (int m = 0; m < 4; ++m) { const int row = row0 + ai * 128 + m * 16;
#pragma unroll
                for (int bj = 0; bj < 2; ++bj) { float o[8];
#pragma unroll
                    for (int e = 0; e < 8; ++e) { const unsigned wv = gv[m][bj][e >> 1]; const float gvv = __uint_as_float((e & 1) ? (wv & 0xffff0000u) : (wv << 16));
                        o[e] = acc[ai][bj][m][e >> 2][e & 3] * gvv; }
                    if (u.kh == 0) {
#pragma unroll
                        for (int e = 0; e < 8; ++e) acc[ai][bj][m][e >> 2][e & 3] = o[e];
                    } else { u32x4 ov; ov[0] = pk2(o[0], o[1]); ov[1] = pk2(o[2], o[3]); ov[2] = pk2(o[4], o[5]); ov[3] = pk2(o[6], o[7]);
                        *(u32x4*)(MG + (size_t)row * DM + col0 + bj * 128) = ov; } } }
            __builtin_amdgcn_sched_barrier(0); }
    }
};
struct EpiX {
    static constexpr bool PERM = false, AFTER_DRAIN = false, CHAIN = false;
    const float* x0a; const float* x0b; const float* x1; const float* gate; float* out;
    __device__ __forceinline__ void operator()(f32x4 (&acc)[2][2][4][2], const pg8::Unit& u, int wr, int wc, int fr, int fq) const {
        const int row0 = u.pm * 256 + wr * 64 + fr, col0 = u.pn * 256 + wc * 32 + 4 * fq;
#pragma unroll
        for (int ai = 0; ai < 2; ++ai)
#pragma unroll
            for (int m = 0; m < 4; ++m) { const int row = row0 + ai * 128 + m * 16;
                const float* xr = x1 ? x1 + (size_t)row * DM : (row < NCTX ? x0a + (size_t)row * DM : x0b + (size_t)(row - NCTX) * DM);
                const float* gr = gate + (size_t)cvec_of(row) * 6144;
#pragma unroll
                for (int bj = 0; bj < 2; ++bj)
#pragma unroll
                    for (int n = 0; n < 2; ++n) { const int col = col0 + bj * 128 + n * 16;
                        const f32x4 xv = *(const f32x4*)(xr + col), gv = *(const f32x4*)(gr + col);
                        *(f32x4*)(out + (size_t)row * DM + col) = xv + gv * acc[ai][bj][m][n]; }
            }
    }
};

template <int T>
__device__ __forceinline__ void conv_line(const bf16_t* __restrict__ P, bf16_t* __restrict__ Y, int base, int stride, int L, int p0, int ch, const float* __restrict__ w, const float* __restrict__ cb) {
    f32x2_t ua[T + 30];
#pragma unroll
    for (int i = 0; i < T + 30; ++i) { const int pos = p0 - 15 + i; f32x2_t v = {0.f, 0.f};
        if (pos >= 0 && pos < L) { const bf16_t* pr = P + (size_t)(base + pos * stride) * NP + ch; const unsigned a = *(const unsigned*)(pr + C_AVAL), g = *(const unsigned*)(pr + C_AGLU);
            v[0] = __uint_as_float(a << 16) * sigmoidf_(__uint_as_float(g << 16)); v[1] = __uint_as_float(a & 0xffff0000u) * sigmoidf_(__uint_as_float(g & 0xffff0000u)); }
        ua[i] = v; }
    f32x2_t wk[31];
#pragma unroll
    for (int k = 0; k < 31; ++k) wk[k] = *(const f32x2_t*)(w + k * 1024 + ch);
    const f32x2_t bias = *(const f32x2_t*)(cb + ch);
#pragma unroll
    for (int j = 0; j < T; ++j) { f32x2_t a = bias;
#pragma unroll
        for (int k = 0; k < 31; ++k) a += wk[k] * ua[j + k];
        *(unsigned*)(Y + (size_t)(base + (p0 + j) * stride) * 1024 + ch) = pk2(a[0], a[1]); }
}

__device__ __forceinline__ void split8(const float* p, bf16x8& hi, bf16x8& lo) {
    const f32x4 a = *(const f32x4*)p, b2 = *(const f32x4*)(p + 4);
    u32x4 h, l2;
    h[0] = pk2(a[0], a[1]); h[1] = pk2(a[2], a[3]); h[2] = pk2(b2[0], b2[1]); h[3] = pk2(b2[2], b2[3]);
    l2[0] = pk2(a[0] - __uint_as_float(h[0] << 16), a[1] - __uint_as_float(h[0] & 0xffff0000u));
    l2[1] = pk2(a[2] - __uint_as_float(h[1] << 16), a[3] - __uint_as_float(h[1] & 0xffff0000u));
    l2[2] = pk2(b2[0] - __uint_as_float(h[2] << 16), b2[1] - __uint_as_float(h[2] & 0xffff0000u));
    l2[3] = pk2(b2[2] - __uint_as_float(h[3] << 16), b2[3] - __uint_as_float(h[3] & 0xffff0000u));
    hi = __builtin_bit_cast(bf16x8, h); lo = __builtin_bit_cast(bf16x8, l2);
}
__device__ __forceinline__ void dn_precompute(const Params& p, int l, int gc, int h, float* lds) {
    const int tid = opaque_tid(), lane = tid & 63, wid = tid >> 6;
    float* qs = lds;
    float* ks = lds + 8448;
    float* vs = lds + 2 * 8448;
    float* Gm = lds + 3 * 8448;
    float* QKm = Gm + 4160;
    float* betaS = QKm + 4160;
    float* gcS = betaS + 128;
    float* wscS = gcS + 128;
    const bf16_t* P = (const bf16_t*)(pws(p) + WS_P);
    const float* BA = (const float*)(pws(p) + WS_BA);
    int n, nc; if (gc < 64) { n = gc & 3; nc = 4; } else { n = (gc - 64) & 15; nc = 16; }
    const int tok0 = gc * 64;
    const float* cw = pin(p, 14) + (size_t)l * 3 * 3072;
    if (tid < 384) { const int cg = tid % 48, run = tid / 48, which = cg >> 4, d0 = (cg & 15) * 8;
        const int wch = which * 1024 + h * 128 + d0;
        const bf16_t* pc = P + (long)(tok0 + run * 8 - 1) * NP + C_Q + wch;
        u32x4 rows[10];
#pragma unroll
        for (int r = 0; r < 10; ++r) { const int t = run * 8 - 1 + r; const bool valid = (t >= 0 || n > 0) && (t < 64 || n < nc - 1);
            rows[r] = valid ? *(const u32x4*)(pc + (long)r * NP) : (u32x4){0u, 0u, 0u, 0u}; }
        f32x4 w[3][2];
#pragma unroll
        for (int j = 0; j < 3; ++j) { w[j][0] = *(const f32x4*)(cw + j * 3072 + wch); w[j][1] = *(const f32x4*)(cw + j * 3072 + wch + 4); }
        float* dst = (which == 0 ? qs : (which == 1 ? ks : vs)) + d0;
#pragma unroll
        for (int o = 0; o < 8; ++o) { f32x4 r2[2];
#pragma unroll
            for (int e = 0; e < 8; ++e) { const unsigned a = rows[o][e >> 1], bq = rows[o + 1][e >> 1], cq = rows[o + 2][e >> 1];
                const float xm = __uint_as_float((e & 1) ? (a & 0xffff0000u) : (a << 16)), x0 = __uint_as_float((e & 1) ? (bq & 0xffff0000u) : (bq << 16)), xp = __uint_as_float((e & 1) ? (cq & 0xffff0000u) : (cq << 16));
                r2[e >> 2][e & 3] = siluf_(w[0][e >> 2][e & 3] * xm + w[1][e >> 2][e & 3] * x0 + w[2][e >> 2][e & 3] * xp); }
            *(f32x4*)(dst + (run * 8 + o) * 132) = r2[0]; *(f32x4*)(dst + (run * 8 + o) * 132 + 4) = r2[1]; }
    }
    if (tid < 128) { const int dir = tid >> 6, i = tid & 63, tl = dir ? 63 - i : i;
        const float* ba = BA + (size_t)(tok0 + tl) * 32;
        const float bl = ba[dir * 8 + h], al = ba[16 + dir * 8 + h];
        const float xx = al + pin(p, 16)[(l * 2 + dir) * 8 + h];
        const float sp = xx > 20.f ? xx : log1pf(__expf(xx));
        float g = -__expf(pin(p, 15)[(l * 2 + dir) * 8 + h]) * sp;
#pragma unroll
        for (int o = 1; o < 64; o <<= 1) { const float t2 = __shfl_up(g, o); if (i >= o) g += t2; }
        const float bt = sigmoidf_(bl); betaS[dir * 64 + i] = bt; gcS[dir * 64 + i] = g; wscS[dir * 64 + i] = bt * __expf(g); }
    __syncthreads();
    { float a[16], b2[16], ss[16];
#pragma unroll
        for (int k = 0; k < 16; ++k) { const int r = wid + 8 * k; const float* row = (r < 64 ? qs + r * 132 : ks + (r - 64) * 132); a[k] = row[lane]; b2[k] = row[lane + 64]; ss[k] = a[k] * a[k] + b2[k] * b2[k]; }
#pragma unroll
        for (int o = 32; o > 0; o >>= 1) {
#pragma unroll
            for (int k = 0; k < 16; ++k) ss[k] += __shfl_xor(ss[k], o); }
#pragma unroll
        for (int k = 0; k < 16; ++k) { const int r = wid + 8 * k; float* row = (r < 64 ? qs + r * 132 : ks + (r - 64) * 132);
            const float sc = rsqrtf(ss[k] + EPS) * (r < 64 ? 0.08838834764831845f : 1.0f); row[lane] = a[k] * sc; row[lane + 64] = b2[k] * sc; } }
    __syncthreads();
    for (int rg = 0; rg < REP_GRAM; ++rg) { const int mat = wid >> 2, ti = wid & 3, r = lane & 15, q4 = lane >> 4;
        const float* Ar = mat ? qs : ks;
        bf16x8 Ahi[4], Alo[4];
#pragma unroll
        for (int k4 = 0; k4 < 4; ++k4) split8(Ar + (16 * ti + r) * 132 + 32 * k4 + 8 * q4, Ahi[k4], Alo[k4]);
        float* M = mat ? QKm : Gm;
#pragma unroll
        for (int tj = 0; tj < 4; ++tj) { f32x4 acc = (f32x4){0.f, 0.f, 0.f, 0.f};
#pragma unroll
            for (int k4 = 0; k4 < 4; ++k4) { bf16x8 Bhi, Blo; split8(ks + (16 * tj + r) * 132 + 32 * k4 + 8 * q4, Bhi, Blo);
                acc = __builtin_amdgcn_mfma_f32_16x16x32_bf16(Ahi[k4], Bhi, acc, 0, 0, 0);
                acc = __builtin_amdgcn_mfma_f32_16x16x32_bf16(Ahi[k4], Blo, acc, 0, 0, 0);
                acc = __builtin_amdgcn_mfma_f32_16x16x32_bf16(Alo[k4], Bhi, acc, 0, 0, 0); }
#pragma unroll
            for (int j = 0; j < 4; ++j) M[(16 * ti + 4 * q4 + j) * 65 + 16 * tj + r] = acc[j]; } }
    __syncthreads();
    const int dir = tid >> 8, tl = tid & 255;
    unsigned char* rec = pws(p) + WS_DN + (size_t)((gc * 8 + h) * 2 + dir) * DN_REC;
    const float* gcd = gcS + dir * 64; const float* btd = betaS + dir * 64;
    const float gl = gcd[63];
    { bf16_t* qd = (bf16_t*)(rec + DN_QDEC);
        for (int e = tl; e < 64 * 64; e += 256) { const int i = e >> 6, d2 = (e & 63) * 2; const int t = dir ? 63 - i : i; const float eg = __expf(gcd[i]);
            *(unsigned*)(qd + i * 128 + d2) = pk2(qs[t * 132 + d2] * eg, qs[t * 132 + d2 + 1] * eg); } }
    __syncthreads();
    float* Am = qs + dir * 4096;
    for (int e = tl; e < 4096; e += 256) { const int j = e >> 6, i = e & 63; const int ti = dir ? 63 - i : i, tj = dir ? 63 - j : j;
        Am[e] = j < i ? btd[i] * Gm[ti * 65 + tj] * __expf(gcd[i] - gcd[j]) : 0.f; }
    __syncthreads();
    if (tl >= 64) { const int t2 = tl - 64;
        bf16_t* kd = (bf16_t*)(rec + DN_KDT);
        for (int e = t2; e < 128 * 32; e += 192) { const int dk = e >> 5, j2 = (e & 31) * 2; const int t0 = dir ? 63 - j2 : j2, t1 = dir ? 62 - j2 : j2 + 1;
            *(unsigned*)(kd + dk * 64 + j2) = pk2(ks[t0 * 132 + dk] * __expf(gl - gcd[j2]), ks[t1 * 132 + dk] * __expf(gl - gcd[j2 + 1])); }
        bf16_t* qk = (bf16_t*)(rec + DN_QKM);
        for (int e = t2; e < 64 * 32; e += 192) { const int i = e >> 5, j2 = (e & 31) * 2; const int ti = dir ? 63 - i : i, t0 = dir ? 63 - j2 : j2, t1 = dir ? 62 - j2 : j2 + 1;
            const float v0 = j2 <= i ? QKm[ti * 65 + t0] * __expf(gcd[i] - gcd[j2]) : 0.f;
            const float v1 = j2 + 1 <= i ? QKm[ti * 65 + t1] * __expf(gcd[i] - gcd[j2 + 1]) : 0.f;
            *(unsigned*)(qk + i * 64 + j2) = pk2(v0, v1); }
        if (t2 == 0) *(float*)(rec + DN_EGL) = __expf(gl);
    }
    float* Tm = Am;
    if (tl < 64) { const int c = tl;
        f32x2_t U2[32];
#pragma unroll
        for (int i = 0; i < 64; ++i) U2[i >> 1][i & 1] = (i == c) ? 1.f : 0.f;
        f32x4 av[2][16];
#pragma unroll
        for (int i4 = 0; i4 < 16; ++i4) av[0][i4] = *(const f32x4*)(Am + i4 * 4);
        __builtin_amdgcn_sched_barrier(0);
#pragma unroll
        for (int j = 0; j < 63; ++j) {
            if (j + 1 < 63) {
#pragma unroll
                for (int i4 = (j + 2) / 4; i4 < 16; ++i4) av[(j + 1) & 1][i4] = *(const f32x4*)(Am + (j + 1) * 64 + i4 * 4); }
            const float uj = U2[j >> 1][j & 1]; const f32x2_t ujj = {uj, uj};
#pragma unroll
            for (int pr = (j + 1) / 2; pr < 32; ++pr) { const f32x4 a4 = av[j & 1][pr >> 1]; const f32x2_t a2 = (pr & 1) ? (f32x2_t){a4[2], a4[3]} : (f32x2_t){a4[0], a4[1]};
                if (2 * pr > j) U2[pr] = U2[pr] - a2 * ujj; else U2[pr][1] -= a2[1] * uj; }
            __builtin_amdgcn_sched_barrier(0); }
#pragma unroll
        for (int i = 0; i < 64; ++i) Tm[i * 64 + c] = U2[i >> 1][i & 1];
    }
    __syncthreads();
    { const int wq = wid & 3, r = lane & 15, kg = lane >> 4; const bool isu = wq < 2;
        int rstep = dir ? -132 : 132; asm volatile("" : "+v"(rstep));
        const float* src = (isu ? vs + wq * 64 : ks + (wq - 2) * 64) + (dir ? 63 * 132 : 0) + r;
        const float* scl = isu ? btd : wscS + dir * 64;
        bf16x8 Ahi[4][2], Alo[4][2];
#pragma unroll
        for (int m = 0; m < 4; ++m)
#pragma unroll
            for (int kx = 0; kx < 2; ++kx) split8(Tm + (16 * m + r) * 64 + 32 * kx + 8 * kg, Ahi[m][kx], Alo[m][kx]);
        float* ut = (float*)(rec + DN_UT); bf16_t* nw = (bf16_t*)(rec + DN_NEGW);
#pragma unroll
        for (int nt = 0; nt < 4; ++nt) { bf16x8 Bf[2];
#pragma unroll
            for (int kx = 0; kx < 2; ++kx) { const int j0 = 32 * kx + 8 * kg; const f32x4 s0 = *(const f32x4*)(scl + j0), s1 = *(const f32x4*)(scl + j0 + 4);
                u32x4 o;
#pragma unroll
                for (int e2 = 0; e2 < 4; ++e2) { const float x0 = src[(j0 + 2 * e2) * rstep + 16 * nt] * (e2 < 2 ? s0[2 * e2] : s1[2 * e2 - 4]), x1 = src[(j0 + 2 * e2 + 1) * rstep + 16 * nt] * (e2 < 2 ? s0[2 * e2 + 1] : s1[2 * e2 - 3]);
                    o[e2] = pk2(x0, x1); }
                Bf[kx] = __builtin_bit_cast(bf16x8, o); }
#pragma unroll
            for (int m = 0; m < 4; ++m) { f32x4 acc = (f32x4){0.f, 0.f, 0.f, 0.f};
#pragma unroll
                for (int kx = 0; kx < 2; ++kx) { acc = __builtin_amdgcn_mfma_f32_16x16x32_bf16(Ahi[m][kx], Bf[kx], acc, 0, 0, 0); acc = __builtin_amdgcn_mfma_f32_16x16x32_bf16(Alo[m][kx], Bf[kx], acc, 0, 0, 0); }
                const int i0 = 16 * m + 4 * kg, cc = 16 * nt + r;
                if (isu) { u32x2 o2; o2[0] = pk2(acc[0], acc[1]); o2[1] = pk2(acc[2], acc[3]); *(u32x2*)((bf16_t*)ut + (wq * 64 + cc) * 64 + i0) = o2; }
                else {
#pragma unroll
                    for (int jj = 0; jj < 4; ++jj) nw[(i0 + jj) * 128 + (wq - 2) * 64 + cc] = (bf16_t)f2bf(-acc[jj]); } }
        }
    }
    __syncthreads();
}

__device__ __forceinline__ void pc_phase(const Params& p, int l, float* lds) {
    const int tid = opaque_tid();
    const bf16_t* P = (const bf16_t*)(pws(p) + WS_P);
    bf16_t* Y = (bf16_t*)(pws(p) + WS_Y);
    const float* cw = pin(p, 9) + (size_t)l * 31 * 1024;
    const float* cb = pin(p, 10) + l * 1024;
    const bool g256 = (int)gridDim.x == 256;
    for (int kk = 0;; ++kk) {
        int it = (int)blockIdx.x + kk * (int)gridDim.x;
        if (g256 && kk == 5) it = (int)blockIdx.x >= 192 ? 1280 + (int)blockIdx.x - 192 : (1 << 30);
        if (it >= 1024 + 320) break;
#ifndef NO_DN
        if (it < 1024) { for (int rd = 0; rd < REP_DN; ++rd) dn_precompute(p, l, it >> 3, it & 7, lds); continue; }
#endif
#ifndef NO_CONV
        for (int rcv = 0; rcv < REP_CONV; ++rcv) {
        int r = it - 1024;
        int tl = opaque_tid();
        if (r < 192) { int base, L, p0, ch;
            if (r < 128) { const int tile = r & 7, bb = r >> 3; ch = 2 * tl; base = bb * 256; L = 256; p0 = tile * 32; }
            else { r -= 128; const int row = r & 15, bb = r >> 4; ch = 2 * (tl & 255); base = NCTX + bb * 1024 + row * 64; L = 64; p0 = (tl >> 8) * 32; }
            int st = 1; asm volatile("" : "+s"(st));
            conv_line<32>(P, Y, base, st, L, p0, ch, cw, cb);
        } else {
            r -= 192; const int col = 2 * (r & 31) + (tl >> 8), bb = r >> 5; const int ch = 512 + 2 * (tl & 255);
            int st = 64; asm volatile("" : "+s"(st));
            conv_line<16>(P, Y, NCTX + bb * 1024 + col, st, 16, 0, ch, cw, cb);
        }
        }
#endif
    }
}

__device__ __forceinline__ bf16x8 pack8(const f32x4& a, const f32x4& b) {
    u32x4 r; r[0] = pk2(a[0], a[1]); r[1] = pk2(a[2], a[3]); r[2] = pk2(b[0], b[1]); r[3] = pk2(b[2], b[3]);
    return __builtin_bit_cast(bf16x8, r);
}
__device__ __forceinline__ bf16x8 lds_afrag(const unsigned char* base) {
    const u32x2 lo = *(const u32x2*)base, hi = *(const u32x2*)(base + 32);
    u32x4 r; r[0] = lo[0]; r[1] = lo[1]; r[2] = hi[0]; r[3] = hi[1];
    return __builtin_bit_cast(bf16x8, r);
}
#define MFMA16(a, b, c) __builtin_amdgcn_mfma_f32_16x16x32_bf16((a), (b), (c), 0, 0, 0)

#define SCAN_IMG 67584
__device__ __forceinline__ const unsigned char* dn_rec(const Params& p, int gc, int h, int dir) { return pws(p) + WS_DN + (size_t)((gc * 8 + h) * 2 + dir) * DN_REC; }
__device__ __forceinline__ void scan_item(const Params& p, int l, int sq, int h, int dir, unsigned char* lds) {
    const int tid = opaque_tid(), lane = tid & 63, wid = __builtin_amdgcn_readfirstlane(tid >> 6), c = lane & 15, q = lane >> 4;
    const bool ctx = sq < 16;
    const int nc = ctx ? 4 : 16, gc0 = ctx ? sq * 4 : 64 + (sq - 16) * 16;
#define SCAN_GC(s_) (gc0 + (dir ? nc - 1 - (s_) : (s_)))
    if (wid >= 4) {
        const int tl = tid - 256;
        u32x4 Ra[14], Rb[14];
#define SCAN_LOAD(R_, s_) do { const unsigned char* r_ = dn_rec(p, SCAN_GC((s_) < nc ? (s_) : nc - 1), h, dir); _Pragma("unroll") for (int k = 0; k < 14; ++k) R_[k] = *(const u32x4*)(r_ + (size_t)(tl + 256 * k) * 16); } while (0)
#define SCAN_WRITE(R_, buf_) do { unsigned char* b_ = lds + (buf_) * SCAN_IMG; _Pragma("unroll") for (int k = 0; k < 14; ++k) { const int ch = tl + 256 * k; unsigned char* dst; \
            if (k < 4) dst = b_ + (ch >> 4) * 288 + (ch & 15) * 16; \
            else if (k < 8) { const int x = ch - 1024; dst = b_ + 18432 + (x >> 4) * 288 + (x & 15) * 16; } \
            else if (k < 12) { const int x = ch - 2048; dst = b_ + 36864 + (x >> 3) * 160 + (x & 7) * 16; } \
            else { const int x = ch - 3072; dst = b_ + 57344 + (x >> 3) * 160 + (x & 7) * 16; } \
            *(u32x4*)dst = R_[k]; } } while (0)
        SCAN_LOAD(Ra, 0); SCAN_LOAD(Rb, 1);
        SCAN_WRITE(Ra, 0);
        __syncthreads();
        for (int s = 0; s < nc; s += 2) {
            SCAN_LOAD(Ra, s + 2);
            SCAN_WRITE(Rb, 1);
            __syncthreads();
            SCAN_LOAD(Rb, s + 3);
            SCAN_WRITE(Ra, 0);
            __syncthreads();
        }
#undef SCAN_LOAD
#undef SCAN_WRITE
    } else {
        const int dv0 = wid * 32;
        bf16_t* O = (bf16_t*)(pws(p) + WS_R1) + (size_t)dir * NTOK * 1024;
        f32x4 S[2][8];
#pragma unroll
        for (int t = 0; t < 2; ++t)
#pragma unroll
            for (int m = 0; m < 8; ++m) S[t][m] = (f32x4){0.f, 0.f, 0.f, 0.f};
        if (!ctx) { const float* sd = pin(p, 2) + ((size_t)(((sq - 16) * 2 + l) * 2 + dir) * 8 + h) * 16384;
#pragma unroll
            for (int t = 0; t < 2; ++t)
#pragma unroll
                for (int m = 0; m < 8; ++m)
#pragma unroll
                    for (int j = 0; j < 4; ++j) S[t][m][j] = sd[(16 * m + 4 * q + j) * 128 + dv0 + 16 * t + c]; }
        u32x2 utn[2][4]; float egl;
        { const unsigned char* rec0 = dn_rec(p, SCAN_GC(0), h, dir);
#pragma unroll
            for (int t = 0; t < 2; ++t)
#pragma unroll
                for (int m = 0; m < 4; ++m) utn[t][m] = *(const u32x2*)((const bf16_t*)(rec0 + DN_UT) + (dv0 + 16 * t + c) * 64 + 16 * m + 4 * q);
            egl = *(const float*)(rec0 + DN_EGL); }
        __syncthreads();
        for (int s = 0; s < nc; ++s) {
            const int gc = SCAN_GC(s);
            const unsigned char* recn = dn_rec(p, SCAN_GC(s + 1 < nc ? s + 1 : s), h, dir);
            const unsigned char* L_negw = lds + (s & 1) * SCAN_IMG;
            const unsigned char* L_qdec = L_negw + 18432;
            const unsigned char* L_kdt = L_negw + 36864;
            const unsigned char* L_qkm = L_negw + 57344;
            f32x4 vn[2][4];
#pragma unroll
            for (int t = 0; t < 2; ++t)
#pragma unroll
                for (int m = 0; m < 4; ++m) vn[t][m] = bf4_to_f32(utn[t][m]);
            bf16x8 Bs[2][4];
#pragma unroll
            for (int t = 0; t < 2; ++t)
#pragma unroll
                for (int kb = 0; kb < 4; ++kb) Bs[t][kb] = pack8(S[t][2 * kb], S[t][2 * kb + 1]);
            const unsigned char* aN = L_negw + c * 288 + 8 * q;
            const unsigned char* aQ = L_qdec + c * 288 + 8 * q;
            const unsigned char* aM = L_qkm + c * 160 + 8 * q;
            const unsigned char* aK = L_kdt + c * 160 + 8 * q;
#define SB_ __builtin_amdgcn_sched_barrier(0)
#define LD_N(F, m) do { _Pragma("unroll") for (int kb = 0; kb < 4; ++kb) F[kb] = lds_afrag(aN + (m) * 16 * 288 + 64 * kb); } while (0)
#define LD_Q(F, m) do { _Pragma("unroll") for (int kb = 0; kb < 4; ++kb) F[kb] = lds_afrag(aQ + (m) * 16 * 288 + 64 * kb); } while (0)
#define LD_M(F, m) do { _Pragma("unroll") for (int kb = 0; kb < 2; ++kb) F[kb] = lds_afrag(aM + (m) * 16 * 160 + 64 * kb); } while (0)
#define LD_K(F, m2) do { _Pragma("unroll") for (int mm = 0; mm < 2; ++mm) _Pragma("unroll") for (int kb = 0; kb < 2; ++kb) F[mm * 2 + kb] = lds_afrag(aK + (2 * (m2) + mm) * 16 * 160 + 64 * kb); } while (0)
#define MF_N(F, m) do { _Pragma("unroll") for (int kb = 0; kb < 4; ++kb) { vn[0][m] = MFMA16(F[kb], Bs[0][kb], vn[0][m]); vn[1][m] = MFMA16(F[kb], Bs[1][kb], vn[1][m]); } } while (0)
#define MF_Q(F, m) do { oa0 = (f32x4){0.f, 0.f, 0.f, 0.f}; oa1 = oa0; \
            _Pragma("unroll") for (int kb = 0; kb < 4; ++kb) { oa0 = MFMA16(F[kb], Bs[0][kb], oa0); oa1 = MFMA16(F[kb], Bs[1][kb], oa1); } } while (0)
#define MF_M(F, m) do { f32x4 a0 = oa0, a1 = oa1; \
            _Pragma("unroll") for (int kb = 0; kb < 2; ++kb) { a0 = MFMA16(F[kb], Bv[0][kb], a0); a1 = MFMA16(F[kb], Bv[1][kb], a1); } \
            _Pragma("unroll") for (int j = 0; j < 4; ++j) { const int i = 16 * (m) + 4 * q + j; const int tok = gc * 64 + (dir ? 63 - i : i); \
                bf16_t* op = O + (size_t)tok * 1024 + h * 128 + dv0 + c; op[0] = (bf16_t)f2bf(a0[j]); op[16] = (bf16_t)f2bf(a1[j]); } } while (0)
#define MF_K(F, m2) do { _Pragma("unroll") for (int mm = 0; mm < 2; ++mm) { f32x4 a0 = S[0][2 * (m2) + mm] * egl, a1 = S[1][2 * (m2) + mm] * egl; \
            _Pragma("unroll") for (int kb = 0; kb < 2; ++kb) { a0 = MFMA16(F[mm * 2 + kb], Bv[0][kb], a0); a1 = MFMA16(F[mm * 2 + kb], Bv[1][kb], a1); } \
            S[0][2 * (m2) + mm] = a0; S[1][2 * (m2) + mm] = a1; } } while (0)
            bf16x8 X[4], Y[4]; f32x4 oa0, oa1;
            LD_N(X, 0); SB_;
            LD_N(Y, 1); SB_; MF_N(X, 0); SB_;
            LD_N(X, 2); SB_; MF_N(Y, 1); SB_;
            LD_N(Y, 3); SB_; MF_N(X, 2); SB_;
            LD_Q(X, 0); SB_; MF_N(Y, 3); SB_;
            bf16x8 Bv[2][2];
#pragma unroll
            for (int t = 0; t < 2; ++t)
#pragma unroll
                for (int kb = 0; kb < 2; ++kb) Bv[t][kb] = pack8(vn[t][2 * kb], vn[t][2 * kb + 1]);
#pragma unroll
            for (int t = 0; t < 2; ++t)
#pragma unroll
                for (int m = 0; m < 4; ++m) utn[t][m] = *(const u32x2*)((const bf16_t*)(recn + DN_UT) + (dv0 + 16 * t + c) * 64 + 16 * m + 4 * q);
            SB_;
            LD_M(Y, 0); SB_; MF_Q(X, 0); SB_;
            LD_Q(X, 1); SB_; MF_M(Y, 0); SB_;
            LD_M(Y, 1); SB_; MF_Q(X, 1); SB_;
            LD_Q(X, 2); SB_; MF_M(Y, 1); SB_;
            LD_M(Y, 2); SB_; MF_Q(X, 2); SB_;
            LD_Q(X, 3); SB_; MF_M(Y, 2); SB_;
            LD_M(Y, 3); SB_; MF_Q(X, 3); SB_;
            LD_K(X, 0); SB_; MF_M(Y, 3); SB_;
            LD_K(Y, 1); SB_; MF_K(X, 0); SB_;
            LD_K(X, 2); SB_; MF_K(Y, 1); SB_;
            LD_K(Y, 3); SB_; MF_K(X, 2); SB_;
            MF_K(Y, 3);
#undef SB_
#undef LD_N
#undef LD_Q
#undef LD_M
#undef LD_K
#undef MF_N
#undef MF_Q
#undef MF_M
#undef MF_K
            egl = *(const float*)(recn + DN_EGL);
            __syncthreads();
        }
        if (ctx) { float* so = pout(p) + (size_t)NTOK * DM + ((size_t)((sq * 2 + l) * 2 + dir) * 8 + h) * 16384;
#pragma unroll
            for (int t = 0; t < 2; ++t)
#pragma unroll
                for (int m = 0; m < 8; ++m)
#pragma unroll
                    for (int j = 0; j < 4; ++j) so[(16 * m + 4 * q + j) * 128 + dv0 + 16 * t + c] = S[t][m][j]; }
    }
#undef SCAN_GC
}

__device__ __forceinline__ void lna_group(const Params& p, int l, int grp) {
    const int tid = opaque_tid(), lane = tid & 63, wid = tid >> 6;
    const int tok = grp * 8 + wid;
    const bf16_t* y = (const bf16_t*)(pws(p) + WS_Y) + (size_t)tok * 1024;
    const bf16_t* az = (const bf16_t*)(pws(p) + WS_P) + (size_t)tok * NP + C_AZ;
    bf16_t* U = (bf16_t*)(pws(p) + WS_U) + (size_t)tok * 2048;
    const float* lg = pin(p, 11) + l * 1024; const float* lb = pin(p, 12) + l * 1024;
    f32x4 v[4]; float s = 0.f;
#pragma unroll
    for (int i = 0; i < 4; ++i) { v[i] = bf4_to_f32(*(const u32x2*)(y + (lane + 64 * i) * 4)); s += v[i][0] + v[i][1] + v[i][2] + v[i][3]; }
    const float mu = wave_sum(s) * (1.0f / 1024.0f);
    float s2 = 0.f;
#pragma unroll
    for (int i = 0; i < 4; ++i) { v[i] -= mu; s2 += v[i][0] * v[i][0] + v[i][1] * v[i][1] + v[i][2] * v[i][2] + v[i][3] * v[i][3]; }
    const float rstd = rsqrtf(wave_sum(s2) * (1.0f / 1024.0f) + EPS);
#pragma unroll
    for (int i = 0; i < 4; ++i) { const int cc = (lane + 64 * i) * 4; const f32x4 g = *(const f32x4*)(lg + cc), bb = *(const f32x4*)(lb + cc);
        const u32x2 zz = *(const u32x2*)(az + cc);
        f32x4 o = v[i] * rstd * g + bb;
        const float z0 = __uint_as_float(zz[0] << 16), z1 = __uint_as_float(zz[0] & 0xffff0000u), z2 = __uint_as_float(zz[1] << 16), z3 = __uint_as_float(zz[1] & 0xffff0000u);
        u32x2 ov; ov[0] = pk2(siluf_(o[0]) * siluf_(z0), siluf_(o[1]) * siluf_(z1)); ov[1] = pk2(siluf_(o[2]) * siluf_(z2), siluf_(o[3]) * siluf_(z3));
        *(u32x2*)(U + cc) = ov; }
}

__device__ __forceinline__ void ps_phase(const Params& p, int l, unsigned char* lds) {
    const int b = blockIdx.x, G = gridDim.x;
    for (int r = 0;; ++r) { const int id = r * G + (r == 0 ? b : (b + 64 * G - 64) % G); if (id >= 320) break;
        const int sq = id < 64 ? 16 + (id >> 4) : ((id - 64) >> 4);
        for (int rsc = 0; rsc < REP_SCAN; ++rsc) scan_item(p, l, sq, (id >> 1) & 7, id & 1, lds); }
    const int gs = G == 256 ? (b >= 64 ? b - 64 : 1024) : b, gst = G == 256 ? 192 : G;
    for (int rl = 0; rl < REP_LNA; ++rl) for (int g = gs; g < 1024; g += gst) lna_group(p, l, g);
    if (l == 0) drain_tiles(p, 1 << 20, lds);
}

__device__ __forceinline__ void pnb_phase(const Params& p, int l) {
    const int tid = opaque_tid(), lane = tid & 63, wid = tid >> 6;
    const bf16_t* Of = (const bf16_t*)(pws(p) + WS_R1); const bf16_t* Ob = Of + (size_t)NTOK * 1024;
    const float* hg = pin(p, 17) + l * 128;
    for (int tok = blockIdx.x * 8 + wid; tok < NTOK; tok += gridDim.x * 8) {
        const int cb = lane * 16;
        f32x4 v[4]; float ss = 0.f;
#pragma unroll
        for (int i = 0; i < 4; ++i) { v[i] = bf4_to_f32(*(const u32x2*)(Of + (size_t)tok * 1024 + cb + 4 * i)) + bf4_to_f32(*(const u32x2*)(Ob + (size_t)tok * 1024 + cb + 4 * i));
            ss += v[i][0] * v[i][0] + v[i][1] * v[i][1] + v[i][2] * v[i][2] + v[i][3] * v[i][3]; }
        ss += __shfl_xor(ss, 1); ss += __shfl_xor(ss, 2); ss += __shfl_xor(ss, 4);
        const float rstd = rsqrtf(ss * (1.0f / 128.0f) + EPS);
        const bf16_t* zb = (const bf16_t*)(pws(p) + WS_P) + (size_t)tok * NP + C_ZB + cb;
        bf16_t* U = (bf16_t*)(pws(p) + WS_U) + (size_t)tok * 2048 + 1024 + cb;
        const u32x4 z0 = *(const u32x4*)zb, z1 = *(const u32x4*)(zb + 8);
        float o[16];
#pragma unroll
        for (int i = 0; i < 4; ++i) { const f32x4 g = *(const f32x4*)(hg + ((cb + 4 * i) & 127));
#pragma unroll
            for (int e = 0; e < 4; ++e) o[4 * i + e] = v[i][e] * rstd * g[e]; }
        u32x4 r0, r1;
#pragma unroll
        for (int w2 = 0; w2 < 4; ++w2) { const unsigned za = z0[w2], zc = z1[w2];
            r0[w2] = pk2(o[2 * w2] * siluf_(__uint_as_float(za << 16)), o[2 * w2 + 1] * siluf_(__uint_as_float(za & 0xffff0000u)));
            r1[w2] = pk2(o[8 + 2 * w2] * siluf_(__uint_as_float(zc << 16)), o[8 + 2 * w2 + 1] * siluf_(__uint_as_float(zc & 0xffff0000u))); }
        *(u32x4*)U = r0; *(u32x4*)(U + 8) = r1;
    }
}

#define XB_TMO      128
#define XB_XCNT(j)  (256  + 64 * (j))
#define XB_XSUB(j)  (1280 + 64 * (j))
#define XB_XGEN(j)  (2304 + 64 * (j))
#define XB_TOP      3328
#define XB_TOPGEN   3392
#define XCD_BAR_WORDS 3456
#define XB_SPIN_CAP (1u << 18)

__device__ __forceinline__ unsigned xb_ld(unsigned* p)              { return __hip_atomic_load(p, __ATOMIC_RELAXED, __HIP_MEMORY_SCOPE_AGENT); }
__device__ __forceinline__ unsigned xb_add(unsigned* p, unsigned v) { return __hip_atomic_fetch_add(p, v, __ATOMIC_RELAXED, __HIP_MEMORY_SCOPE_AGENT); }
__device__ __forceinline__ unsigned xb_xcc_id() { return (unsigned)__builtin_amdgcn_s_getreg((3 << 11) | 20) & 0xFu; }
#define XB_SPIN(cond, bar) do { unsigned _sp = 0; while (cond) { __builtin_amdgcn_s_sleep(1); \
    if ((++_sp & 255u) == 0u) { if (xb_ld(&(bar)[XB_TMO])) break; if (_sp > XB_SPIN_CAP) { atomicAdd(&(bar)[XB_TMO], 1u); break; } } } } while (0)

struct XcdBarrier {
    unsigned* bar; unsigned x;
    volatile LAS unsigned* st;
};

__device__ __forceinline__ XcdBarrier xcd_barrier_post(unsigned* bar, volatile LAS unsigned* st) {
    XcdBarrier b; b.bar = bar; b.x = xb_xcc_id(); b.st = st;
    if (threadIdx.x == 0) (void)xb_add(&bar[XB_XCNT(b.x)], 1u);
    return b;
}
__device__ __forceinline__ void xcd_barrier_complete(unsigned* bar, unsigned x, unsigned& nloc, unsigned& nx) {
    const unsigned G = gridDim.x * gridDim.y * gridDim.z;
    unsigned sum, cnt, mine, sp = 0u;
    for (;;) {
        sum = 0u; cnt = 0u; mine = 0u;
#pragma unroll
        for (unsigned j = 0; j < 16; ++j) { const unsigned c = xb_ld(&bar[XB_XCNT(j)]); sum += c; cnt += (c > 0u) ? 1u : 0u; mine = (j == x) ? c : mine; }
        if (sum == G) break;
        __builtin_amdgcn_s_sleep(1);
        if ((++sp & 255u) == 0u) { if (xb_ld(&bar[XB_TMO])) break; if (sp > XB_SPIN_CAP) { atomicAdd(&bar[XB_TMO], 1u); break; } }
    }
    nloc = mine > 0u ? mine : 1u; nx = cnt > 0u ? cnt : 1u;
}

__device__ __forceinline__ void xcd_barrier(const XcdBarrier& b) {
    asm volatile("s_waitcnt vmcnt(0)" ::: "memory");
    __syncthreads();
    if (threadIdx.x == 0) {
        unsigned* bar = b.bar;
        __builtin_amdgcn_s_waitcnt(0);
        unsigned nloc = b.st[0], nx = b.st[1];
        if (nloc == 0u) { xcd_barrier_complete(bar, b.x, nloc, nx); b.st[0] = nloc; b.st[1] = nx; }
        const unsigned old = xb_add(&bar[XB_XSUB(b.x)], 1u);
        const unsigned gen = old / nloc;
        if (old + 1u == (gen + 1u) * nloc) {
            __builtin_amdgcn_fence(__ATOMIC_RELEASE, "agent");
            asm volatile("s_waitcnt vmcnt(0)" ::: "memory");
            const unsigned og = xb_add(&bar[XB_TOP], 1u);
            const unsigned tg = og / nx;
            if (og + 1u == (tg + 1u) * nx) xb_add(&bar[XB_TOPGEN], 1u);
            else XB_SPIN(xb_ld(&bar[XB_TOPGEN]) == tg, bar);
            __builtin_amdgcn_fence(__ATOMIC_ACQUIRE, "agent");
            xb_add(&bar[XB_XGEN(b.x)], 1u);
            asm volatile("s_waitcnt vmcnt(0)" ::: "memory");
        } else {
            XB_SPIN(xb_ld(&bar[XB_XGEN(b.x)]) == gen, bar);
            __builtin_amdgcn_fence(__ATOMIC_ACQUIRE, "agent");
            asm volatile("s_waitcnt vmcnt(0)" ::: "memory");
        }
    }
    __syncthreads();
}

#ifndef REP0
#define REP0 1
#endif
#ifndef REP1
#define REP1 1
#endif
#ifndef REP2
#define REP2 1
#endif
#ifndef REP3
#define REP3 1
#endif
#ifndef REP4
#define REP4 1
#endif
#ifndef REP5
#define REP5 1
#endif
#ifndef REP6
#define REP6 1
#endif
#ifndef REP7
#define REP7 1
#endif
__global__ void __launch_bounds__(NTHR) fwd_megakernel(Params p) {
    extern __shared__ __attribute__((aligned(16))) unsigned char lds[];
    cg::grid_group grid = cg::this_grid();
    const int lo = p.ph_lo, hi = p.ph_hi;
    if (lo < 0) grid.sync();
    if (threadIdx.x < 2) ((volatile LAS unsigned*)((LAS unsigned char*)lds + LDS_BARST))[threadIdx.x] = 0u;
    __syncthreads();
    const XcdBarrier xbar = xcd_barrier_post((unsigned*)(pws(p) + WS_BARW), (volatile LAS unsigned*)((LAS unsigned char*)lds + LDS_BARST));
#define IN(k) (lo <= (k) && (k) < hi)
#ifndef SYNC_REP
#define SYNC_REP 1
#endif
#define SEAM(k) do { if (IN(k) && IN((k) + 1)) for (int sr = 0; sr < SYNC_REP; ++sr) { xcd_barrier(xbar); } } while (0)
#if (!defined(ONLY) || ONLY == 0) && !defined(SKIP0)
    if (IN(0)) for (int rp = 0; rp < REP0; ++rp) p0_prologue(p, (float*)lds);
#endif
    SEAM(0);
    for (int l = 0; l < 2; ++l) {
        const int pb = 1 + 7 * l;
        unsigned char* ws = pws(p);
#if (!defined(ONLY) || ONLY == 1) && !defined(SKIP1)
        if (IN(pb)) for (int rp = 0; rp < REP1; ++rp) pn_norm(p, l);
#endif
        SEAM(pb);
#if (!defined(ONLY) || ONLY == 2) && !defined(SKIP2)
        if (IN(pb + 1)) for (int rp = 0; rp < REP2; ++rp) {
            pg8::Gemm g{(const bf16_t*)(ws + WS_R1), (const bf16_t*)(ws + WS_WIN + l * SZ_WIN1), NTOK, NP, DM, DM};
            pg8::StaticOrder S; S.init(NTOK, NP, (int)gridDim.x, (int)blockIdx.x);
            EpiP E{(bf16_t*)(ws + WS_P), (float*)(ws + WS_BA)};
            pg8::gemm_phase<EpiP, pg8::StaticOrder, false, GEMM_ALIGN, GEMM_SP2>((LAS unsigned char*)lds, g, S, E, nullptr);
            if (l == 0 && (int)gridDim.x == 256 && (int)blockIdx.x >= 160) drain_tiles(p, PG1_TILES, lds);
        }
#endif
        SEAM(pb + 1);
#if (!defined(ONLY) || ONLY == 3) && !defined(SKIP3)
        if (IN(pb + 2)) for (int rp = 0; rp < REP3; ++rp) pc_phase(p, l, (float*)lds);
#endif
        SEAM(pb + 2);
#if (!defined(ONLY) || ONLY == 4) && !defined(SKIP4)
        if (IN(pb + 3)) for (int rp = 0; rp < REP4; ++rp) ps_phase(p, l, lds);
#endif
        SEAM(pb + 3);
#if (!defined(ONLY) || ONLY == 5) && !defined(SKIP5)
        if (IN(pb + 4)) for (int rp = 0; rp < REP5; ++rp) pnb_phase(p, l);
#endif
        SEAM(pb + 4);
#if (!defined(ONLY) || ONLY == 6) && !defined(SKIP6)
        if (IN(pb + 5)) for (int rp = 0; rp < REP6; ++rp) {
            pg8::Gemm g{(const bf16_t*)(ws + WS_U), (const bf16_t*)(ws + WS_WP2 + l * SZ_SQ), NTOK, DM, 1024, DM};
            ChainOrder S; S.init(NTOK, DM, (int)gridDim.x, (int)blockIdx.x);
            EpiMG E{(const bf16_t*)(ws + WS_P), (bf16_t*)(ws + WS_R1)};
            pg8::gemm_phase<EpiMG, ChainOrder, false, GEMM_ALIGN, GEMM_SP2>((LAS unsigned char*)lds, g, S, E, nullptr);
        }
#endif
        SEAM(pb + 5);
#if (!defined(ONLY) || ONLY == 7) && !defined(SKIP7)
        if (IN(pb + 6)) for (int rp = 0; rp < REP7; ++rp) {
            pg8::Gemm g{(const bf16_t*)(ws + WS_R1), (const bf16_t*)(ws + WS_WO + l * SZ_SQ), NTOK, DM, DM, DM};
            pg8::StaticOrder S; S.init(NTOK, DM, (int)gridDim.x, (int)blockIdx.x);
            EpiX E{pin(p, 0), pin(p, 1), l == 0 ? nullptr : (const float*)(ws + WS_X1), (const float*)(ws + WS_MOD) + (size_t)l * 5 * 6144 + 4096, l == 0 ? (float*)(ws + WS_X1) : (float*)(ws + WS_P)};
            pg8::gemm_phase<EpiX, pg8::StaticOrder, false, GEMM_ALIGN, GEMM_SP2>((LAS unsigned char*)lds, g, S, E, nullptr);
        }
#endif
        SEAM(pb + 6);
    }
#if (!defined(ONLY) || ONLY == 8) && !defined(SKIP8)
    if (IN(15)) pf_final(p);
#endif
}

#ifndef MK_N_LAUNCHES
#define MK_N_LAUNCHES 1
#endif
extern "C" void kernel_launch(void* const* d_in, const int* in_sizes, int n_in, void* d_out, int out_size, void* d_ws, size_t ws_size, hipStream_t stream) {
    static int grid = 0;
    if (grid == 0) {
        int dev = 0, cus = 0, per_cu = 0;
        hipGetDevice(&dev);
        hipDeviceGetAttribute(&cus, hipDeviceAttributeMultiprocessorCount, dev);
        if (hipFuncSetAttribute((const void*)fwd_megakernel, hipFuncAttributeMaxDynamicSharedMemorySize, LDS_BYTES) != hipSuccess) { fprintf(stderr, "kernel_launch: hipFuncSetAttribute failed\n"); grid = -1; return; }
        if (hipOccupancyMaxActiveBlocksPerMultiprocessor(&per_cu, (const void*)fwd_megakernel, NTHR, LDS_BYTES) != hipSuccess || per_cu < 1) { fprintf(stderr, "kernel_launch: occupancy query says %d blocks per CU\n", per_cu); grid = -1; return; }
        grid = cus * 1;
        if (n_in != 21 || ws_size < WS_END2) { fprintf(stderr, "kernel_launch: unexpected n_in %d / ws %zu\n", n_in, ws_size); grid = -1; return; }
    }
    if (grid < 0) return;
    if (hipMemsetAsync((char*)d_ws + WS_BARW, 0, 16384, stream) != hipSuccess) { fprintf(stderr, "kernel_launch: memset failed\n"); return; }
    Params p{};
    for (int i = 0; i < 21; ++i) p.in[i] = (const float*)d_in[i];
    p.out = (float*)d_out; p.ws = (unsigned char*)d_ws;
#if MK_N_LAUNCHES == 1
    p.ph_lo = 0; p.ph_hi = 16;
    void* args[] = {&p};
    hipError_t e = hipLaunchCooperativeKernel((const void*)fwd_megakernel, dim3(grid), dim3(NTHR), args, LDS_BYTES, stream);
    if (e != hipSuccess) fprintf(stderr, "cooperative launch failed: %s (grid %d)\n", hipGetErrorString(e), grid);
#else
    for (int ph = 0; ph < 16; ++ph) { p.ph_lo = ph; p.ph_hi = ph + 1;
        hipLaunchKernelGGL(fwd_megakernel, dim3(grid), dim3(NTHR), LDS_BYTES, stream, p); }
#endif
}
```

```cpp
#include <hip/hip_runtime.h>
#include <hip/hip_cooperative_groups.h>
#include <cstdio>
#include <cstdint>
namespace cg = cooperative_groups;
namespace pg8 {
#define PG8_LAS __attribute__((address_space(3)))
typedef unsigned short bf16_t;
typedef short bf16x8 __attribute__((ext_vector_type(8)));
typedef float f32x4 __attribute__((ext_vector_type(4)));
typedef unsigned u32x4 __attribute__((ext_vector_type(4)));
constexpr int BM = 256, BK = 64, HALF = 128, HTB = HALF * BK * 2  , STAGE_BYTES = 8 * HTB, NXCD = 8, WGM = 8;

__host__ __device__ __forceinline__ int lds_byte(int r, int c) { const int st = (r >> 4) * 2 + (c >> 5), rr = r & 15, cc = c & 31, ob = rr * 64 + cc * 2; return st * 1024 + (ob ^ (((ob >> 9) & 1) << 5)); }
__host__ __device__ __forceinline__ void stage_rc(int b, int& R, int& C) { const int st = b / 1024, sb = b % 1024, swz = sb ^ (((sb >> 9) & 1) << 5); R = (st >> 1) * 16 + swz / 64; C = (st & 1) * 32 + (swz % 64) / 2; }
__host__ __device__ __forceinline__ int perm32(int rho) { const int n = rho >> 4, i = rho & 15; return 8 * (i >> 2) + 4 * n + (i & 3); }

struct Unit { int pm, pn, kh; };
struct Gemm { const bf16_t* A; const bf16_t* Bt; int M, N, K, lda; };

struct StaticOrder {
    int nM, nN, nwg, G, c;
    __host__ __device__ void init(int M, int N, int G_, int c_) { nM = M / BM; nN = N / BM; nwg = nM * nN; G = G_; c = c_; }
    __host__ __device__ bool next(int i, Unit& u) const {
        const long L = (long)i * G + c; if (L >= nwg) return false;
        int wgid = (int)L; { const int q = nwg / NXCD, r = nwg % NXCD, xcd = wgid % NXCD, off = wgid / NXCD; wgid = (xcd < r ? xcd * (q + 1) : r * (q + 1) + (xcd - r) * q) + off; }
        const int nig = WGM * nN, gid = wgid / nig, fm = gid * WGM, gsz = (nM - fm) < WGM ? (nM - fm) : WGM;
        u.pm = fm + ((wgid % nig) % gsz); u.pn = (wgid % nig) / gsz; u.kh = 0; return true;
    }
    __device__ __forceinline__ void a_ready(const Unit&) const {}
    __device__ __forceinline__ void done(const Unit&) const {}
};
__device__ __forceinline__ unsigned cvt_pk_bf16(float lo, float hi) { unsigned r; asm volatile("v_cvt_pk_bf16_f32 %0, %1, %2" : "=v"(r) : "v"(lo), "v"(hi)); return r; }
template <class Epi, class Sched, bool STAMP = false, bool ALIGN_EPI = false, bool SP2 = false>
__device__ __forceinline__ void gemm_phase(PG8_LAS unsigned char* lds, const Gemm g, const Sched& S, const Epi& E, unsigned long long* stamps) {
    int tid_ = threadIdx.x; asm volatile("" : "+v"(tid_)); const int tid = tid_, wid = __builtin_amdgcn_readfirstlane(tid >> 6), lane = tid & 63, wr = wid >> 2, wc = wid & 3, fr = lane & 15, fq = lane >> 4;
    const int K = g.K, nt = K / BK;
    int ts_lo = 0, ts_hi = 0, nts = 0; const unsigned long long rt_entry = STAMP ? (unsigned long long)wall_clock64() : 0ull;
#define PG8_STAMP() do { if (STAMP && wid == 0 && nts < 64) { const unsigned long long _c = (unsigned long long)clock64(); \
        ts_lo = (lane == nts) ? (int)(unsigned)_c : ts_lo; ts_hi = (lane == nts) ? (int)(unsigned)(_c >> 32) : ts_hi; ++nts; } } while (0)
    PG8_STAMP();
    unsigned voffA[2], voffB[2];
#pragma unroll
    for (int i = 0; i < 2; ++i) { int R, C; stage_rc(tid * 16 + i * 8192, R, C); const int Rb = Epi::PERM ? ((R & ~31) + perm32(R & 31)) : R;
        voffA[i] = (unsigned)(R * g.lda + C) * 2u; voffB[i] = (unsigned)(Rb * g.lda + C) * 2u; }
    const size_t kstep = (size_t)(BK * 2);
    const size_t hstep = (size_t)HALF * g.lda * 2; const size_t khstep = (size_t)K * 2;
    const size_t tstep = 2 * hstep;
    const unsigned ldsw = (unsigned)wid * 1024u;
    const int aoff = lds_byte(wr * 64 + fr, fq * 8), boff = lds_byte(wc * 32 + fr, fq * 8);
#define PG8_SA(b, h) (((b) * 2 + (h)) * HTB)
#define PG8_SB(b, h) ((4 + (b) * 2 + (h)) * HTB)
#define PG8_STAGE(bufoff, gbase, voff) do { _Pragma("unroll") for (int _i = 0; _i < 2; ++_i) \
        __builtin_amdgcn_global_load_lds((const unsigned*)((const char*)(gbase) + (voff)[_i]), (PG8_LAS unsigned*)(lds + (bufoff) + ldsw + _i * 8192), 16, 0, 0); } while (0)
#define PG8_LDA(dst, b, h) do { _Pragma("unroll") for (int m = 0; m < 4; ++m) _Pragma("unroll") for (int k = 0; k < 2; ++k) dst[m][k] = *(const PG8_LAS bf16x8*)(lds + PG8_SA(b, h) + aoff + m * 2048 + k * 1024); } while (0)
#define PG8_LDB(dst, b, h) do { _Pragma("unroll") for (int n = 0; n < 2; ++n) _Pragma("unroll") for (int k = 0; k < 2; ++k) dst[n][k] = *(const PG8_LAS bf16x8*)(lds + PG8_SB(b, h) + boff + n * 2048 + k * 1024); } while (0)
#define PG8_MMA(ai, bj, At, Bt) do { __builtin_amdgcn_s_setprio(1); _Pragma("unroll") for (int m = 0; m < 4; ++m) _Pragma("unroll") for (int n = 0; n < 2; ++n) _Pragma("unroll") for (int k = 0; k < 2; ++k) \
        acc[ai][bj][m][n] = __builtin_amdgcn_mfma_f32_16x16x32_bf16(Bt[n][k], At[m][k], acc[ai][bj][m][n], 0, 0, 0); __builtin_amdgcn_s_setprio(0); } while (0)
#define PG8_WAIT_V(n) asm volatile("s_waitcnt vmcnt(" #n ")" ::: "memory")
#define PG8_WAIT_L(n) asm volatile("s_waitcnt lgkmcnt(" #n ")" ::: "memory")
#define PG8_BAR __builtin_amdgcn_s_barrier()
#define PG8_SCHED __builtin_amdgcn_sched_barrier(0)
    Unit cur, nxt; int ui = 0;
    if (!S.next(0, cur)) return;
    f32x4 acc[2][2][4][2];
#pragma unroll
    for (int a = 0; a < 2; ++a)
#pragma unroll
        for (int b = 0; b < 2; ++b)
#pragma unroll
            for (int m = 0; m < 4; ++m)
#pragma unroll
                for (int n = 0; n < 2; ++n) acc[a][b][m][n] = (f32x4){0.f, 0.f, 0.f, 0.f};
    bf16x8 At[4][2], B0[2][2], B1[2][2];
    const char* cA = (const char*)g.A + (size_t)cur.pm * tstep + cur.kh * khstep; const char* cB = (const char*)g.Bt + (size_t)cur.pn * tstep + cur.kh * khstep;
    S.a_ready(cur);
    if constexpr (SP2) {
        PG8_STAGE(PG8_SB(0, 0), cB, voffB); PG8_STAGE(PG8_SB(0, 1), cB + hstep, voffB); PG8_STAGE(PG8_SA(0, 0), cA, voffA); PG8_STAGE(PG8_SA(0, 1), cA + hstep, voffA);
        if (wr == 1) PG8_BAR;
        PG8_WAIT_V(2); PG8_BAR;
        PG8_STAGE(PG8_SB(1, 0), cB + kstep, voffB); PG8_STAGE(PG8_SA(1, 0), cA + kstep, voffA); PG8_STAGE(PG8_SB(1, 1), cB + hstep + kstep, voffB);
        PG8_WAIT_V(6); PG8_BAR;
    } else {
    PG8_STAGE(PG8_SB(0, 0), cB, voffB); PG8_STAGE(PG8_SA(0, 0), cA, voffA); PG8_STAGE(PG8_SB(0, 1), cB + hstep, voffB); PG8_STAGE(PG8_SA(0, 1), cA + hstep, voffA);
    if (wr == 1) PG8_BAR;
    PG8_WAIT_V(4); PG8_BAR;
    PG8_STAGE(PG8_SB(1, 0), cB + kstep, voffB); PG8_STAGE(PG8_SA(1, 0), cA + kstep, voffA); PG8_STAGE(PG8_SB(1, 1), cB + hstep + kstep, voffB);
    PG8_WAIT_V(6); PG8_BAR;
    }
    PG8_STAMP();
    for (;;) {
        const bool has_next = S.next(ui + 1, nxt);
        const char* nA = has_next ? (const char*)g.A + (size_t)nxt.pm * tstep + nxt.kh * khstep : cA; const char* nB = has_next ? (const char*)g.Bt + (size_t)nxt.pn * tstep + nxt.kh * khstep : cB;
        for (int t = 0; t < nt; t += 2) {
            const bool last = (t == nt - 2);
            const char* a1 = cA + (size_t)(t + 1) * kstep;
            const char* a2 = last ? nA : cA + (size_t)(t + 2) * kstep; const char* b2 = last ? nB : cB + (size_t)(t + 2) * kstep;
            const char* a3 = a2 + kstep; const char* b3 = b2 + kstep;
            if (last && has_next) S.a_ready(nxt);
            if constexpr (SP2) {
            PG8_LDB(B0, 0, 0); PG8_LDB(B1, 0, 1); PG8_SCHED; PG8_LDA(At, 0, 0); PG8_STAGE(PG8_SA(1, 1), a1 + hstep, voffA);
            PG8_WAIT_V(8); PG8_WAIT_L(0); PG8_BAR; PG8_MMA(0, 0, At, B0); PG8_MMA(0, 1, At, B1); PG8_BAR; PG8_SCHED;
            PG8_LDA(At, 0, 1); PG8_STAGE(PG8_SB(0, 0), b2, voffB); PG8_STAGE(PG8_SB(0, 1), b2 + hstep, voffB); PG8_STAGE(PG8_SA(0, 0), a2, voffA);
            PG8_WAIT_V(8); PG8_WAIT_L(0); PG8_BAR; PG8_MMA(1, 0, At, B0); PG8_MMA(1, 1, At, B1); PG8_BAR; PG8_SCHED;
            PG8_LDB(B0, 1, 0); PG8_LDB(B1, 1, 1); PG8_SCHED; PG8_LDA(At, 1, 0); PG8_STAGE(PG8_SA(0, 1), a2 + hstep, voffA);
            PG8_WAIT_V(8); PG8_WAIT_L(0); PG8_BAR; PG8_MMA(0, 0, At, B0); PG8_MMA(0, 1, At, B1); PG8_BAR; PG8_SCHED;
            PG8_LDA(At, 1, 1); PG8_STAGE(PG8_SB(1, 0), b3, voffB); PG8_STAGE(PG8_SB(1, 1), b3 + hstep, voffB); PG8_STAGE(PG8_SA(1, 0), a3, voffA);
            PG8_WAIT_V(8); PG8_WAIT_L(0); PG8_BAR; PG8_MMA(1, 0, At, B0); PG8_MMA(1, 1, At, B1); PG8_BAR; PG8_SCHED;
            } else {
            PG8_LDB(B0, 0, 0); PG8_SCHED; PG8_LDA(At, 0, 0); PG8_STAGE(PG8_SA(1, 1), a1 + hstep, voffA);
            PG8_WAIT_L(8); PG8_BAR; PG8_WAIT_L(0); PG8_MMA(0, 0, At, B0); PG8_BAR; PG8_SCHED;
            PG8_LDB(B1, 0, 1); PG8_STAGE(PG8_SB(0, 0), b2, voffB);
            PG8_BAR; PG8_WAIT_L(0); PG8_MMA(0, 1, At, B1); PG8_BAR;
            PG8_LDA(At, 0, 1); PG8_STAGE(PG8_SA(0, 0), a2, voffA);
            PG8_BAR; PG8_WAIT_L(0); PG8_MMA(1, 0, At, B0); PG8_BAR; PG8_SCHED;
            PG8_STAGE(PG8_SB(0, 1), b2 + hstep, voffB);
            PG8_WAIT_V(6); PG8_BAR; PG8_MMA(1, 1, At, B1); PG8_BAR;
            PG8_LDB(B0, 1, 0); PG8_SCHED; PG8_LDA(At, 1, 0); PG8_STAGE(PG8_SA(0, 1), a2 + hstep, voffA);
            PG8_WAIT_L(8); PG8_BAR; PG8_WAIT_L(0); PG8_MMA(0, 0, At, B0); PG8_BAR; PG8_SCHED;
            PG8_LDB(B1, 1, 1); PG8_STAGE(PG8_SB(1, 0), b3, voffB);
            PG8_BAR; PG8_WAIT_L(0); PG8_MMA(0, 1, At, B1); PG8_BAR;
            PG8_LDA(At, 1, 1); PG8_STAGE(PG8_SA(1, 0), a3, voffA);
            PG8_BAR; PG8_WAIT_L(0); PG8_MMA(1, 0, At, B0); PG8_BAR; PG8_SCHED;
            PG8_STAGE(PG8_SB(1, 1), b3 + hstep, voffB);
            PG8_WAIT_V(6); PG8_BAR; PG8_MMA(1, 1, At, B1); PG8_BAR;
            }
        }
        PG8_STAMP();
        if constexpr (ALIGN_EPI) { if (wr == 0) PG8_BAR; }
        if constexpr (!Epi::AFTER_DRAIN) { E(acc, cur, wr, wc, fr, fq); S.done(cur); }
        PG8_STAMP();
        if (!has_next) break;
        if (!(Epi::CHAIN && cur.kh == 0))
#pragma unroll
        for (int a = 0; a < 2; ++a)
#pragma unroll
            for (int b = 0; b < 2; ++b)
#pragma unroll
                for (int m = 0; m < 4; ++m)
#pragma unroll
                    for (int n = 0; n < 2; ++n) acc[a][b][m][n] = (f32x4){0.f, 0.f, 0.f, 0.f};
        cur = nxt; cA = nA; cB = nB; ++ui;
        if constexpr (ALIGN_EPI) { if (wr == 1) PG8_BAR; }
    }
    PG8_WAIT_V(0);
    if constexpr (!ALIGN_EPI) { if (wr == 0) PG8_BAR; }
    PG8_BAR;
    if constexpr (Epi::AFTER_DRAIN) { E.fused(acc, cur, wr, wc, fr, fq, lds, wid, lane); S.done(cur); }
    PG8_STAMP();
    if (STAMP && wid == 0) { stamps[lane] = lane < nts ? (((unsigned long long)(unsigned)ts_hi << 32) | (unsigned)ts_lo) : 0ull;
        if (lane == 62) stamps[62] = rt_entry; if (lane == 63) stamps[63] = (unsigned long long)wall_clock64(); }
#undef PG8_STAMP
#undef PG8_SA
#undef PG8_SB
#undef PG8_STAGE
#undef PG8_LDA
#undef PG8_LDB
#undef PG8_MMA
#undef PG8_WAIT_V
#undef PG8_WAIT_L
#undef PG8_BAR
#undef PG8_SCHED
}
}
#ifndef GEMM_SP2
#define GEMM_SP2 true
#endif
#ifndef GEMM_ALIGN
#define GEMM_ALIGN true
#endif
#ifndef REP_DN
#define REP_DN 1
#endif
#ifndef REP_CONV
#define REP_CONV 1
#endif
#ifndef PG1_TILES
#define PG1_TILES 6
#endif
#ifndef REP_SCAN
#define REP_SCAN 1
#endif
#ifndef REP_TILES
#define REP_TILES 1
#endif
#ifndef REP_LNA
#define REP_LNA 1
#endif
#ifndef REP_GRAM
#define REP_GRAM 1
#endif
#ifndef REP_E
#define REP_E 1
#endif
#ifndef REP_SOLVE
#define REP_SOLVE 1
#endif

#define LAS __attribute__((address_space(3)))
typedef unsigned short bf16_t;
typedef short bf16x8 __attribute__((ext_vector_type(8)));
typedef float f32x4 __attribute__((ext_vector_type(4)));
typedef unsigned u32x4 __attribute__((ext_vector_type(4)));
typedef unsigned u32x2 __attribute__((ext_vector_type(2)));

constexpr int NTOK = 8192, DM = 2048, NCTX = 4096, NP = 11520, NTHR = 512;
constexpr int C_AVAL = 0, C_AGLU = 1024, C_AZ = 2048, C_Q = 3072, C_ZB = 6144, C_GA = 7168, C_GB = 9216, C_BA = 11264;
constexpr float EPS = 1e-6f;
constexpr int LDS_BYTES = 139264;
constexpr int LDS_TQ = LDS_BYTES - 8;
constexpr int LDS_BARST = LDS_BYTES - 16;
constexpr int XCD_BAR_BYTES = 3456 * 4;

constexpr size_t WS_WIN = 256;
constexpr size_t SZ_WIN1 = (size_t)NP * DM * 2;
constexpr size_t WS_WP2 = WS_WIN + 2 * SZ_WIN1;
constexpr size_t SZ_SQ = (size_t)DM * DM * 2;
constexpr size_t WS_WO = WS_WP2 + 2 * SZ_SQ;
constexpr size_t WS_MOD = WS_WO + 2 * SZ_SQ;
constexpr size_t WS_R1 = WS_MOD + 2 * 5 * 6144 * 4;
constexpr size_t WS_P = WS_R1 + (size_t)2 * NTOK * 1024 * 4;
constexpr size_t WS_BA = WS_P + (size_t)NTOK * NP * 2;
constexpr size_t WS_Y = WS_BA + (size_t)NTOK * 32 * 4;
constexpr size_t WS_U = WS_Y + (size_t)NTOK * 1024 * 4;
constexpr size_t WS_DN = WS_U + (size_t)NTOK * 2048 * 2;
constexpr int DN_NEGW = 0, DN_QDEC = 16384, DN_KDT = 32768, DN_QKM = 49152, DN_UT = 57344, DN_EGL = 90112, DN_REC = 90368;
constexpr size_t WS_X1 = WS_DN + (size_t)2048 * DN_REC;
constexpr size_t WS_END = WS_X1 + (size_t)NTOK * DM * 4;
constexpr size_t WS_BARW = WS_END;
constexpr size_t WS_TQ = WS_BARW + 15360;
constexpr size_t WS_END2 = WS_BARW + 16384;
static_assert(WS_END2 <= 740294656ull && XCD_BAR_BYTES <= 16384, "workspace");

__device__ __forceinline__ int opaque_tid() { int t = threadIdx.x; asm volatile("" : "+v"(t)); return t; }
struct Params { const float* in[21]; float* out; unsigned char* ws; int ph_lo, ph_hi; };
#define KA_ __attribute__((address_space(4)))
__device__ __forceinline__ const float* pin(const Params&, int k) { const KA_ char* ka = (const KA_ char*)__builtin_amdgcn_kernarg_segment_ptr(); return *(const float* const volatile KA_*)(ka + 8 * k); }
__device__ __forceinline__ unsigned char* pws(const Params&) { const KA_ char* ka = (const KA_ char*)__builtin_amdgcn_kernarg_segment_ptr(); return *(unsigned char* const volatile KA_*)(ka + 8 * 22); }
__device__ __forceinline__ float* pout(const Params&) { const KA_ char* ka = (const KA_ char*)__builtin_amdgcn_kernarg_segment_ptr(); return *(float* const volatile KA_*)(ka + 8 * 21); }

__device__ __forceinline__ float bf2f(unsigned short b) { return __uint_as_float(((unsigned)b) << 16); }
__device__ __forceinline__ unsigned f2bf(float f) { unsigned u = __float_as_uint(f); u += 0x7fffu + ((u >> 16) & 1u); return u >> 16; }
typedef float f32x2_t __attribute__((ext_vector_type(2)));
typedef __bf16 bf16x2_t __attribute__((ext_vector_type(2)));
__device__ __forceinline__ unsigned pk2(float lo, float hi) { const f32x2_t v = {lo, hi}; return __builtin_bit_cast(unsigned, __builtin_convertvector(v, bf16x2_t)); }
__device__ __forceinline__ float sigmoidf_(float x) { return __builtin_amdgcn_rcpf(1.0f + __expf(-x)); }
__device__ __forceinline__ float siluf_(float x) { return x * __builtin_amdgcn_rcpf(1.0f + __expf(-x)); }
__device__ __forceinline__ f32x4 bf4_to_f32(u32x2 w) { return (f32x4){__uint_as_float(w[0] << 16), __uint_as_float(w[0] & 0xffff0000u), __uint_as_float(w[1] << 16), __uint_as_float(w[1] & 0xffff0000u)}; }
__device__ __forceinline__ float wave_sum(float v) {
#pragma unroll
    for (int o = 32; o > 0; o >>= 1) v += __shfl_xor(v, o);
    return v;
}
__device__ __forceinline__ const float* xrow0(const Params& p, int tok) { return tok < NCTX ? pin(p, 0) + (size_t)tok * DM : pin(p, 1) + (size_t)(tok - NCTX) * DM; }
__device__ __forceinline__ int cvec_of(int tok) { return tok < NCTX ? 0 : 1 + ((tok - NCTX) >> 10); }

__device__ __forceinline__ void tr_tile(const float* __restrict__ src, int ldsrc, int k0, int n0, int mode, bf16_t* __restrict__ dst, int lddst, int koff, float* lds) {
    const int tid = opaque_tid();
    { const int c4 = tid & 31, rr = tid >> 5; const int np = n0 + c4 * 4; int sc = np;
        if (mode == 1) {
            if (np < 2048) { const int T = np >> 8, w = np & 255; sc = w < 128 ? 128 * T + w : 1024 + 128 * T + (w - 128); }
            else if (np < 7168) sc = np; else if (np < 11264) { const int off = np - 7168, T = off >> 8, w = off & 255; sc = w < 128 ? 7200 + 128 * T + w : 9248 + 128 * T + (w - 128); }
            else sc = np < 11296 ? np - 11264 + 7168 : -1; }
#pragma unroll
        for (int i = 0; i < 8; ++i) { const int r = rr + 16 * i;
            *(f32x4*)(lds + r * 132 + c4 * 4) = sc >= 0 ? *(const f32x4*)(src + (size_t)(k0 + r) * ldsrc + sc) : (f32x4){0.f, 0.f, 0.f, 0.f}; } }
    __syncthreads();
#pragma unroll
    for (int i = 0; i < 4; ++i) { const int u = tid + 512 * i, nn = u & 127, kg = u >> 7;
        u32x4 o;
#pragma unroll
        for (int j = 0; j < 4; ++j) o[j] = pk2(lds[(kg * 8 + 2 * j) * 132 + nn], lds[(kg * 8 + 2 * j + 1) * 132 + nn]);
        *(u32x4*)(dst + (size_t)(n0 + nn) * lddst + koff + k0 + kg * 8) = o; }
    __syncthreads();
}
__device__ __forceinline__ void weight_tile(const Params& p, int it, float* lds) {
    unsigned char* ws = pws(p);
    const int l = it / 1952; int r = it % 1952;
    const float* src; int ldsrc, kt, ntile, mode = 0, koff = 0; bf16_t* dst;
    if (r < 1440) { kt = r / 90; ntile = r % 90; src = pin(p, 8) + (size_t)l * 2048 * 11296; ldsrc = 11296; mode = 1; dst = (bf16_t*)(ws + WS_WIN + l * SZ_WIN1); }
    else if (r < 1440 + 256) { r -= 1440; const int which = r / 128; r %= 128; kt = r / 16; ntile = r % 16;
        src = pin(p, which ? 18 : 13) + (size_t)l * 1024 * 2048; ldsrc = 2048; dst = (bf16_t*)(ws + WS_WP2 + l * SZ_SQ); koff = which * 1024; }
    else { r -= 1696; kt = r / 16; ntile = r % 16; src = pin(p, 19) + (size_t)l * 2048 * 2048; ldsrc = 2048; dst = (bf16_t*)(ws + WS_WO + l * SZ_SQ); }
    tr_tile(src, ldsrc, kt * 128, ntile * 128, mode, dst, 2048, koff, lds);
}

__device__ __forceinline__ void drain_tiles(const Params& p, int max_tiles, unsigned char* lds) {
    volatile LAS unsigned* slot = (volatile LAS unsigned*)((LAS unsigned char*)lds + LDS_TQ);
    __syncthreads();
    for (int n = 0; n < max_tiles; ++n) {
        if (threadIdx.x == 0) *slot = __hip_atomic_fetch_add((unsigned*)(pws(p) + WS_TQ), 1u, __ATOMIC_RELAXED, __HIP_MEMORY_SCOPE_AGENT);
        __syncthreads();
        const unsigned it = *slot;
        if (it >= 2u * 1952u - 1440u) break;
        weight_tile(p, 1440 + (int)it, (float*)lds);
    }
}
__device__ __forceinline__ void p0_prologue(const Params& p, float* lds) {
    const int tid = opaque_tid(), G = gridDim.x, b = blockIdx.x;
    unsigned char* ws = pws(p);
    for (int it = b; it < 1440; it += G) weight_tile(p, it, lds);
    float* sc = lds;
    float* red = lds + 5 * 2048;
    __syncthreads();
    for (int i = tid; i < 5 * 2048; i += NTHR) { const int v = i >> 11, k = i & 2047; const float x = v == 0 ? pin(p, 4)[k] : pin(p, 3)[(v - 1) * 2048 + k]; sc[i] = siluf_(x); }
    __syncthreads();
    for (int it = b; it < 192; it += G) {
        const int l = it / 96, col0 = (it % 96) * 64;
        const int kq = tid >> 4, c4 = tid & 15;
        f32x4 acc[5];
#pragma unroll
        for (int v = 0; v < 5; ++v) acc[v] = (f32x4){0.f, 0.f, 0.f, 0.f};
        const float* wp = pin(p, 5) + (size_t)l * 2048 * 6144 + col0 + c4 * 4;
#pragma unroll 8
        for (int i = 0; i < 64; ++i) { const int k = kq + 32 * i; const f32x4 w = *(const f32x4*)(wp + (size_t)k * 6144);
#pragma unroll
            for (int v = 0; v < 5; ++v) acc[v] += w * sc[v * 2048 + k]; }
#pragma unroll
        for (int v = 0; v < 5; ++v) *(f32x4*)(red + (kq * 5 + v) * 64 + c4 * 4) = acc[v];
        __syncthreads();
        if (tid < 320) { const int v = tid >> 6, c = tid & 63; float s = 0.f;
            for (int q = 0; q < 32; ++q) s += red[(q * 5 + v) * 64 + c];
            ((float*)(ws + WS_MOD))[(size_t)(l * 5 + v) * 6144 + col0 + c] = s + pin(p, 6)[l * 6144 + col0 + c]; }
        __syncthreads();
    }
}

__device__ __forceinline__ void pn_norm(const Params& p, int l) {
    const int tid = opaque_tid(), lane = tid & 63, wid = tid >> 6;
    bf16_t* XN = (bf16_t*)(pws(p) + WS_R1);
    const float* MOD = (const float*)(pws(p) + WS_MOD);
    const float* ng = pin(p, 7) + l * DM;
    for (int tok = blockIdx.x * 8 + wid; tok < NTOK; tok += gridDim.x * 8) {
        const float* xr = l == 0 ? xrow0(p, tok) : (const float*)(pws(p) + WS_X1) + (size_t)tok * DM;
        f32x4 v[8]; float ss = 0.f;
#pragma unroll
        for (int i = 0; i < 8; ++i) { v[i] = *(const f32x4*)(xr + (lane + 64 * i) * 4); ss += v[i][0] * v[i][0] + v[i][1] * v[i][1] + v[i][2] * v[i][2] + v[i][3] * v[i][3]; }
        ss = wave_sum(ss);
        const float rstd = rsqrtf(ss * (1.0f / DM) + EPS);
        const float* md = MOD + (size_t)(l * 5 + cvec_of(tok)) * 6144;
#pragma unroll
        for (int i = 0; i < 8; ++i) { const int c = (lane + 64 * i) * 4;
            const f32x4 g = *(const f32x4*)(ng + c), sh = *(const f32x4*)(md + c), scl = *(const f32x4*)(md + 2048 + c);
            const f32x4 h = (v[i] * rstd * g) * (scl + 1.0f) + sh;
            u32x2 o; o[0] = pk2(h[0], h[1]); o[1] = pk2(h[2], h[3]);
            *(u32x2*)(XN + (size_t)tok * DM + c) = o; }
    }
}
__device__ __forceinline__ void pf_final(const Params& p) {
    const int tid = opaque_tid(), lane = tid & 63, wid = tid >> 6;
    const float* X2 = (const float*)(pws(p) + WS_P);
    const float* fg = pin(p, 20);
    for (int tok = blockIdx.x * 8 + wid; tok < NTOK; tok += gridDim.x * 8) {
        const float* xr = X2 + (size_t)tok * DM;
        f32x4 v[8]; float ss = 0.f;
#pragma unroll
        for (int i = 0; i < 8; ++i) { v[i] = *(const f32x4*)(xr + (lane + 64 * i) * 4); ss += v[i][0] * v[i][0] + v[i][1] * v[i][1] + v[i][2] * v[i][2] + v[i][3] * v[i][3]; }
        ss = wave_sum(ss);
        const float rstd = rsqrtf(ss * (1.0f / DM) + EPS);
#pragma unroll
        for (int i = 0; i < 8; ++i) { const int c = (lane + 64 * i) * 4; const f32x4 g = *(const f32x4*)(fg + c);
            *(f32x4*)(pout(p) + (size_t)tok * DM + c) = v[i] * rstd * g; }
    }
}

struct ChainOrder : pg8::StaticOrder {
    __device__ bool next(int i, pg8::Unit& u) const { const bool ok = pg8::StaticOrder::next(i >> 1, u); u.kh = i & 1; return ok; }
};
struct EpiP {
    static constexpr bool PERM = true, AFTER_DRAIN = false, CHAIN = false;
    bf16_t* P; float* BA;
    __device__ __forceinline__ void operator()(f32x4 (&acc)[2][2][4][2], const pg8::Unit& u, int wr, int wc, int fr, int fq) const {
        const int row0 = u.pm * 256 + wr * 64 + fr, col0 = u.pn * 256 + wc * 32 + 8 * fq;
#pragma unroll
        for (int ai = 0; ai < 2; ++ai)
#pragma unroll
            for (int m = 0; m < 4; ++m) { const int row = row0 + ai * 128 + m * 16; bf16_t* rowp = P + (size_t)row * NP + col0;
                if (u.pn < 8) {
                    f32x4 G[2];
#pragma unroll
                    for (int n = 0; n < 2; ++n)
#pragma unroll
                        for (int e = 0; e < 4; ++e) G[n][e] = acc[ai][0][m][n][e] * sigmoidf_(acc[ai][1][m][n][e]);
                    u32x4 o; o[0] = pk2(G[0][0], G[0][1]); o[1] = pk2(G[0][2], G[0][3]); o[2] = pk2(G[1][0], G[1][1]); o[3] = pk2(G[1][2], G[1][3]);
                    *(u32x4*)rowp = o;
                } else if (u.pn >= 28 && u.pn < 44) {
                    f32x4 R[2], Sg[2];
#pragma unroll
                    for (int n = 0; n < 2; ++n)
#pragma unroll
                        for (int e = 0; e < 4; ++e) { const float ea = __expf(-acc[ai][0][m][n][e]), eb = __expf(-acc[ai][1][m][n][e]);
                            R[n][e] = (1.0f + eb) * __builtin_amdgcn_rcpf(1.0f + ea); Sg[n][e] = __builtin_amdgcn_rcpf(1.0f + eb); }
                    u32x4 o; o[0] = pk2(R[0][0], R[0][1]); o[1] = pk2(R[0][2], R[0][3]); o[2] = pk2(R[1][0], R[1][1]); o[3] = pk2(R[1][2], R[1][3]);
                    *(u32x4*)rowp = o;
                    o[0] = pk2(Sg[0][0], Sg[0][1]); o[1] = pk2(Sg[0][2], Sg[0][3]); o[2] = pk2(Sg[1][0], Sg[1][1]); o[3] = pk2(Sg[1][2], Sg[1][3]);
                    *(u32x4*)(rowp + 128) = o;
                } else
#pragma unroll
                for (int bj = 0; bj < 2; ++bj) { const f32x4 v0 = acc[ai][bj][m][0], v1 = acc[ai][bj][m][1];
                    u32x4 o; o[0] = pg8::cvt_pk_bf16(v0[0], v0[1]); o[1] = pg8::cvt_pk_bf16(v0[2], v0[3]); o[2] = pg8::cvt_pk_bf16(v1[0], v1[1]); o[3] = pg8::cvt_pk_bf16(v1[2], v1[3]);
                    *(u32x4*)(rowp + bj * 128) = o; }
                if (u.pn == 44 && wc == 0) { *(f32x4*)(BA + (size_t)row * 32 + 8 * fq) = acc[ai][0][m][0]; *(f32x4*)(BA + (size_t)row * 32 + 8 * fq + 4) = acc[ai][0][m][1]; }
            }
    }
};
struct EpiMG {
    static constexpr bool PERM = true, AFTER_DRAIN = false, CHAIN = true;
    const bf16_t* P; bf16_t* MG;
    __device__ __forceinline__ void operator()(f32x4 (&acc)[2][2][4][2], const pg8::Unit& u, int wr, int wc, int fr, int fq) const {
        const int row0 = u.pm * 256 + wr * 64 + fr, w0 = wc * 32 + 8 * fq, col0 = u.pn * 256 + w0;
        const int goff = u.kh == 0 ? 0 : 128;
#pragma unroll
        for (int ai = 0; ai < 2; ++ai) { u32x4 gv[4][2];
#pragma unroll
            for (int m = 0; m < 4; ++m) { const bf16_t* rowp = P + (size_t)(row0 + ai * 128 + m * 16) * NP + C_GA + w0 + goff;
#pragma unroll
                for (int bj = 0; bj < 2; ++bj) gv[m][bj] = *(const u32x4*)(rowp + (2 * u.pn + bj) * 256); }
#pragma unroll
            for (int m = 0; m < 4; ++m) { const int row = row0 + ai * 128 + m * 16;
#pragma unroll
                for (int bj = 0; bj < 2; ++bj) { float o[8];
#pragma unroll
                    for (int e = 0; e < 8; ++e) { const unsigned wv = gv[m][bj][e >> 1]; const float gvv = __uint_as_float((e & 1) ? (wv & 0xffff0000u) : (wv << 16));
                        o[e] = acc[ai][bj][m][e >> 2][e & 3] * gvv; }
                    if (u.kh == 0) {
#pragma unroll
                        for (int e = 0; e < 8; ++e) acc[ai][bj][m][e >> 2][e & 3] = o[e];
                    } else { u32x4 ov; ov[0] = pk2(o[0], o[1]); ov[1] = pk2(o[2], o[3]); ov[2] = pk2(o[4], o[5]); ov[3] = pk2(o[6], o[7]);
                        *(u32x4*)(MG + (size_t)row * DM + col0 + bj * 128) = ov; } } }
            __builtin_amdgcn_sched_barrier(0); }
    }
};
struct EpiX {
    static constexpr bool PERM = false, AFTER_DRAIN = false, CHAIN = false;
    const float* x0a; const float* x0b; const float* x1; const float* gate; float* out;
    __device__ __forceinline__ void operator()(f32x4 (&acc)[2][2][4][2], const pg8::Unit& u, int wr, int wc, int fr, int fq) const {
        const int row0 = u.pm * 256 + wr * 64 + fr, col0 = u.pn * 256 + wc * 32 + 4 * fq;
#pragma unroll
        for (int ai = 0; ai < 2; ++ai)
#pragma unroll
            for (int m = 0; m < 4; ++m) { const int row = row0 + ai * 128 + m * 16;
                const float* xr = x1 ? x1 + (size_t)row * DM : (row < NCTX ? x0a + (size_t)row * DM : x0b + (size_t)(row - NCTX) * DM);
                const float* gr = gate + (size_t)cvec_of(row) * 6144;
#pragma unroll
                for (int bj = 0; bj < 2; ++bj)
#pragma unroll
                    for (int n = 0; n < 2; ++n) { const int col = col0 + bj * 128 + n * 16;
                        const f32x4 xv = *(const f32x4*)(xr + col), gv = *(const f32x4*)(gr + col);
                        *(f32x4*)(out + (size_t)row * DM + col) = xv + gv * acc[ai][bj][m][n]; }
            }
    }
};

template <int T>
__device__ __forceinline__ void conv_line(const bf16_t* __restrict__ P, bf16_t* __restrict__ Y, int base, int stride, int L, int p0, int ch, const float* __restrict__ w, const float* __restrict__ cb) {
    const int ucol = (ch >> 7) * 256 + (ch & 127);
    f32x2_t ua[T + 30];
#pragma unroll
    for (int i = 0; i < T + 30; ++i) { const int pos = p0 - 15 + i; f32x2_t v = {0.f, 0.f};
        if (pos >= 0 && pos < L) { const unsigned a = *(const unsigned*)(P + (size_t)(base + pos * stride) * NP + ucol);
            v[0] = __uint_as_float(a << 16); v[1] = __uint_as_float(a & 0xffff0000u); }
        ua[i] = v; }
    f32x2_t wk[31];
#pragma unroll
    for (int k = 0; k < 31; ++k) wk[k] = *(const f32x2_t*)(w + k * 1024 + ch);
    const f32x2_t bias = *(const f32x2_t*)(cb + ch);
#pragma unroll
    for (int j = 0; j < T; ++j) { f32x2_t a = bias;
#pragma unroll
        for (int k = 0; k < 31; ++k) a += wk[k] * ua[j + k];
        *(unsigned*)(Y + (size_t)(base + (p0 + j) * stride) * 1024 + ch) = pk2(a[0], a[1]); }
}

__device__ __forceinline__ void split8(const float* p, bf16x8& hi, bf16x8& lo) {
    const f32x4 a = *(const f32x4*)p, b2 = *(const f32x4*)(p + 4);
    u32x4 h, l2;
    h[0] = pk2(a[0], a[1]); h[1] = pk2(a[2], a[3]); h[2] = pk2(b2[0], b2[1]); h[3] = pk2(b2[2], b2[3]);
    l2[0] = pk2(a[0] - __uint_as_float(h[0] << 16), a[1] - __uint_as_float(h[0] & 0xffff0000u));
    l2[1] = pk2(a[2] - __uint_as_float(h[1] << 16), a[3] - __uint_as_float(h[1] & 0xffff0000u));
    l2[2] = pk2(b2[0] - __uint_as_float(h[2] << 16), b2[1] - __uint_as_float(h[2] & 0xffff0000u));
    l2[3] = pk2(b2[2] - __uint_as_float(h[3] << 16), b2[3] - __uint_as_float(h[3] & 0xffff0000u));
    hi = __builtin_bit_cast(bf16x8, h); lo = __builtin_bit_cast(bf16x8, l2);
}
__device__ __forceinline__ void dn_precompute(const Params& p, int l, int gc, int h, float* lds) {
    const int tid = opaque_tid(), lane = tid & 63, wid = tid >> 6;
    float* qs = lds;
    float* ks = lds + 8448;
    float* vs = lds + 2 * 8448;
    float* Gm = lds + 3 * 8448;
    float* QKm = Gm + 4160;
    float* betaS = QKm + 4160;
    float* gcS = betaS + 128;
    float* wscS = gcS + 128;
    const bf16_t* P = (const bf16_t*)(pws(p) + WS_P);
    const float* BA = (const float*)(pws(p) + WS_BA);
    int n, nc; if (gc < 64) { n = gc & 3; nc = 4; } else { n = (gc - 64) & 15; nc = 16; }
    const int tok0 = gc * 64;
    const float* cw = pin(p, 14) + (size_t)l * 3 * 3072;
    if (tid < 384) { const int cg = tid % 48, run = tid / 48, which = cg >> 4, d0 = (cg & 15) * 8;
        const int wch = which * 1024 + h * 128 + d0;
        const bf16_t* pc = P + (long)(tok0 + run * 8 - 1) * NP + C_Q + wch;
        u32x4 rows[10];
#pragma unroll
        for (int r = 0; r < 10; ++r) { const int t = run * 8 - 1 + r; const bool valid = (t >= 0 || n > 0) && (t < 64 || n < nc - 1);
            rows[r] = valid ? *(const u32x4*)(pc + (long)r * NP) : (u32x4){0u, 0u, 0u, 0u}; }
        f32x4 w[3][2];
#pragma unroll
        for (int j = 0; j < 3; ++j) { w[j][0] = *(const f32x4*)(cw + j * 3072 + wch); w[j][1] = *(const f32x4*)(cw + j * 3072 + wch + 4); }
        float* dst = (which == 0 ? qs : (which == 1 ? ks : vs)) + d0;
#pragma unroll
        for (int o = 0; o < 8; ++o) { f32x4 r2[2];
#pragma unroll
            for (int e = 0; e < 8; ++e) { const unsigned a = rows[o][e >> 1], bq = rows[o + 1][e >> 1], cq = rows[o + 2][e >> 1];
                const float xm = __uint_as_float((e & 1) ? (a & 0xffff0000u) : (a << 16)), x0 = __uint_as_float((e & 1) ? (bq & 0xffff0000u) : (bq << 16)), xp = __uint_as_float((e & 1) ? (cq & 0xffff0000u) : (cq << 16));
                r2[e >> 2][e & 3] = siluf_(w[0][e >> 2][e & 3] * xm + w[1][e >> 2][e & 3] * x0 + w[2][e >> 2][e & 3] * xp); }
            *(f32x4*)(dst + (run * 8 + o) * 132) = r2[0]; *(f32x4*)(dst + (run * 8 + o) * 132 + 4) = r2[1]; }
    }
    if (tid < 128) { const int dir = tid >> 6, i = tid & 63, tl = dir ? 63 - i : i;
        const float* ba = BA + (size_t)(tok0 + tl) * 32;
        const float bl = ba[dir * 8 + h], al = ba[16 + dir * 8 + h];
        const float xx = al + pin(p, 16)[(l * 2 + dir) * 8 + h];
        const float sp = xx > 20.f ? xx : log1pf(__expf(xx));
        float g = -__expf(pin(p, 15)[(l * 2 + dir) * 8 + h]) * sp;
#pragma unroll
        for (int o = 1; o < 64; o <<= 1) { const float t2 = __shfl_up(g, o); if (i >= o) g += t2; }
        const float bt = sigmoidf_(bl); betaS[dir * 64 + i] = bt; gcS[dir * 64 + i] = g; wscS[dir * 64 + i] = bt * __expf(g); }
    __syncthreads();
    { float a[16], b2[16], ss[16];
#pragma unroll
        for (int k = 0; k < 16; ++k) { const int r = wid + 8 * k; const float* row = (r < 64 ? qs + r * 132 : ks + (r - 64) * 132); a[k] = row[lane]; b2[k] = row[lane + 64]; ss[k] = a[k] * a[k] + b2[k] * b2[k]; }
#pragma unroll
        for (int o = 32; o > 0; o >>= 1) {
#pragma unroll
            for (int k = 0; k < 16; ++k) ss[k] += __shfl_xor(ss[k], o); }
#pragma unroll
        for (int k = 0; k < 16; ++k) { const int r = wid + 8 * k; float* row = (r < 64 ? qs + r * 132 : ks + (r - 64) * 132);
            const float sc = rsqrtf(ss[k] + EPS) * (r < 64 ? 0.08838834764831845f : 1.0f); row[lane] = a[k] * sc; row[lane + 64] = b2[k] * sc; } }
    __syncthreads();
    for (int rg = 0; rg < REP_GRAM; ++rg) { const int mat = wid >> 2, ti = wid & 3, r = lane & 15, q4 = lane >> 4;
        const float* Ar = mat ? qs : ks;
        bf16x8 Ahi[4], Alo[4];
#pragma unroll
        for (int k4 = 0; k4 < 4; ++k4) split8(Ar + (16 * ti + r) * 132 + 32 * k4 + 8 * q4, Ahi[k4], Alo[k4]);
        float* M = mat ? QKm : Gm;
#pragma unroll
        for (int tj = 0; tj < 4; ++tj) { f32x4 acc = (f32x4){0.f, 0.f, 0.f, 0.f};
#pragma unroll
            for (int k4 = 0; k4 < 4; ++k4) { bf16x8 Bhi, Blo; split8(ks + (16 * tj + r) * 132 + 32 * k4 + 8 * q4, Bhi, Blo);
                acc = __builtin_amdgcn_mfma_f32_16x16x32_bf16(Ahi[k4], Bhi, acc, 0, 0, 0);
                acc = __builtin_amdgcn_mfma_f32_16x16x32_bf16(Ahi[k4], Blo, acc, 0, 0, 0);
                acc = __builtin_amdgcn_mfma_f32_16x16x32_bf16(Alo[k4], Bhi, acc, 0, 0, 0); }
#pragma unroll
            for (int j = 0; j < 4; ++j) M[(16 * ti + 4 * q4 + j) * 65 + 16 * tj + r] = acc[j]; } }
    __syncthreads();
    const int dir = tid >> 8, tl = tid & 255;
    unsigned char* rec = pws(p) + WS_DN + (size_t)((gc * 8 + h) * 2 + dir) * DN_REC;
    const float* gcd = gcS + dir * 64; const float* btd = betaS + dir * 64;
    const float gl = gcd[63];
    { bf16_t* qd = (bf16_t*)(rec + DN_QDEC);
        for (int e = tl; e < 64 * 64; e += 256) { const int i = e >> 6, d2 = (e & 63) * 2; const int t = dir ? 63 - i : i; const float eg = __expf(gcd[i]);
            *(unsigned*)(qd + i * 128 + d2) = pk2(qs[t * 132 + d2] * eg, qs[t * 132 + d2 + 1] * eg); } }
    __syncthreads();
    float* Am = qs + dir * 4096;
    for (int e = tl; e < 4096; e += 256) { const int j = e >> 6, i = e & 63; const int ti = dir ? 63 - i : i, tj = dir ? 63 - j : j;
        Am[e] = j < i ? btd[i] * Gm[ti * 65 + tj] * __expf(gcd[i] - gcd[j]) : 0.f; }
    __syncthreads();
    if (tl >= 64) { const int t2 = tl - 64;
        bf16_t* kd = (bf16_t*)(rec + DN_KDT);
        for (int e = t2; e < 128 * 32; e += 192) { const int dk = e >> 5, j2 = (e & 31) * 2; const int t0 = dir ? 63 - j2 : j2, t1 = dir ? 62 - j2 : j2 + 1;
            *(unsigned*)(kd + dk * 64 + j2) = pk2(ks[t0 * 132 + dk] * __expf(gl - gcd[j2]), ks[t1 * 132 + dk] * __expf(gl - gcd[j2 + 1])); }
        bf16_t* qk = (bf16_t*)(rec + DN_QKM);
        for (int e = t2; e < 64 * 32; e += 192) { const int i = e >> 5, j2 = (e & 31) * 2; const int ti = dir ? 63 - i : i, t0 = dir ? 63 - j2 : j2, t1 = dir ? 62 - j2 : j2 + 1;
            const float v0 = j2 <= i ? QKm[ti * 65 + t0] * __expf(gcd[i] - gcd[j2]) : 0.f;
            const float v1 = j2 + 1 <= i ? QKm[ti * 65 + t1] * __expf(gcd[i] - gcd[j2 + 1]) : 0.f;
            *(unsigned*)(qk + i * 64 + j2) = pk2(v0, v1); }
        if (t2 == 0) *(float*)(rec + DN_EGL) = __expf(gl);
    }
    float* Tm = Am;
    if (tl < 64) { const int c = tl;
        f32x2_t U2[32];
#pragma unroll
        for (int i = 0; i < 64; ++i) U2[i >> 1][i & 1] = (i == c) ? 1.f : 0.f;
        f32x4 av[2][16];
#pragma unroll
        for (int i4 = 0; i4 < 16; ++i4) av[0][i4] = *(const f32x4*)(Am + i4 * 4);
        __builtin_amdgcn_sched_barrier(0);
#pragma unroll
        for (int j = 0; j < 63; ++j) {
            if (j + 1 < 63) {
#pragma unroll
                for (int i4 = (j + 2) / 4; i4 < 16; ++i4) av[(j + 1) & 1][i4] = *(const f32x4*)(Am + (j + 1) * 64 + i4 * 4); }
            const float uj = U2[j >> 1][j & 1]; const f32x2_t ujj = {uj, uj};
#pragma unroll
            for (int pr = (j + 1) / 2; pr < 32; ++pr) { const f32x4 a4 = av[j & 1][pr >> 1]; const f32x2_t a2 = (pr & 1) ? (f32x2_t){a4[2], a4[3]} : (f32x2_t){a4[0], a4[1]};
                if (2 * pr > j) U2[pr] = U2[pr] - a2 * ujj; else U2[pr][1] -= a2[1] * uj; }
            __builtin_amdgcn_sched_barrier(0); }
#pragma unroll
        for (int i = 0; i < 64; ++i) Tm[i * 64 + c] = U2[i >> 1][i & 1];
    }
    __syncthreads();
    { const int wq = wid & 3, r = lane & 15, kg = lane >> 4; const bool isu = wq < 2;
        int rstep = dir ? -132 : 132; asm volatile("" : "+v"(rstep));
        const float* src = (isu ? vs + wq * 64 : ks + (wq - 2) * 64) + (dir ? 63 * 132 : 0) + r;
        const float* scl = isu ? btd : wscS + dir * 64;
        bf16x8 Ahi[4][2], Alo[4][2];
#pragma unroll
        for (int m = 0; m < 4; ++m)
#pragma unroll
            for (int kx = 0; kx < 2; ++kx) split8(Tm + (16 * m + r) * 64 + 32 * kx + 8 * kg, Ahi[m][kx], Alo[m][kx]);
        float* ut = (float*)(rec + DN_UT); bf16_t* nw = (bf16_t*)(rec + DN_NEGW);
#pragma unroll
        for (int nt = 0; nt < 4; ++nt) { bf16x8 Bf[2];
#pragma unroll
            for (int kx = 0; kx < 2; ++kx) { const int j0 = 32 * kx + 8 * kg; const f32x4 s0 = *(const f32x4*)(scl + j0), s1 = *(const f32x4*)(scl + j0 + 4);
                u32x4 o;
#pragma unroll
                for (int e2 = 0; e2 < 4; ++e2) { const float x0 = src[(j0 + 2 * e2) * rstep + 16 * nt] * (e2 < 2 ? s0[2 * e2] : s1[2 * e2 - 4]), x1 = src[(j0 + 2 * e2 + 1) * rstep + 16 * nt] * (e2 < 2 ? s0[2 * e2 + 1] : s1[2 * e2 - 3]);
                    o[e2] = pk2(x0, x1); }
                Bf[kx] = __builtin_bit_cast(bf16x8, o); }
#pragma unroll
            for (int m = 0; m < 4; ++m) { f32x4 acc = (f32x4){0.f, 0.f, 0.f, 0.f};
#pragma unroll
                for (int kx = 0; kx < 2; ++kx) { acc = __builtin_amdgcn_mfma_f32_16x16x32_bf16(Ahi[m][kx], Bf[kx], acc, 0, 0, 0); acc = __builtin_amdgcn_mfma_f32_16x16x32_bf16(Alo[m][kx], Bf[kx], acc, 0, 0, 0); }
                const int i0 = 16 * m + 4 * kg, cc = 16 * nt + r;
                if (isu) { u32x2 o2; o2[0] = pk2(acc[0], acc[1]); o2[1] = pk2(acc[2], acc[3]); *(u32x2*)((bf16_t*)ut + (wq * 64 + cc) * 64 + i0) = o2; }
                else {
#pragma unroll
                    for (int jj = 0; jj < 4; ++jj) nw[(i0 + jj) * 128 + (wq - 2) * 64 + cc] = (bf16_t)f2bf(-acc[jj]); } }
        }
    }
    __syncthreads();
}

__device__ __forceinline__ void pc_phase(const Params& p, int l, float* lds) {
    const int tid = opaque_tid();
    const bf16_t* P = (const bf16_t*)(pws(p) + WS_P);
    bf16_t* Y = (bf16_t*)(pws(p) + WS_Y);
    const float* cw = pin(p, 9) + (size_t)l * 31 * 1024;
    const float* cb = pin(p, 10) + l * 1024;
    const bool g256 = (int)gridDim.x == 256;
    for (int kk = 0;; ++kk) {
        int it = (int)blockIdx.x + kk * (int)gridDim.x;
        if (g256 && kk == 5) it = (int)blockIdx.x >= 192 ? 1280 + (int)blockIdx.x - 192 : (1 << 30);
        if (it >= 1024 + 320) break;
#ifndef NO_DN
        if (it < 1024) { for (int rd = 0; rd < REP_DN; ++rd) dn_precompute(p, l, it >> 3, it & 7, lds); continue; }
#endif
#ifndef NO_CONV
        for (int rcv = 0; rcv < REP_CONV; ++rcv) {
        int r = it - 1024;
        int tl = opaque_tid();
        if (r < 192) { int base, L, p0, ch;
            if (r < 128) { const int tile = r & 7, bb = r >> 3; ch = 2 * tl; base = bb * 256; L = 256; p0 = tile * 32; }
            else { r -= 128; const int row = r & 15, bb = r >> 4; ch = 2 * (tl & 255); base = NCTX + bb * 1024 + row * 64; L = 64; p0 = (tl >> 8) * 32; }
            int st = 1; asm volatile("" : "+s"(st));
            conv_line<32>(P, Y, base, st, L, p0, ch, cw, cb);
        } else {
            r -= 192; const int col = 2 * (r & 31) + (tl >> 8), bb = r >> 5; const int ch = 512 + 2 * (tl & 255);
            int st = 64; asm volatile("" : "+s"(st));
            conv_line<16>(P, Y, NCTX + bb * 1024 + col, st, 16, 0, ch, cw, cb);
        }
        }
#endif
    }
}

__device__ __forceinline__ bf16x8 pack8(const f32x4& a, const f32x4& b) {
    u32x4 r; r[0] = pk2(a[0], a[1]); r[1] = pk2(a[2], a[3]); r[2] = pk2(b[0], b[1]); r[3] = pk2(b[2], b[3]);
    return __builtin_bit_cast(bf16x8, r);
}
__device__ __forceinline__ bf16x8 lds_afrag(const unsigned char* base) {
    const u32x2 lo = *(const u32x2*)base, hi = *(const u32x2*)(base + 32);
    u32x4 r; r[0] = lo[0]; r[1] = lo[1]; r[2] = hi[0]; r[3] = hi[1];
    return __builtin_bit_cast(bf16x8, r);
}
#define MFMA16(a, b, c) __builtin_amdgcn_mfma_f32_16x16x32_bf16((a), (b), (c), 0, 0, 0)

#define SCAN_IMG 67584
__device__ __forceinline__ const unsigned char* dn_rec(const Params& p, int gc, int h, int dir) { return pws(p) + WS_DN + (size_t)((gc * 8 + h) * 2 + dir) * DN_REC; }
__device__ __forceinline__ void scan_item(const Params& p, int l, int sq, int h, int dir, unsigned char* lds) {
    const int tid = opaque_tid(), lane = tid & 63, wid = __builtin_amdgcn_readfirstlane(tid >> 6), c = lane & 15, q = lane >> 4;
    const bool ctx = sq < 16;
    const int nc = ctx ? 4 : 16, gc0 = ctx ? sq * 4 : 64 + (sq - 16) * 16;
#define SCAN_GC(s_) (gc0 + (dir ? nc - 1 - (s_) : (s_)))
    if (wid >= 4) {
        const int tl = tid - 256;
        u32x4 Ra[14], Rb[14];
#define SCAN_LOAD(R_, s_) do { const unsigned char* r_ = dn_rec(p, SCAN_GC((s_) < nc ? (s_) : nc - 1), h, dir); _Pragma("unroll") for (int k = 0; k < 14; ++k) R_[k] = *(const u32x4*)(r_ + (size_t)(tl + 256 * k) * 16); } while (0)
#define SCAN_WRITE(R_, buf_) do { unsigned char* b_ = lds + (buf_) * SCAN_IMG; _Pragma("unroll") for (int k = 0; k < 14; ++k) { const int ch = tl + 256 * k; unsigned char* dst; \
            if (k < 4) dst = b_ + (ch >> 4) * 288 + (ch & 15) * 16; \
            else if (k < 8) { const int x = ch - 1024; dst = b_ + 18432 + (x >> 4) * 288 + (x & 15) * 16; } \
            else if (k < 12) { const int x = ch - 2048; dst = b_ + 36864 + (x >> 3) * 160 + (x & 7) * 16; } \
            else { const int x = ch - 3072; dst = b_ + 57344 + (x >> 3) * 160 + (x & 7) * 16; } \
            *(u32x4*)dst = R_[k]; } } while (0)
        SCAN_LOAD(Ra, 0); SCAN_LOAD(Rb, 1);
        SCAN_WRITE(Ra, 0);
        __syncthreads();
        for (int s = 0; s < nc; s += 2) {
            SCAN_LOAD(Ra, s + 2);
            SCAN_WRITE(Rb, 1);
            __syncthreads();
            SCAN_LOAD(Rb, s + 3);
            SCAN_WRITE(Ra, 0);
            __syncthreads();
        }
#undef SCAN_LOAD
#undef SCAN_WRITE
    } else {
        const int dv0 = wid * 32;
        bf16_t* O = (bf16_t*)(pws(p) + WS_R1) + (size_t)dir * NTOK * 1024;
        f32x4 S[2][8];
#pragma unroll
        for (int t = 0; t < 2; ++t)
#pragma unroll
            for (int m = 0; m < 8; ++m) S[t][m] = (f32x4){0.f, 0.f, 0.f, 0.f};
        if (!ctx) { const float* sd = pin(p, 2) + ((size_t)(((sq - 16) * 2 + l) * 2 + dir) * 8 + h) * 16384;
#pragma unroll
            for (int t = 0; t < 2; ++t)
#pragma unroll
                for (int m = 0; m < 8; ++m)
#pragma unroll
                    for (int j = 0; j < 4; ++j) S[t][m][j] = sd[(16 * m + 4 * q + j) * 128 + dv0 + 16 * t + c]; }
        u32x2 utn[2][4]; float egl;
        { const unsigned char* rec0 = dn_rec(p, SCAN_GC(0), h, dir);
#pragma unroll
            for (int t = 0; t < 2; ++t)
#pragma unroll
                for (int m = 0; m < 4; ++m) utn[t][m] = *(const u32x2*)((const bf16_t*)(rec0 + DN_UT) + (dv0 + 16 * t + c) * 64 + 16 * m + 4 * q);
            egl = *(const float*)(rec0 + DN_EGL); }
        __syncthreads();
        for (int s = 0; s < nc; ++s) {
            const int gc = SCAN_GC(s);
            const unsigned char* recn = dn_rec(p, SCAN_GC(s + 1 < nc ? s + 1 : s), h, dir);
            const unsigned char* L_negw = lds + (s & 1) * SCAN_IMG;
            const unsigned char* L_qdec = L_negw + 18432;
            const unsigned char* L_kdt = L_negw + 36864;
            const unsigned char* L_qkm = L_negw + 57344;
            f32x4 vn[2][4];
#pragma unroll
            for (int t = 0; t < 2; ++t)
#pragma unroll
                for (int m = 0; m < 4; ++m) vn[t][m] = bf4_to_f32(utn[t][m]);
            bf16x8 Bs[2][4];
#pragma unroll
            for (int t = 0; t < 2; ++t)
#pragma unroll
                for (int kb = 0; kb < 4; ++kb) Bs[t][kb] = pack8(S[t][2 * kb], S[t][2 * kb + 1]);
            const unsigned char* aN = L_negw + c * 288 + 8 * q;
            const unsigned char* aQ = L_qdec + c * 288 + 8 * q;
            const unsigned char* aM = L_qkm + c * 160 + 8 * q;
            const unsigned char* aK = L_kdt + c * 160 + 8 * q;
#define SB_ __builtin_amdgcn_sched_barrier(0)
#define LD_N(F, m) do { _Pragma("unroll") for (int kb = 0; kb < 4; ++kb) F[kb] = lds_afrag(aN + (m) * 16 * 288 + 64 * kb); } while (0)
#define LD_Q(F, m) do { _Pragma("unroll") for (int kb = 0; kb < 4; ++kb) F[kb] = lds_afrag(aQ + (m) * 16 * 288 + 64 * kb); } while (0)
#define LD_M(F, m) do { _Pragma("unroll") for (int kb = 0; kb < 2; ++kb) F[kb] = lds_afrag(aM + (m) * 16 * 160 + 64 * kb); } while (0)
#define LD_K(F, m2) do { _Pragma("unroll") for (int mm = 0; mm < 2; ++mm) _Pragma("unroll") for (int kb = 0; kb < 2; ++kb) F[mm * 2 + kb] = lds_afrag(aK + (2 * (m2) + mm) * 16 * 160 + 64 * kb); } while (0)
#define MF_N(F, m) do { _Pragma("unroll") for (int kb = 0; kb < 4; ++kb) { vn[0][m] = MFMA16(F[kb], Bs[0][kb], vn[0][m]); vn[1][m] = MFMA16(F[kb], Bs[1][kb], vn[1][m]); } } while (0)
#define MF_Q(F, m) do { oa0 = (f32x4){0.f, 0.f, 0.f, 0.f}; oa1 = oa0; \
            _Pragma("unroll") for (int kb = 0; kb < 4; ++kb) { oa0 = MFMA16(F[kb], Bs[0][kb], oa0); oa1 = MFMA16(F[kb], Bs[1][kb], oa1); } } while (0)
#define MF_M(F, m) do { f32x4 a0 = oa0, a1 = oa1; \
            _Pragma("unroll") for (int kb = 0; kb < 2; ++kb) { a0 = MFMA16(F[kb], Bv[0][kb], a0); a1 = MFMA16(F[kb], Bv[1][kb], a1); } \
            _Pragma("unroll") for (int j = 0; j < 4; ++j) { const int i = 16 * (m) + 4 * q + j; const int tok = gc * 64 + (dir ? 63 - i : i); \
                bf16_t* op = O + (size_t)tok * 1024 + h * 128 + dv0 + c; op[0] = (bf16_t)f2bf(a0[j]); op[16] = (bf16_t)f2bf(a1[j]); } } while (0)
#define MF_K(F, m2) do { _Pragma("unroll") for (int mm = 0; mm < 2; ++mm) { f32x4 a0 = S[0][2 * (m2) + mm] * egl, a1 = S[1][2 * (m2) + mm] * egl; \
            _Pragma("unroll") for (int kb = 0; kb < 2; ++kb) { a0 = MFMA16(F[mm * 2 + kb], Bv[0][kb], a0); a1 = MFMA16(F[mm * 2 + kb], Bv[1][kb], a1); } \
            S[0][2 * (m2) + mm] = a0; S[1][2 * (m2) + mm] = a1; } } while (0)
            bf16x8 X[4], Y[4]; f32x4 oa0, oa1;
            LD_N(X, 0); SB_;
            LD_N(Y, 1); SB_; MF_N(X, 0); SB_;
            LD_N(X, 2); SB_; MF_N(Y, 1); SB_;
            LD_N(Y, 3); SB_; MF_N(X, 2); SB_;
            LD_Q(X, 0); SB_; MF_N(Y, 3); SB_;
            bf16x8 Bv[2][2];
#pragma unroll
            for (int t = 0; t < 2; ++t)
#pragma unroll
                for (int kb = 0; kb < 2; ++kb) Bv[t][kb] = pack8(vn[t][2 * kb], vn[t][2 * kb + 1]);
#pragma unroll
            for (int t = 0; t < 2; ++t)
#pragma unroll
                for (int m = 0; m < 4; ++m) utn[t][m] = *(const u32x2*)((const bf16_t*)(recn + DN_UT) + (dv0 + 16 * t + c) * 64 + 16 * m + 4 * q);
            SB_;
            LD_M(Y, 0); SB_; MF_Q(X, 0); SB_;
            LD_Q(X, 1); SB_; MF_M(Y, 0); SB_;
            LD_M(Y, 1); SB_; MF_Q(X, 1); SB_;
            LD_Q(X, 2); SB_; MF_M(Y, 1); SB_;
            LD_M(Y, 2); SB_; MF_Q(X, 2); SB_;
            LD_Q(X, 3); SB_; MF_M(Y, 2); SB_;
            LD_M(Y, 3); SB_; MF_Q(X, 3); SB_;
            LD_K(X, 0); SB_; MF_M(Y, 3); SB_;
            LD_K(Y, 1); SB_; MF_K(X, 0); SB_;
            LD_K(X, 2); SB_; MF_K(Y, 1); SB_;
            LD_K(Y, 3); SB_; MF_K(X, 2); SB_;
            MF_K(Y, 3);
#undef SB_
#undef LD_N
#undef LD_Q
#undef LD_M
#undef LD_K
#undef MF_N
#undef MF_Q
#undef MF_M
#undef MF_K
            egl = *(const float*)(recn + DN_EGL);
            __syncthreads();
        }
        if (ctx) { float* so = pout(p) + (size_t)NTOK * DM + ((size_t)((sq * 2 + l) * 2 + dir) * 8 + h) * 16384;
#pragma unroll
            for (int t = 0; t < 2; ++t)
#pragma unroll
                for (int m = 0; m < 8; ++m)
#pragma unroll
                    for (int j = 0; j < 4; ++j) so[(16 * m + 4 * q + j) * 128 + dv0 + 16 * t + c] = S[t][m][j]; }
    }
#undef SCAN_GC
}

__device__ __forceinline__ void lna_group(const Params& p, int l, int grp) {
    const int tid = opaque_tid(), lane = tid & 63, wid = tid >> 6;
    const int tok = grp * 8 + wid;
    const bf16_t* y = (const bf16_t*)(pws(p) + WS_Y) + (size_t)tok * 1024;
    const bf16_t* az = (const bf16_t*)(pws(p) + WS_P) + (size_t)tok * NP + C_AZ;
    bf16_t* U = (bf16_t*)(pws(p) + WS_U) + (size_t)tok * 2048;
    const float* lg = pin(p, 11) + l * 1024; const float* lb = pin(p, 12) + l * 1024;
    f32x4 v[4]; float s = 0.f;
#pragma unroll
    for (int i = 0; i < 4; ++i) { v[i] = bf4_to_f32(*(const u32x2*)(y + (lane + 64 * i) * 4)); s += v[i][0] + v[i][1] + v[i][2] + v[i][3]; }
    const float mu = wave_sum(s) * (1.0f / 1024.0f);
    float s2 = 0.f;
#pragma unroll
    for (int i = 0; i < 4; ++i) { v[i] -= mu; s2 += v[i][0] * v[i][0] + v[i][1] * v[i][1] + v[i][2] * v[i][2] + v[i][3] * v[i][3]; }
    const float rstd = rsqrtf(wave_sum(s2) * (1.0f / 1024.0f) + EPS);
#pragma unroll
    for (int i = 0; i < 4; ++i) { const int cc = (lane + 64 * i) * 4; const f32x4 g = *(const f32x4*)(lg + cc), bb = *(const f32x4*)(lb + cc);
        const u32x2 zz = *(const u32x2*)(az + cc);
        f32x4 o = v[i] * rstd * g + bb;
        const float z0 = __uint_as_float(zz[0] << 16), z1 = __uint_as_float(zz[0] & 0xffff0000u), z2 = __uint_as_float(zz[1] << 16), z3 = __uint_as_float(zz[1] & 0xffff0000u);
        u32x2 ov; ov[0] = pk2(siluf_(o[0]) * siluf_(z0), siluf_(o[1]) * siluf_(z1)); ov[1] = pk2(siluf_(o[2]) * siluf_(z2), siluf_(o[3]) * siluf_(z3));
        *(u32x2*)(U + cc) = ov; }
}

__device__ __forceinline__ void ps_phase(const Params& p, int l, unsigned char* lds) {
    const int b = blockIdx.x, G = gridDim.x;
    for (int r = 0;; ++r) { const int id = r * G + (r == 0 ? b : (b + 64 * G - 64) % G); if (id >= 320) break;
        const int sq = id < 64 ? 16 + (id >> 4) : ((id - 64) >> 4);
        for (int rsc = 0; rsc < REP_SCAN; ++rsc) scan_item(p, l, sq, (id >> 1) & 7, id & 1, lds); }
    const int gs = G == 256 ? (b >= 64 ? b - 64 : 1024) : b, gst = G == 256 ? 192 : G;
    for (int rl = 0; rl < REP_LNA; ++rl) for (int g = gs; g < 1024; g += gst) lna_group(p, l, g);
    if (l == 0) drain_tiles(p, 1 << 20, lds);
}

__device__ __forceinline__ void pnb_phase(const Params& p, int l) {
    const int tid = opaque_tid(), lane = tid & 63, wid = tid >> 6;
    const bf16_t* Of = (const bf16_t*)(pws(p) + WS_R1); const bf16_t* Ob = Of + (size_t)NTOK * 1024;
    const float* hg = pin(p, 17) + l * 128;
    for (int tok = blockIdx.x * 8 + wid; tok < NTOK; tok += gridDim.x * 8) {
        const int cb = lane * 16;
        f32x4 v[4]; float ss = 0.f;
#pragma unroll
        for (int i = 0; i < 4; ++i) { v[i] = bf4_to_f32(*(const u32x2*)(Of + (size_t)tok * 1024 + cb + 4 * i)) + bf4_to_f32(*(const u32x2*)(Ob + (size_t)tok * 1024 + cb + 4 * i));
            ss += v[i][0] * v[i][0] + v[i][1] * v[i][1] + v[i][2] * v[i][2] + v[i][3] * v[i][3]; }
        ss += __shfl_xor(ss, 1); ss += __shfl_xor(ss, 2); ss += __shfl_xor(ss, 4);
        const float rstd = rsqrtf(ss * (1.0f / 128.0f) + EPS);
        const bf16_t* zb = (const bf16_t*)(pws(p) + WS_P) + (size_t)tok * NP + C_ZB + cb;
        bf16_t* U = (bf16_t*)(pws(p) + WS_U) + (size_t)tok * 2048 + 1024 + cb;
        const u32x4 z0 = *(const u32x4*)zb, z1 = *(const u32x4*)(zb + 8);
        float o[16];
#pragma unroll
        for (int i = 0; i < 4; ++i) { const f32x4 g = *(const f32x4*)(hg + ((cb + 4 * i) & 127));
#pragma unroll
            for (int e = 0; e < 4; ++e) o[4 * i + e] = v[i][e] * rstd * g[e]; }
        u32x4 r0, r1;
#pragma unroll
        for (int w2 = 0; w2 < 4; ++w2) { const unsigned za = z0[w2], zc = z1[w2];
            r0[w2] = pk2(o[2 * w2] * siluf_(__uint_as_float(za << 16)), o[2 * w2 + 1] * siluf_(__uint_as_float(za & 0xffff0000u)));
            r1[w2] = pk2(o[8 + 2 * w2] * siluf_(__uint_as_float(zc << 16)), o[8 + 2 * w2 + 1] * siluf_(__uint_as_float(zc & 0xffff0000u))); }
        *(u32x4*)U = r0; *(u32x4*)(U + 8) = r1;
    }
}

#define XB_TMO      128
#define XB_XCNT(j)  (256  + 64 * (j))
#define XB_XSUB(j)  (1280 + 64 * (j))
#define XB_XGEN(j)  (2304 + 64 * (j))
#define XB_TOP      3328
#define XB_TOPGEN   3392
#define XCD_BAR_WORDS 3456
#define XB_SPIN_CAP (1u << 18)

__device__ __forceinline__ unsigned xb_ld(unsigned* p)              { return __hip_atomic_load(p, __ATOMIC_RELAXED, __HIP_MEMORY_SCOPE_AGENT); }
__device__ __forceinline__ unsigned xb_add(unsigned* p, unsigned v) { return __hip_atomic_fetch_add(p, v, __ATOMIC_RELAXED, __HIP_MEMORY_SCOPE_AGENT); }
__device__ __forceinline__ unsigned xb_xcc_id() { return (unsigned)__builtin_amdgcn_s_getreg((3 << 11) | 20) & 0xFu; }
#define XB_SPIN(cond, bar) do { unsigned _sp = 0; while (cond) { __builtin_amdgcn_s_sleep(1); \
    if ((++_sp & 255u) == 0u) { if (xb_ld(&(bar)[XB_TMO])) break; if (_sp > XB_SPIN_CAP) { atomicAdd(&(bar)[XB_TMO], 1u); break; } } } } while (0)

struct XcdBarrier {
    unsigned* bar; unsigned x;
    volatile LAS unsigned* st;
};

__device__ __forceinline__ XcdBarrier xcd_barrier_post(unsigned* bar, volatile LAS unsigned* st) {
    XcdBarrier b; b.bar = bar; b.x = xb_xcc_id(); b.st = st;
    if (threadIdx.x == 0) (void)xb_add(&bar[XB_XCNT(b.x)], 1u);
    return b;
}
__device__ __forceinline__ void xcd_barrier_complete(unsigned* bar, unsigned x, unsigned& nloc, unsigned& nx) {
    const unsigned G = gridDim.x * gridDim.y * gridDim.z;
    unsigned sum, cnt, mine, sp = 0u;
    for (;;) {
        sum = 0u; cnt = 0u; mine = 0u;
#pragma unroll
        for (unsigned j = 0; j < 16; ++j) { const unsigned c = xb_ld(&bar[XB_XCNT(j)]); sum += c; cnt += (c > 0u) ? 1u : 0u; mine = (j == x) ? c : mine; }
        if (sum == G) break;
        __builtin_amdgcn_s_sleep(1);
        if ((++sp & 255u) == 0u) { if (xb_ld(&bar[XB_TMO])) break; if (sp > XB_SPIN_CAP) { atomicAdd(&bar[XB_TMO], 1u); break; } }
    }
    nloc = mine > 0u ? mine : 1u; nx = cnt > 0u ? cnt : 1u;
}

__device__ __forceinline__ void xcd_barrier(const XcdBarrier& b) {
    asm volatile("s_waitcnt vmcnt(0)" ::: "memory");
    __syncthreads();
    if (threadIdx.x == 0) {
        unsigned* bar = b.bar;
        __builtin_amdgcn_s_waitcnt(0);
        unsigned nloc = b.st[0], nx = b.st[1];
        if (nloc == 0u) { xcd_barrier_complete(bar, b.x, nloc, nx); b.st[0] = nloc; b.st[1] = nx; }
        const unsigned old = xb_add(&bar[XB_XSUB(b.x)], 1u);
        const unsigned gen = old / nloc;
        if (old + 1u == (gen + 1u) * nloc) {
            __builtin_amdgcn_fence(__ATOMIC_RELEASE, "agent");
            asm volatile("s_waitcnt vmcnt(0)" ::: "memory");
            const unsigned og = xb_add(&bar[XB_TOP], 1u);
            const unsigned tg = og / nx;
            if (og + 1u == (tg + 1u) * nx) xb_add(&bar[XB_TOPGEN], 1u);
            else XB_SPIN(xb_ld(&bar[XB_TOPGEN]) == tg, bar);
            __builtin_amdgcn_fence(__ATOMIC_ACQUIRE, "agent");
            xb_add(&bar[XB_XGEN(b.x)], 1u);
            asm volatile("s_waitcnt vmcnt(0)" ::: "memory");
        } else {
            XB_SPIN(xb_ld(&bar[XB_XGEN(b.x)]) == gen, bar);
            __builtin_amdgcn_fence(__ATOMIC_ACQUIRE, "agent");
            asm volatile("s_waitcnt vmcnt(0)" ::: "memory");
        }
    }
    __syncthreads();
}

#ifndef REP0
#define REP0 1
#endif
#ifndef REP1
#define REP1 1
#endif
#ifndef REP2
#define REP2 1
#endif
#ifndef REP3
#define REP3 1
#endif
#ifndef REP4
#define REP4 1
#endif
#ifndef REP5
#define REP5 1
#endif
#ifndef REP6
#define REP6 1
#endif
#ifndef REP7
#define REP7 1
#endif
__global__ void __launch_bounds__(NTHR) fwd_megakernel(Params p) {
    extern __shared__ __attribute__((aligned(16))) unsigned char lds[];
    cg::grid_group grid = cg::this_grid();
    const int lo = p.ph_lo, hi = p.ph_hi;
    if (lo < 0) grid.sync();
    if (threadIdx.x < 2) ((volatile LAS unsigned*)((LAS unsigned char*)lds + LDS_BARST))[threadIdx.x] = 0u;
    __syncthreads();
    const XcdBarrier xbar = xcd_barrier_post((unsigned*)(pws(p) + WS_BARW), (volatile LAS unsigned*)((LAS unsigned char*)lds + LDS_BARST));
#define IN(k) (lo <= (k) && (k) < hi)
#ifndef SYNC_REP
#define SYNC_REP 1
#endif
#define SEAM(k) do { if (IN(k) && IN((k) + 1)) for (int sr = 0; sr < SYNC_REP; ++sr) { xcd_barrier(xbar); } } while (0)
#if (!defined(ONLY) || ONLY == 0) && !defined(SKIP0)
    if (IN(0)) for (int rp = 0; rp < REP0; ++rp) p0_prologue(p, (float*)lds);
#endif
    SEAM(0);
    for (int l = 0; l < 2; ++l) {
        const int pb = 1 + 7 * l;
        unsigned char* ws = pws(p);
#if (!defined(ONLY) || ONLY == 1) && !defined(SKIP1)
        if (IN(pb)) for (int rp = 0; rp < REP1; ++rp) pn_norm(p, l);
#endif
        SEAM(pb);
#if (!defined(ONLY) || ONLY == 2) && !defined(SKIP2)
        if (IN(pb + 1)) for (int rp = 0; rp < REP2; ++rp) {
            pg8::Gemm g{(const bf16_t*)(ws + WS_R1), (const bf16_t*)(ws + WS_WIN + l * SZ_WIN1), NTOK, NP, DM, DM};
            pg8::StaticOrder S; S.init(NTOK, NP, (int)gridDim.x, (int)blockIdx.x);
            EpiP E{(bf16_t*)(ws + WS_P), (float*)(ws + WS_BA)};
            pg8::gemm_phase<EpiP, pg8::StaticOrder, false, GEMM_ALIGN, GEMM_SP2>((LAS unsigned char*)lds, g, S, E, nullptr);
            if (l == 0 && (int)gridDim.x == 256 && (int)blockIdx.x >= 160) drain_tiles(p, PG1_TILES, lds);
        }
#endif
        SEAM(pb + 1);
#if (!defined(ONLY) || ONLY == 3) && !defined(SKIP3)
        if (IN(pb + 2)) for (int rp = 0; rp < REP3; ++rp) pc_phase(p, l, (float*)lds);
#endif
        SEAM(pb + 2);
#if (!defined(ONLY) || ONLY == 4) && !defined(SKIP4)
        if (IN(pb + 3)) for (int rp = 0; rp < REP4; ++rp) ps_phase(p, l, lds);
#endif
        SEAM(pb + 3);
#if (!defined(ONLY) || ONLY == 5) && !defined(SKIP5)
        if (IN(pb + 4)) for (int rp = 0; rp < REP5; ++rp) pnb_phase(p, l);
#endif
        SEAM(pb + 4);
#if (!defined(ONLY) || ONLY == 6) && !defined(SKIP6)
        if (IN(pb + 5)) for (int rp = 0; rp < REP6; ++rp) {
            pg8::Gemm g{(const bf16_t*)(ws + WS_U), (const bf16_t*)(ws + WS_WP2 + l * SZ_SQ), NTOK, DM, 1024, DM};
            ChainOrder S; S.init(NTOK, DM, (int)gridDim.x, (int)blockIdx.x);
            EpiMG E{(const bf16_t*)(ws + WS_P), (bf16_t*)(ws + WS_R1)};
            pg8::gemm_phase<EpiMG, ChainOrder, false, GEMM_ALIGN, GEMM_SP2>((LAS unsigned char*)lds, g, S, E, nullptr);
        }
#endif
        SEAM(pb + 5);
#if (!defined(ONLY) || ONLY == 7) && !defined(SKIP7)
        if (IN(pb + 6)) for (int rp = 0; rp < REP7; ++rp) {
            pg8::Gemm g{(const bf16_t*)(ws + WS_R1), (const bf16_t*)(ws + WS_WO + l * SZ_SQ), NTOK, DM, DM, DM};
            pg8::StaticOrder S; S.init(NTOK, DM, (int)gridDim.x, (int)blockIdx.x);
            EpiX E{pin(p, 0), pin(p, 1), l == 0 ? nullptr : (const float*)(ws + WS_X1), (const float*)(ws + WS_MOD) + (size_t)l * 5 * 6144 + 4096, l == 0 ? (float*)(ws + WS_X1) : (float*)(ws + WS_P)};
            pg8::gemm_phase<EpiX, pg8::StaticOrder, false, GEMM_ALIGN, GEMM_SP2>((LAS unsigned char*)lds, g, S, E, nullptr);
        }
#endif
        SEAM(pb + 6);
    }
#if (!defined(ONLY) || ONLY == 8) && !defined(SKIP8)
    if (IN(15)) pf_final(p);
#endif
}

#ifndef MK_N_LAUNCHES
#define MK_N_LAUNCHES 1
#endif
extern "C" void kernel_launch(void* const* d_in, const int* in_sizes, int n_in, void* d_out, int out_size, void* d_ws, size_t ws_size, hipStream_t stream) {
    static int grid = 0;
    if (grid == 0) {
        int dev = 0, cus = 0, per_cu = 0;
        hipGetDevice(&dev);
        hipDeviceGetAttribute(&cus, hipDeviceAttributeMultiprocessorCount, dev);
        if (hipFuncSetAttribute((const void*)fwd_megakernel, hipFuncAttributeMaxDynamicSharedMemorySize, LDS_BYTES) != hipSuccess) { fprintf(stderr, "kernel_launch: hipFuncSetAttribute failed\n"); grid = -1; return; }
        if (hipOccupancyMaxActiveBlocksPerMultiprocessor(&per_cu, (const void*)fwd_megakernel, NTHR, LDS_BYTES) != hipSuccess || per_cu < 1) { fprintf(stderr, "kernel_launch: occupancy query says %d blocks per CU\n", per_cu); grid = -1; return; }
        grid = cus * 1;
        if (n_in != 21 || ws_size < WS_END2) { fprintf(stderr, "kernel_launch: unexpected n_in %d / ws %zu\n", n_in, ws_size); grid = -1; return; }
    }
    if (grid < 0) return;
    if (hipMemsetAsync((char*)d_ws + WS_BARW, 0, 16384, stream) != hipSuccess) { fprintf(stderr, "kernel_launch: memset failed\n"); return; }
    Params p{};
    for (int i = 0; i < 21; ++i) p.in[i] = (const float*)d_in[i];
    p.out = (float*)d_out; p.ws = (unsigned char*)d_ws;
#if MK_N_LAUNCHES == 1
    p.ph_lo = 0; p.ph_hi = 16;
    void* args[] = {&p};
    hipError_t e = hipLaunchCooperativeKernel((const void*)fwd_megakernel, dim3(grid), dim3(NTHR), args, LDS_BYTES, stream);
    if (e != hipSuccess) fprintf(stderr, "cooperative launch failed: %s (grid %d)\n", hipGetErrorString(e), grid);
#else
    for (int ph = 0; ph < 16; ++ph) { p.ph_lo = ph; p.ph_hi = ph + 1;
        hipLaunchKernelGGL(fwd_megakernel, dim3(grid), dim3(NTHR), LDS_BYTES, stream, p); }
#endif
}
```

```cpp
#include <hip/hip_runtime.h>
#include <hip/hip_cooperative_groups.h>
#include <cstdio>
#include <cstdint>
namespace cg = cooperative_groups;
namespace pg8 {
#define PG8_LAS __attribute__((address_space(3)))
typedef unsigned short bf16_t;
typedef short bf16x8 __attribute__((ext_vector_type(8)));
typedef float f32x4 __attribute__((ext_vector_type(4)));
typedef unsigned u32x4 __attribute__((ext_vector_type(4)));
constexpr int BM = 256, BK = 64, HALF = 128, HTB = HALF * BK * 2  , STAGE_BYTES = 8 * HTB, NXCD = 8, WGM = 8;

__host__ __device__ __forceinline__ int lds_byte(int r, int c) { const int st = (r >> 4) * 2 + (c >> 5), rr = r & 15, cc = c & 31, ob = rr * 64 + cc * 2; return st * 1024 + (ob ^ (((ob >> 9) & 1) << 5)); }
__host__ __device__ __forceinline__ void stage_rc(int b, int& R, int& C) { const int st = b / 1024, sb = b % 1024, swz = sb ^ (((sb >> 9) & 1) << 5); R = (st >> 1) * 16 + swz / 64; C = (st & 1) * 32 + (swz % 64) / 2; }
__host__ __device__ __forceinline__ int perm32(int rho) { const int n = rho >> 4, i = rho & 15; return 8 * (i >> 2) + 4 * n + (i & 3); }

struct Unit { int pm, pn, kh; };
struct Gemm { const bf16_t* A; const bf16_t* Bt; int M, N, K, lda; };

struct StaticOrder {
    int nM, nN, nwg, G, c;
    __host__ __device__ void init(int M, int N, int G_, int c_) { nM = M / BM; nN = N / BM; nwg = nM * nN; G = G_; c = c_; }
    __host__ __device__ bool next(int i, Unit& u) const {
        const long L = (long)i * G + c; if (L >= nwg) return false;
        int wgid = (int)L; { const int q = nwg / NXCD, r = nwg % NXCD, xcd = wgid % NXCD, off = wgid / NXCD; wgid = (xcd < r ? xcd * (q + 1) : r * (q + 1) + (xcd - r) * q) + off; }
        const int nig = WGM * nN, gid = wgid / nig, fm = gid * WGM, gsz = (nM - fm) < WGM ? (nM - fm) : WGM;
        u.pm = fm + ((wgid % nig) % gsz); u.pn = (wgid % nig) / gsz; u.kh = 0; return true;
    }
    __device__ __forceinline__ void a_ready(const Unit&) const {}
    __device__ __forceinline__ void done(const Unit&) const {}
};
__device__ __forceinline__ unsigned cvt_pk_bf16(float lo, float hi) { unsigned r; asm volatile("v_cvt_pk_bf16_f32 %0, %1, %2" : "=v"(r) : "v"(lo), "v"(hi)); return r; }
template <class Epi, class Sched, bool STAMP = false, bool ALIGN_EPI = false, bool SP2 = false>
__device__ __forceinline__ void gemm_phase(PG8_LAS unsigned char* lds, const Gemm g, const Sched& S, const Epi& E, unsigned long long* stamps) {
    int tid_ = threadIdx.x; asm volatile("" : "+v"(tid_)); const int tid = tid_, wid = __builtin_amdgcn_readfirstlane(tid >> 6), lane = tid & 63, wr = wid >> 2, wc = wid & 3, fr = lane & 15, fq = lane >> 4;
    const int K = g.K, nt = K / BK;
    int ts_lo = 0, ts_hi = 0, nts = 0; const unsigned long long rt_entry = STAMP ? (unsigned long long)wall_clock64() : 0ull;
#define PG8_STAMP() do { if (STAMP && wid == 0 && nts < 64) { const unsigned long long _c = (unsigned long long)clock64(); \
        ts_lo = (lane == nts) ? (int)(unsigned)_c : ts_lo; ts_hi = (lane == nts) ? (int)(unsigned)(_c >> 32) : ts_hi; ++nts; } } while (0)
    PG8_STAMP();
    unsigned voffA[2], voffB[2];
#pragma unroll
    for (int i = 0; i < 2; ++i) { int R, C; stage_rc(tid * 16 + i * 8192, R, C); const int Rb = Epi::PERM ? ((R & ~31) + perm32(R & 31)) : R;
        voffA[i] = (unsigned)(R * g.lda + C) * 2u; voffB[i] = (unsigned)(Rb * g.lda + C) * 2u; }
    const size_t kstep = (size_t)(BK * 2);
    const size_t hstep = (size_t)HALF * g.lda * 2; const size_t khstep = (size_t)K * 2;
    const size_t tstep = 2 * hstep;
    const unsigned ldsw = (unsigned)wid * 1024u;
    const int aoff = lds_byte(wr * 64 + fr, fq * 8), boff = lds_byte(wc * 32 + fr, fq * 8);
#define PG8_SA(b, h) (((b) * 2 + (h)) * HTB)
#define PG8_SB(b, h) ((4 + (b) * 2 + (h)) * HTB)
#define PG8_STAGE(bufoff, gbase, voff) do { _Pragma("unroll") for (int _i = 0; _i < 2; ++_i) \
        __builtin_amdgcn_global_load_lds((const unsigned*)((const char*)(gbase) + (voff)[_i]), (PG8_LAS unsigned*)(lds + (bufoff) + ldsw + _i * 8192), 16, 0, 0); } while (0)
#define PG8_LDA(dst, b, h) do { _Pragma("unroll") for (int m = 0; m < 4; ++m) _Pragma("unroll") for (int k = 0; k < 2; ++k) dst[m][k] = *(const PG8_LAS bf16x8*)(lds + PG8_SA(b, h) + aoff + m * 2048 + k * 1024); } while (0)
#define PG8_LDB(dst, b, h) do { _Pragma("unroll") for (int n = 0; n < 2; ++n) _Pragma("unroll") for (int k = 0; k < 2; ++k) dst[n][k] = *(const PG8_LAS bf16x8*)(lds + PG8_SB(b, h) + boff + n * 2048 + k * 1024); } while (0)
#define PG8_MMA(ai, bj, At, Bt) do { __builtin_amdgcn_s_setprio(1); _Pragma("unroll") for (int m = 0; m < 4; ++m) _Pragma("unroll") for (int n = 0; n < 2; ++n) _Pragma("unroll") for (int k = 0; k < 2; ++k) \
        acc[ai][bj][m][n] = __builtin_amdgcn_mfma_f32_16x16x32_bf16(Bt[n][k], At[m][k], acc[ai][bj][m][n], 0, 0, 0); __builtin_amdgcn_s_setprio(0); } while (0)
#define PG8_WAIT_V(n) asm volatile("s_waitcnt vmcnt(" #n ")" ::: "memory")
#define PG8_WAIT_L(n) asm volatile("s_waitcnt lgkmcnt(" #n ")" ::: "memory")
#define PG8_BAR __builtin_amdgcn_s_barrier()
#define PG8_SCHED __builtin_amdgcn_sched_barrier(0)
    Unit cur, nxt; int ui = 0;
    if (!S.next(0, cur)) return;
    f32x4 acc[2][2][4][2];
#pragma unroll
    for (int a = 0; a < 2; ++a)
#pragma unroll
        for (int b = 0; b < 2; ++b)
#pragma unroll
            for (int m = 0; m < 4; ++m)
#pragma unroll
                for (int n = 0; n < 2; ++n) acc[a][b][m][n] = (f32x4){0.f, 0.f, 0.f, 0.f};
    bf16x8 At[4][2], B0[2][2], B1[2][2];
    const char* cA = (const char*)g.A + (size_t)cur.pm * tstep + cur.kh * khstep; const char* cB = (const char*)g.Bt + (size_t)cur.pn * tstep + cur.kh * khstep;
    S.a_ready(cur);
    if constexpr (SP2) {
        PG8_STAGE(PG8_SB(0, 0), cB, voffB); PG8_STAGE(PG8_SB(0, 1), cB + hstep, voffB); PG8_STAGE(PG8_SA(0, 0), cA, voffA); PG8_STAGE(PG8_SA(0, 1), cA + hstep, voffA);
        if (wr == 1) PG8_BAR;
        PG8_WAIT_V(2); PG8_BAR;
        PG8_STAGE(PG8_SB(1, 0), cB + kstep, voffB); PG8_STAGE(PG8_SA(1, 0), cA + kstep, voffA); PG8_STAGE(PG8_SB(1, 1), cB + hstep + kstep, voffB);
        PG8_WAIT_V(6); PG8_BAR;
    } else {
    PG8_STAGE(PG8_SB(0, 0), cB, voffB); PG8_STAGE(PG8_SA(0, 0), cA, voffA); PG8_STAGE(PG8_SB(0, 1), cB + hstep, voffB); PG8_STAGE(PG8_SA(0, 1), cA + hstep, voffA);
    if (wr == 1) PG8_BAR;
    PG8_WAIT_V(4); PG8_BAR;
    PG8_STAGE(PG8_SB(1, 0), cB + kstep, voffB); PG8_STAGE(PG8_SA(1, 0), cA + kstep, voffA); PG8_STAGE(PG8_SB(1, 1), cB + hstep + kstep, voffB);
    PG8_WAIT_V(6); PG8_BAR;
    }
    PG8_STAMP();
    for (;;) {
        const bool has_next = S.next(ui + 1, nxt);
        const char* nA = has_next ? (const char*)g.A + (size_t)nxt.pm * tstep + nxt.kh * khstep : cA; const char* nB = has_next ? (const char*)g.Bt + (size_t)nxt.pn * tstep + nxt.kh * khstep : cB;
        for (int t = 0; t < nt; t += 2) {
            const bool last = (t == nt - 2);
            const char* a1 = cA + (size_t)(t + 1) * kstep;
            const char* a2 = last ? nA : cA + (size_t)(t + 2) * kstep; const char* b2 = last ? nB : cB + (size_t)(t + 2) * kstep;
            const char* a3 = a2 + kstep; const char* b3 = b2 + kstep;
            if (last && has_next) S.a_ready(nxt);
            if constexpr (SP2) {
            PG8_LDB(B0, 0, 0); PG8_LDB(B1, 0, 1); PG8_SCHED; PG8_LDA(At, 0, 0); PG8_STAGE(PG8_SA(1, 1), a1 + hstep, voffA);
            PG8_WAIT_V(8); PG8_WAIT_L(0); PG8_BAR; PG8_MMA(0, 0, At, B0); PG8_MMA(0, 1, At, B1); PG8_BAR; PG8_SCHED;
            PG8_LDA(At, 0, 1); PG8_STAGE(PG8_SB(0, 0), b2, voffB); PG8_STAGE(PG8_SB(0, 1), b2 + hstep, voffB); PG8_STAGE(PG8_SA(0, 0), a2, voffA);
            PG8_WAIT_V(8); PG8_WAIT_L(0); PG8_BAR; PG8_MMA(1, 0, At, B0); PG8_MMA(1, 1, At, B1); PG8_BAR; PG8_SCHED;
            PG8_LDB(B0, 1, 0); PG8_LDB(B1, 1, 1); PG8_SCHED; PG8_LDA(At, 1, 0); PG8_STAGE(PG8_SA(0, 1), a2 + hstep, voffA);
            PG8_WAIT_V(8); PG8_WAIT_L(0); PG8_BAR; PG8_MMA(0, 0, At, B0); PG8_MMA(0, 1, At, B1); PG8_BAR; PG8_SCHED;
            PG8_LDA(At, 1, 1); PG8_STAGE(PG8_SB(1, 0), b3, voffB); PG8_STAGE(PG8_SB(1, 1), b3 + hstep, voffB); PG8_STAGE(PG8_SA(1, 0), a3, voffA);
            PG8_WAIT_V(8); PG8_WAIT_L(0); PG8_BAR; PG8_MMA(1, 0, At, B0); PG8_MMA(1, 1, At, B1); PG8_BAR; PG8_SCHED;
            } else {
            PG8_LDB(B0, 0, 0); PG8_SCHED; PG8_LDA(At, 0, 0); PG8_STAGE(PG8_SA(1, 1), a1 + hstep, voffA);
            PG8_WAIT_L(8); PG8_BAR; PG8_WAIT_L(0); PG8_MMA(0, 0, At, B0); PG8_BAR; PG8_SCHED;
            PG8_LDB(B1, 0, 1); PG8_STAGE(PG8_SB(0, 0), b2, voffB);
            PG8_BAR; PG8_WAIT_L(0); PG8_MMA(0, 1, At, B1); PG8_BAR;
            PG8_LDA(At, 0, 1); PG8_STAGE(PG8_SA(0, 0), a2, voffA);
            PG8_BAR; PG8_WAIT_L(0); PG8_MMA(1, 0, At, B0); PG8_BAR; PG8_SCHED;
            PG8_STAGE(PG8_SB(0, 1), b2 + hstep, voffB);
            PG8_WAIT_V(6); PG8_BAR; PG8_MMA(1, 1, At, B1); PG8_BAR;
            PG8_LDB(B0, 1, 0); PG8_SCHED; PG8_LDA(At, 1, 0); PG8_STAGE(PG8_SA(0, 1), a2 + hstep, voffA);
            PG8_WAIT_L(8); PG8_BAR; PG8_WAIT_L(0); PG8_MMA(0, 0, At, B0); PG8_BAR; PG8_SCHED;
            PG8_LDB(B1, 1, 1); PG8_STAGE(PG8_SB(1, 0), b3, voffB);
            PG8_BAR; PG8_WAIT_L(0); PG8_MMA(0, 1, At, B1); PG8_BAR;
            PG8_LDA(At, 1, 1); PG8_STAGE(PG8_SA(1, 0), a3, voffA);
            PG8_BAR; PG8_WAIT_L(0); PG8_MMA(1, 0, At, B0); PG8_BAR; PG8_SCHED;
            PG8_STAGE(PG8_SB(1, 1), b3 + hstep, voffB);
            PG8_WAIT_V(6); PG8_BAR; PG8_MMA(1, 1, At, B1); PG8_BAR;
            }
        }
        PG8_STAMP();
        if constexpr (ALIGN_EPI) { if (wr == 0) PG8_BAR; }
        if constexpr (!Epi::AFTER_DRAIN) { E(acc, cur, wr, wc, fr, fq); S.done(cur); }
        PG8_STAMP();
        if (!has_next) break;
        if (!(Epi::CHAIN && cur.kh == 0))
#pragma unroll
        for (int a = 0; a < 2; ++a)
#pragma unroll
            for (int b = 0; b < 2; ++b)
#pragma unroll
                for (int m = 0; m < 4; ++m)
#pragma unroll
                    for (int n = 0; n < 2; ++n) acc[a][b][m][n] = (f32x4){0.f, 0.f, 0.f, 0.f};
        cur = nxt; cA = nA; cB = nB; ++ui;
        if constexpr (ALIGN_EPI) { if (wr == 1) PG8_BAR; }
    }
    PG8_WAIT_V(0);
    if constexpr (!ALIGN_EPI) { if (wr == 0) PG8_BAR; }
    PG8_BAR;
    if constexpr (Epi::AFTER_DRAIN) { E.fused(acc, cur, wr, wc, fr, fq, lds, wid, lane); S.done(cur); }
    PG8_STAMP();
    if (STAMP && wid == 0) { stamps[lane] = lane < nts ? (((unsigned long long)(unsigned)ts_hi << 32) | (unsigned)ts_lo) : 0ull;
        if (lane == 62) stamps[62] = rt_entry; if (lane == 63) stamps[63] = (unsigned long long)wall_clock64(); }
#undef PG8_STAMP
#undef PG8_SA
#undef PG8_SB
#undef PG8_STAGE
#undef PG8_LDA
#undef PG8_LDB
#undef PG8_MMA
#undef PG8_WAIT_V
#undef PG8_WAIT_L
#undef PG8_BAR
#undef PG8_SCHED
}
}
#ifndef GEMM_SP2
#define GEMM_SP2 true
#endif
#ifndef GEMM_ALIGN
#define GEMM_ALIGN true
#endif
#ifndef REP_DN
#define REP_DN 1
#endif
#ifndef REP_CONV
#define REP_CONV 1
#endif
#ifndef PG1_TILES
#define PG1_TILES 6
#endif
#ifndef REP_SCAN
#define REP_SCAN 1
#endif
#ifndef REP_TILES
#define REP_TILES 1
#endif
#ifndef REP_LNA
#define REP_LNA 1
#endif
#ifndef REP_GRAM
#define REP_GRAM 1
#endif
#ifndef REP_E
#define REP_E 1
#endif
#ifndef REP_SOLVE
#define REP_SOLVE 1
#endif

#define LAS __attribute__((address_space(3)))
typedef unsigned short bf16_t;
typedef short bf16x8 __attribute__((ext_vector_type(8)));
typedef float f32x4 __attribute__((ext_vector_type(4)));
typedef unsigned u32x4 __attribute__((ext_vector_type(4)));
typedef unsigned u32x2 __attribute__((ext_vector_type(2)));

constexpr int NTOK = 8192, DM = 2048, NCTX = 4096, NP = 11520, NTHR = 512;
constexpr int C_AVAL = 0, C_AGLU = 1024, C_AZ = 2048, C_Q = 3072, C_ZB = 6144, C_GA = 7168, C_GB = 9216, C_BA = 11264;
constexpr float EPS = 1e-6f;
constexpr int LDS_BYTES = 139264;
constexpr int LDS_TQ = LDS_BYTES - 8;
constexpr int LDS_BARST = LDS_BYTES - 16;
constexpr int XCD_BAR_BYTES = 3456 * 4;

constexpr size_t WS_WIN = 256;
constexpr size_t SZ_WIN1 = (size_t)NP * DM * 2;
constexpr size_t WS_WP2 = WS_WIN + 2 * SZ_WIN1;
constexpr size_t SZ_SQ = (size_t)DM * DM * 2;
constexpr size_t WS_WO = WS_WP2 + 2 * SZ_SQ;
constexpr size_t WS_MOD = WS_WO + 2 * SZ_SQ;
constexpr size_t WS_R1 = WS_MOD + 2 * 5 * 6144 * 4;
constexpr size_t WS_P = WS_R1 + (size_t)2 * NTOK * 1024 * 4;
constexpr size_t WS_BA = WS_P + (size_t)NTOK * NP * 2;
constexpr size_t WS_Y = WS_BA + (size_t)NTOK * 32 * 4;
constexpr size_t WS_U = WS_Y + (size_t)NTOK * 1024 * 4;
constexpr size_t WS_DN = WS_U + (size_t)NTOK * 2048 * 2;
constexpr int DN_NEGW = 0, DN_QDEC = 16384, DN_KDT = 32768, DN_QKM = 49152, DN_UT = 57344, DN_EGL = 90112, DN_REC = 90368;
constexpr size_t WS_X1 = WS_DN + (size_t)2048 * DN_REC;
constexpr size_t WS_END = WS_X1 + (size_t)NTOK * DM * 4;
constexpr size_t WS_BARW = WS_END;
constexpr size_t WS_TQ = WS_BARW + 15360;
constexpr size_t WS_END2 = WS_BARW + 16384;
static_assert(WS_END2 <= 740294656ull && XCD_BAR_BYTES <= 16384, "workspace");

__device__ __forceinline__ int opaque_tid() { int t = threadIdx.x; asm volatile("" : "+v"(t)); return t; }
struct Params { const float* in[21]; float* out; unsigned char* ws; int ph_lo, ph_hi; };
#define KA_ __attribute__((address_space(4)))
__device__ __forceinline__ const float* pin(const Params&, int k) { const KA_ char* ka = (const KA_ char*)__builtin_amdgcn_kernarg_segment_ptr(); return *(const float* const volatile KA_*)(ka + 8 * k); }
__device__ __forceinline__ unsigned char* pws(const Params&) { const KA_ char* ka = (const KA_ char*)__builtin_amdgcn_kernarg_segment_ptr(); return *(unsigned char* const volatile KA_*)(ka + 8 * 22); }
__device__ __forceinline__ float* pout(const Params&) { const KA_ char* ka = (const KA_ char*)__builtin_amdgcn_kernarg_segment_ptr(); return *(float* const volatile KA_*)(ka + 8 * 21); }

__device__ __forceinline__ float bf2f(unsigned short b) { return __uint_as_float(((unsigned)b) << 16); }
__device__ __forceinline__ unsigned f2bf(float f) { unsigned u = __float_as_uint(f); u += 0x7fffu + ((u >> 16) & 1u); return u >> 16; }
typedef float f32x2_t __attribute__((ext_vector_type(2)));
typedef __bf16 bf16x2_t __attribute__((ext_vector_type(2)));
__device__ __forceinline__ unsigned pk2(float lo, float hi) { const f32x2_t v = {lo, hi}; return __builtin_bit_cast(unsigned, __builtin_convertvector(v, bf16x2_t)); }
__device__ __forceinline__ float sigmoidf_(float x) { return __builtin_amdgcn_rcpf(1.0f + __expf(-x)); }
__device__ __forceinline__ float siluf_(float x) { return x * __builtin_amdgcn_rcpf(1.0f + __expf(-x)); }
__device__ __forceinline__ f32x4 bf4_to_f32(u32x2 w) { return (f32x4){__uint_as_float(w[0] << 16), __uint_as_float(w[0] & 0xffff0000u), __uint_as_float(w[1] << 16), __uint_as_float(w[1] & 0xffff0000u)}; }
__device__ __forceinline__ float wave_sum(float v) {
#pragma unroll
    for (int o = 32; o > 0; o >>= 1) v += __shfl_xor(v, o);
    return v;
}
__device__ __forceinline__ const float* xrow0(const Params& p, int tok) { return tok < NCTX ? pin(p, 0) + (size_t)tok * DM : pin(p, 1) + (size_t)(tok - NCTX) * DM; }
__device__ __forceinline__ int cvec_of(int tok) { return tok < NCTX ? 0 : 1 + ((tok - NCTX) >> 10); }

__device__ __forceinline__ void tr_tile(const float* __restrict__ src, int ldsrc, int k0, int n0, int mode, bf16_t* __restrict__ dst, int lddst, int koff, float* lds) {
    const int tid = opaque_tid();
    { const int c4 = tid & 31, rr = tid >> 5; const int np = n0 + c4 * 4; int sc = np;
        if (mode == 1) {
            if (np < 2048) { const int T = np >> 8, w = np & 255; sc = w < 128 ? 128 * T + w : 1024 + 128 * T + (w - 128); }
            else if (np < 7168) sc = np; else if (np < 11264) { const int off = np - 7168, T = off >> 8, w = off & 255; sc = w < 128 ? 7200 + 128 * T + w : 9248 + 128 * T + (w - 128); }
            else sc = np < 11296 ? np - 11264 + 7168 : -1; }
#pragma unroll
        for (int i = 0; i < 8; ++i) { const int r = rr + 16 * i;
            *(f32x4*)(lds + r * 132 + c4 * 4) = sc >= 0 ? *(const f32x4*)(src + (size_t)(k0 + r) * ldsrc + sc) : (f32x4){0.f, 0.f, 0.f, 0.f}; } }
    __syncthreads();
#pragma unroll
    for (int i = 0; i < 4; ++i) { const int u = tid + 512 * i, nn = u & 127, kg = u >> 7;
        u32x4 o;
#pragma unroll
        for (int j = 0; j < 4; ++j) o[j] = pk2(lds[(kg * 8 + 2 * j) * 132 + nn], lds[(kg * 8 + 2 * j + 1) * 132 + nn]);
        *(u32x4*)(dst + (size_t)(n0 + nn) * lddst + koff + k0 + kg * 8) = o; }
    __syncthreads();
}
__device__ __forceinline__ void weight_tile(const Params& p, int it, float* lds) {
    unsigned char* ws = pws(p);
    const int l = it / 1952; int r = it % 1952;
    const float* src; int ldsrc, kt, ntile, mode = 0, koff = 0; bf16_t* dst;
    if (r < 1440) { kt = r / 90; ntile = r % 90; src = pin(p, 8) + (size_t)l * 2048 * 11296; ldsrc = 11296; mode = 1; dst = (bf16_t*)(ws + WS_WIN + l * SZ_WIN1); }
    else if (r < 1440 + 256) { r -= 1440; const int which = r / 128; r %= 128; kt = r / 16; ntile = r % 16;
        src = pin(p, which ? 18 : 13) + (size_t)l * 1024 * 2048; ldsrc = 2048; dst = (bf16_t*)(ws + WS_WP2 + l * SZ_SQ); koff = which * 1024; }
    else { r -= 1696; kt = r / 16; ntile = r % 16; src = pin(p, 19) + (size_t)l * 2048 * 2048; ldsrc = 2048; dst = (bf16_t*)(ws + WS_WO + l * SZ_SQ); }
    tr_tile(src, ldsrc, kt * 128, ntile * 128, mode, dst, 2048, koff, lds);
}

__device__ __forceinline__ void drain_tiles(const Params& p, int max_tiles, unsigned char* lds) {
    volatile LAS unsigned* slot = (volatile LAS unsigned*)((LAS unsigned char*)lds + LDS_TQ);
    __syncthreads();
    for (int n = 0; n < max_tiles; ++n) {
        if (threadIdx.x == 0) *slot = __hip_atomic_fetch_add((unsigned*)(pws(p) + WS_TQ), 1u, __ATOMIC_RELAXED, __HIP_MEMORY_SCOPE_AGENT);
        __syncthreads();
        const unsigned it = *slot;
        if (it >= 2u * 1952u - 1440u) break;
        weight_tile(p, 1440 + (int)it, (float*)lds);
    }
}
__device__ __forceinline__ void p0_prologue(const Params& p, float* lds) {
    const int tid = opaque_tid(), G = gridDim.x, b = blockIdx.x;
    unsigned char* ws = pws(p);
    for (int it = b; it < 1440; it += G) weight_tile(p, it, lds);
    float* sc = lds;
    float* red = lds + 5 * 2048;
    __syncthreads();
    for (int i = tid; i < 5 * 2048; i += NTHR) { const int v = i >> 11, k = i & 2047; const float x = v == 0 ? pin(p, 4)[k] : pin(p, 3)[(v - 1) * 2048 + k]; sc[i] = siluf_(x); }
    __syncthreads();
    for (int it = b; it < 192; it += G) {
        const int l = it / 96, col0 = (it % 96) * 64;
        const int kq = tid >> 4, c4 = tid & 15;
        f32x4 acc[5];
#pragma unroll
        for (int v = 0; v < 5; ++v) acc[v] = (f32x4){0.f, 0.f, 0.f, 0.f};
        const float* wp = pin(p, 5) + (size_t)l * 2048 * 6144 + col0 + c4 * 4;
#pragma unroll 8
        for (int i = 0; i < 64; ++i) { const int k = kq + 32 * i; const f32x4 w = *(const f32x4*)(wp + (size_t)k * 6144);
#pragma unroll
            for (int v = 0; v < 5; ++v) acc[v] += w * sc[v * 2048 + k]; }
#pragma unroll
        for (int v = 0; v < 5; ++v) *(f32x4*)(red + (kq * 5 + v) * 64 + c4 * 4) = acc[v];
        __syncthreads();
        if (tid < 320) { const int v = tid >> 6, c = tid & 63; float s = 0.f;
            for (int q = 0; q < 32; ++q) s += red[(q * 5 + v) * 64 + c];
            ((float*)(ws + WS_MOD))[(size_t)(l * 5 + v) * 6144 + col0 + c] = s + pin(p, 6)[l * 6144 + col0 + c]; }
        __syncthreads();
    }
}

__device__ __forceinline__ void pn_norm(const Params& p, int l) {
    const int tid = opaque_tid(), lane = tid & 63, wid = tid >> 6;
    bf16_t* XN = (bf16_t*)(pws(p) + WS_R1);
    const float* MOD = (const float*)(pws(p) + WS_MOD);
    const float* ng = pin(p, 7) + l * DM;
    for (int tok = blockIdx.x * 8 + wid; tok < NTOK; tok += gridDim.x * 8) {
        const float* xr = xrow0(p, tok); const bf16_t* xb = (const bf16_t*)(pws(p) + WS_X1) + (size_t)tok * DM;
        f32x4 v[8]; float ss = 0.f;
#pragma unroll
        for (int i = 0; i < 8; ++i) { v[i] = l == 0 ? *(const f32x4*)(xr + (lane + 64 * i) * 4) : bf4_to_f32(*(const u32x2*)(xb + (lane + 64 * i) * 4)); ss += v[i][0] * v[i][0] + v[i][1] * v[i][1] + v[i][2] * v[i][2] + v[i][3] * v[i][3]; }
        ss = wave_sum(ss);
        const float rstd = rsqrtf(ss * (1.0f / DM) + EPS);
        const float* md = MOD + (size_t)(l * 5 + cvec_of(tok)) * 6144;
#pragma unroll
        for (int i = 0; i < 8; ++i) { const int c = (lane + 64 * i) * 4;
            const f32x4 g = *(const f32x4*)(ng + c), sh = *(const f32x4*)(md + c), scl = *(const f32x4*)(md + 2048 + c);
            const f32x4 h = (v[i] * rstd * g) * (scl + 1.0f) + sh;
            u32x2 o; o[0] = pk2(h[0], h[1]); o[1] = pk2(h[2], h[3]);
            *(u32x2*)(XN + (size_t)tok * DM + c) = o; }
    }
}
__device__ __forceinline__ void pf_final(const Params& p) {
    const int tid = opaque_tid(), lane = tid & 63, wid = tid >> 6;
    const bf16_t* X2 = (const bf16_t*)(pws(p) + WS_P);
    const float* fg = pin(p, 20);
    for (int tok = blockIdx.x * 8 + wid; tok < NTOK; tok += gridDim.x * 8) {
        const bf16_t* xr = X2 + (size_t)tok * DM;
        f32x4 v[8]; float ss = 0.f;
#pragma unroll
        for (int i = 0; i < 8; ++i) { v[i] = bf4_to_f32(*(const u32x2*)(xr + (lane + 64 * i) * 4)); ss += v[i][0] * v[i][0] + v[i][1] * v[i][1] + v[i][2] * v[i][2] + v[i][3] * v[i][3]; }
        ss = wave_sum(ss);
        const float rstd = rsqrtf(ss * (1.0f / DM) + EPS);
#pragma unroll
        for (int i = 0; i < 8; ++i) { const int c = (lane + 64 * i) * 4; const f32x4 g = *(const f32x4*)(fg + c);
            *(f32x4*)(pout(p) + (size_t)tok * DM + c) = v[i] * rstd * g; }
    }
}

struct ChainOrder : pg8::StaticOrder {
    __device__ bool next(int i, pg8::Unit& u) const { const bool ok = pg8::StaticOrder::next(i >> 1, u); u.kh = i & 1; return ok; }
};
struct EpiP {
    static constexpr bool PERM = true, AFTER_DRAIN = false, CHAIN = false;
    bf16_t* P; float* BA;
    __device__ __forceinline__ void operator()(f32x4 (&acc)[2][2][4][2], const pg8::Unit& u, int wr, int wc, int fr, int fq) const {
        const int row0 = u.pm * 256 + wr * 64 + fr, col0 = u.pn * 256 + wc * 32 + 8 * fq;
#pragma unroll
        for (int ai = 0; ai < 2; ++ai)
#pragma unroll
            for (int m = 0; m < 4; ++m) { const int row = row0 + ai * 128 + m * 16; bf16_t* rowp = P + (size_t)row * NP + col0;
                if (u.pn < 8) {
                    f32x4 G[2];
#pragma unroll
                    for (int n = 0; n < 2; ++n)
#pragma unroll
                        for (int e = 0; e < 4; ++e) G[n][e] = acc[ai][0][m][n][e] * sigmoidf_(acc[ai][1][m][n][e]);
                    u32x4 o; o[0] = pk2(G[0][0], G[0][1]); o[1] = pk2(G[0][2], G[0][3]); o[2] = pk2(G[1][0], G[1][1]); o[3] = pk2(G[1][2], G[1][3]);
                    *(u32x4*)rowp = o;
                } else if (u.pn >= 28 && u.pn < 44) {
                    f32x4 R[2], Sg[2];
#pragma unroll
                    for (int n = 0; n < 2; ++n)
#pragma unroll
                        for (int e = 0; e < 4; ++e) { const float ea = __expf(-acc[ai][0][m][n][e]), eb = __expf(-acc[ai][1][m][n][e]);
                            R[n][e] = (1.0f + eb) * __builtin_amdgcn_rcpf(1.0f + ea); Sg[n][e] = __builtin_amdgcn_rcpf(1.0f + eb); }
                    u32x4 o; o[0] = pk2(R[0][0], R[0][1]); o[1] = pk2(R[0][2], R[0][3]); o[2] = pk2(R[1][0], R[1][1]); o[3] = pk2(R[1][2], R[1][3]);
                    *(u32x4*)rowp = o;
                    o[0] = pk2(Sg[0][0], Sg[0][1]); o[1] = pk2(Sg[0][2], Sg[0][3]); o[2] = pk2(Sg[1][0], Sg[1][1]); o[3] = pk2(Sg[1][2], Sg[1][3]);
                    *(u32x4*)(rowp + 128) = o;
                } else
#pragma unroll
                for (int bj = 0; bj < 2; ++bj) { const f32x4 v0 = acc[ai][bj][m][0], v1 = acc[ai][bj][m][1];
                    u32x4 o; o[0] = pg8::cvt_pk_bf16(v0[0], v0[1]); o[1] = pg8::cvt_pk_bf16(v0[2], v0[3]); o[2] = pg8::cvt_pk_bf16(v1[0], v1[1]); o[3] = pg8::cvt_pk_bf16(v1[2], v1[3]);
                    *(u32x4*)(rowp + bj * 128) = o; }
                if (u.pn == 44 && wc == 0) { *(f32x4*)(BA + (size_t)row * 32 + 8 * fq) = acc[ai][0][m][0]; *(f32x4*)(BA + (size_t)row * 32 + 8 * fq + 4) = acc[ai][0][m][1]; }
            }
    }
};
struct EpiMG {
    static constexpr bool PERM = true, AFTER_DRAIN = false, CHAIN = true;
    const bf16_t* P; bf16_t* MG;
    __device__ __forceinline__ void operator()(f32x4 (&acc)[2][2][4][2], const pg8::Unit& u, int wr, int wc, int fr, int fq) const {
        const int row0 = u.pm * 256 + wr * 64 + fr, w0 = wc * 32 + 8 * fq, col0 = u.pn * 256 + w0;
        const int goff = u.kh == 0 ? 0 : 128;
#pragma unroll
        for (int ai = 0; ai < 2; ++ai) { u32x4 gv[4][2];
#pragma unroll
            for (int m = 0; m < 4; ++m) { const bf16_t* rowp = P + (size_t)(row0 + ai * 128 + m * 16) * NP + C_GA + w0 + goff;
#pragma unroll
                for (int bj = 0; bj < 2; ++bj) gv[m][bj] = *(const u32x4*)(rowp + (2 * u.pn + bj) * 256); }
#pragma unroll
            for (int m = 0; m < 4; ++m) { const int row = row0 + ai * 128 + m * 16;
#pragma unroll
                for (int bj = 0; bj < 2; ++bj) { float o[8];
#pragma unroll
                    for (int e = 0; e < 8; ++e) { const unsigned wv = gv[m][bj][e >> 1]; const float gvv = __uint_as_float((e & 1) ? (wv & 0xffff0000u) : (wv << 16));
                        o[e] = acc[ai][bj][m][e >> 2][e & 3] * gvv; }
                    if (u.kh == 0) {
#pragma unroll
                        for (int e = 0; e < 8; ++e) acc[ai][bj][m][e >> 2][e & 3] = o[e];
                    } else { u32x4 ov; ov[0] = pk2(o[0], o[1]); ov[1] = pk2(o[2], o[3]); ov[2] = pk2(o[4], o[5]); ov[3] = pk2(o[6], o[7]);
                        *(u32x4*)(MG + (size_t)row * DM + col0 + bj * 128) = ov; } } }
            __builtin_amdgcn_sched_barrier(0); }
    }
};
struct EpiX {
    static constexpr bool PERM = false, AFTER_DRAIN = false, CHAIN = false;
    const float* x0a; const float* x0b; const bf16_t* x1; const float* gate; bf16_t* out;
    __device__ __forceinline__ void operator()(f32x4 (&acc)[2][2][4][2], const pg8::Unit& u, int wr, int wc, int fr, int fq) const {
        const int row0 = u.pm * 256 + wr * 64 + fr, col0 = u.pn * 256 + wc * 32 + 4 * fq;
#pragma unroll
        for (int ai = 0; ai < 2; ++ai)
#pragma unroll
            for (int m = 0; m < 4; ++m) { const int row = row0 + ai * 128 + m * 16;
                const float* xr = row < NCTX ? x0a + (size_t)row * DM : x0b + (size_t)(row - NCTX) * DM;
                const float* gr = gate + (size_t)cvec_of(row) * 6144;
#pragma unroll
                for (int bj = 0; bj < 2; ++bj)
#pragma unroll
                    for (int n = 0; n < 2; ++n) { const int col = col0 + bj * 128 + n * 16;
                        const f32x4 xv = x1 ? bf4_to_f32(*(const u32x2*)(x1 + (size_t)row * DM + col)) : *(const f32x4*)(xr + col), gv = *(const f32x4*)(gr + col);
                        const f32x4 r4 = xv + gv * acc[ai][bj][m][n];
                        u32x2 o2; o2[0] = pk2(r4[0], r4[1]); o2[1] = pk2(r4[2], r4[3]); *(u32x2*)(out + (size_t)row * DM + col) = o2; }
            }
    }
};

template <int T>
__device__ __forceinline__ void conv_line(const bf16_t* __restrict__ P, bf16_t* __restrict__ Y, int base, int stride, int L, int p0, int ch, const float* __restrict__ w, const float* __restrict__ cb) {
    const int ucol = (ch >> 7) * 256 + (ch & 127);
    f32x2_t ua[T + 30];
#pragma unroll
    for (int i = 0; i < T + 30; ++i) { const int pos = p0 - 15 + i; f32x2_t v = {0.f, 0.f};
        if (pos >= 0 && pos < L) { const unsigned a = *(const unsigned*)(P + (size_t)(base + pos * stride) * NP + ucol);
            v[0] = __uint_as_float(a << 16); v[1] = __uint_as_float(a & 0xffff0000u); }
        ua[i] = v; }
    f32x2_t wk[31];
#pragma unroll
    for (int k = 0; k < 31; ++k) wk[k] = *(const f32x2_t*)(w + k * 1024 + ch);
    const f32x2_t bias = *(const f32x2_t*)(cb + ch);
#pragma unroll
    for (int j = 0; j < T; ++j) { f32x2_t a = bias;
#pragma unroll
        for (int k = 0; k < 31; ++k) a += wk[k] * ua[j + k];
        *(unsigned*)(Y + (size_t)(base + (p0 + j) * stride) * 1024 + ch) = pk2(a[0], a[1]); }
}

__device__ __forceinline__ void split8(const float* p, bf16x8& hi, bf16x8& lo) {
    const f32x4 a = *(const f32x4*)p, b2 = *(const f32x4*)(p + 4);
    u32x4 h, l2;
    h[0] = pk2(a[0], a[1]); h[1] = pk2(a[2], a[3]); h[2] = pk2(b2[0], b2[1]); h[3] = pk2(b2[2], b2[3]);
    l2[0] = pk2(a[0] - __uint_as_float(h[0] << 16), a[1] - __uint_as_float(h[0] & 0xffff0000u));
    l2[1] = pk2(a[2] - __uint_as_float(h[1] << 16), a[3] - __uint_as_float(h[1] & 0xffff0000u));
    l2[2] = pk2(b2[0] - __uint_as_float(h[2] << 16), b2[1] - __uint_as_float(h[2] & 0xffff0000u));
    l2[3] = pk2(b2[2] - __uint_as_float(h[3] << 16), b2[3] - __uint_as_float(h[3] & 0xffff0000u));
    hi = __builtin_bit_cast(bf16x8, h); lo = __builtin_bit_cast(bf16x8, l2);
}
__device__ __forceinline__ void dn_precompute(const Params& p, int l, int gc, int h, float* lds) {
    const int tid = opaque_tid(), lane = tid & 63, wid = tid >> 6;
    float* qs = lds;
    float* ks = lds + 8448;
    float* vs = lds + 2 * 8448;
    float* Gm = lds + 3 * 8448;
    float* QKm = Gm + 4160;
    float* betaS = QKm + 4160;
    float* gcS = betaS + 128;
    float* wscS = gcS + 128;
    const bf16_t* P = (const bf16_t*)(pws(p) + WS_P);
    const float* BA = (const float*)(pws(p) + WS_BA);
    int n, nc; if (gc < 64) { n = gc & 3; nc = 4; } else { n = (gc - 64) & 15; nc = 16; }
    const int tok0 = gc * 64;
    const float* cw = pin(p, 14) + (size_t)l * 3 * 3072;
    if (tid < 384) { const int cg = tid % 48, run = tid / 48, which = cg >> 4, d0 = (cg & 15) * 8;
        const int wch = which * 1024 + h * 128 + d0;
        const bf16_t* pc = P + (long)(tok0 + run * 8 - 1) * NP + C_Q + wch;
        u32x4 rows[10];
#pragma unroll
        for (int r = 0; r < 10; ++r) { const int t = run * 8 - 1 + r; const bool valid = (t >= 0 || n > 0) && (t < 64 || n < nc - 1);
            rows[r] = valid ? *(const u32x4*)(pc + (long)r * NP) : (u32x4){0u, 0u, 0u, 0u}; }
        f32x4 w[3][2];
#pragma unroll
        for (int j = 0; j < 3; ++j) { w[j][0] = *(const f32x4*)(cw + j * 3072 + wch); w[j][1] = *(const f32x4*)(cw + j * 3072 + wch + 4); }
        float* dst = (which == 0 ? qs : (which == 1 ? ks : vs)) + d0;
#pragma unroll
        for (int o = 0; o < 8; ++o) { f32x4 r2[2];
#pragma unroll
            for (int e = 0; e < 8; ++e) { const unsigned a = rows[o][e >> 1], bq = rows[o + 1][e >> 1], cq = rows[o + 2][e >> 1];
                const float xm = __uint_as_float((e & 1) ? (a & 0xffff0000u) : (a << 16)), x0 = __uint_as_float((e & 1) ? (bq & 0xffff0000u) : (bq << 16)), xp = __uint_as_float((e & 1) ? (cq & 0xffff0000u) : (cq << 16));
                r2[e >> 2][e & 3] = siluf_(w[0][e >> 2][e & 3] * xm + w[1][e >> 2][e & 3] * x0 + w[2][e >> 2][e & 3] * xp); }
            *(f32x4*)(dst + (run * 8 + o) * 132) = r2[0]; *(f32x4*)(dst + (run * 8 + o) * 132 + 4) = r2[1]; }
    }
    if (tid < 128) { const int dir = tid >> 6, i = tid & 63, tl = dir ? 63 - i : i;
        const float* ba = BA + (size_t)(tok0 + tl) * 32;
        const float bl = ba[dir * 8 + h], al = ba[16 + dir * 8 + h];
        const float xx = al + pin(p, 16)[(l * 2 + dir) * 8 + h];
        const float sp = xx > 20.f ? xx : log1pf(__expf(xx));
        float g = -__expf(pin(p, 15)[(l * 2 + dir) * 8 + h]) * sp;
#pragma unroll
        for (int o = 1; o < 64; o <<= 1) { const float t2 = __shfl_up(g, o); if (i >= o) g += t2; }
        const float bt = sigmoidf_(bl); betaS[dir * 64 + i] = bt; gcS[dir * 64 + i] = g; wscS[dir * 64 + i] = bt * __expf(g); }
    __syncthreads();
    { float a[16], b2[16], ss[16];
#pragma unroll
        for (int k = 0; k < 16; ++k) { const int r = wid + 8 * k; const float* row = (r < 64 ? qs + r * 132 : ks + (r - 64) * 132); a[k] = row[lane]; b2[k] = row[lane + 64]; ss[k] = a[k] * a[k] + b2[k] * b2[k]; }
#pragma unroll
        for (int o = 32; o > 0; o >>= 1) {
#pragma unroll
            for (int k = 0; k < 16; ++k) ss[k] += __shfl_xor(ss[k], o); }
#pragma unroll
        for (int k = 0; k < 16; ++k) { const int r = wid + 8 * k; float* row = (r < 64 ? qs + r * 132 : ks + (r - 64) * 132);
            const float sc = rsqrtf(ss[k] + EPS) * (r < 64 ? 0.08838834764831845f : 1.0f); row[lane] = a[k] * sc; row[lane + 64] = b2[k] * sc; } }
    __syncthreads();
    for (int rg = 0; rg < REP_GRAM; ++rg) { const int mat = wid >> 2, ti = wid & 3, r = lane & 15, q4 = lane >> 4;
        const float* Ar = mat ? qs : ks;
        bf16x8 Ahi[4], Alo[4];
#pragma unroll
        for (int k4 = 0; k4 < 4; ++k4) split8(Ar + (16 * ti + r) * 132 + 32 * k4 + 8 * q4, Ahi[k4], Alo[k4]);
        float* M = mat ? QKm : Gm;
#pragma unroll
        for (int tj = 0; tj < 4; ++tj) { f32x4 acc = (f32x4){0.f, 0.f, 0.f, 0.f};
#pragma unroll
            for (int k4 = 0; k4 < 4; ++k4) { bf16x8 Bhi, Blo; split8(ks + (16 * tj + r) * 132 + 32 * k4 + 8 * q4, Bhi, Blo);
                acc = __builtin_amdgcn_mfma_f32_16x16x32_bf16(Ahi[k4], Bhi, acc, 0, 0, 0);
                acc = __builtin_amdgcn_mfma_f32_16x16x32_bf16(Ahi[k4], Blo, acc, 0, 0, 0);
                acc = __builtin_amdgcn_mfma_f32_16x16x32_bf16(Alo[k4], Bhi, acc, 0, 0, 0); }
#pragma unroll
            for (int j = 0; j < 4; ++j) M[(16 * ti + 4 * q4 + j) * 65 + 16 * tj + r] = acc[j]; } }
    __syncthreads();
    const int dir = tid >> 8, tl = tid & 255;
    unsigned char* rec = pws(p) + WS_DN + (size_t)((gc * 8 + h) * 2 + dir) * DN_REC;
    const float* gcd = gcS + dir * 64; const float* btd = betaS + dir * 64;
    const float gl = gcd[63];
    { bf16_t* qd = (bf16_t*)(rec + DN_QDEC);
        for (int e = tl; e < 64 * 64; e += 256) { const int i = e >> 6, d2 = (e & 63) * 2; const int t = dir ? 63 - i : i; const float eg = __expf(gcd[i]);
            *(unsigned*)(qd + i * 128 + d2) = pk2(qs[t * 132 + d2] * eg, qs[t * 132 + d2 + 1] * eg); } }
    __syncthreads();
    float* Am = qs + dir * 4096;
    for (int e = tl; e < 4096; e += 256) { const int j = e >> 6, i = e & 63; const int ti = dir ? 63 - i : i, tj = dir ? 63 - j : j;
        Am[e] = j < i ? btd[i] * Gm[ti * 65 + tj] * __expf(gcd[i] - gcd[j]) : 0.f; }
    __syncthreads();
    if (tl >= 64) { const int t2 = tl - 64;
        bf16_t* kd = (bf16_t*)(rec + DN_KDT);
        for (int e = t2; e < 128 * 32; e += 192) { const int dk = e >> 5, j2 = (e & 31) * 2; const int t0 = dir ? 63 - j2 : j2, t1 = dir ? 62 - j2 : j2 + 1;
            *(unsigned*)(kd + dk * 64 + j2) = pk2(ks[t0 * 132 + dk] * __expf(gl - gcd[j2]), ks[t1 * 132 + dk] * __expf(gl - gcd[j2 + 1])); }
        bf16_t* qk = (bf16_t*)(rec + DN_QKM);
        for (int e = t2; e < 64 * 32; e += 192) { const int i = e >> 5, j2 = (e & 31) * 2; const int ti = dir ? 63 - i : i, t0 = dir ? 63 - j2 : j2, t1 = dir ? 62 - j2 : j2 + 1;
            const float v0 = j2 <= i ? QKm[ti * 65 + t0] * __expf(gcd[i] - gcd[j2]) : 0.f;
            const float v1 = j2 + 1 <= i ? QKm[ti * 65 + t1] * __expf(gcd[i] - gcd[j2 + 1]) : 0.f;
            *(unsigned*)(qk + i * 64 + j2) = pk2(v0, v1); }
        if (t2 == 0) *(float*)(rec + DN_EGL) = __expf(gl);
    }
    float* Tm = Am;
    if (tl < 64) { const int c = tl;
        f32x2_t U2[32];
#pragma unroll
        for (int i = 0; i < 64; ++i) U2[i >> 1][i & 1] = (i == c) ? 1.f : 0.f;
        f32x4 av[2][16];
#pragma unroll
        for (int i4 = 0; i4 < 16; ++i4) av[0][i4] = *(const f32x4*)(Am + i4 * 4);
        __builtin_amdgcn_sched_barrier(0);
#pragma unroll
        for (int j = 0; j < 63; ++j) {
            if (j + 1 < 63) {
#pragma unroll
                for (int i4 = (j + 2) / 4; i4 < 16; ++i4) av[(j + 1) & 1][i4] = *(const f32x4*)(Am + (j + 1) * 64 + i4 * 4); }
            const float uj = U2[j >> 1][j & 1]; const f32x2_t ujj = {uj, uj};
#pragma unroll
            for (int pr = (j + 1) / 2; pr < 32; ++pr) { const f32x4 a4 = av[j & 1][pr >> 1]; const f32x2_t a2 = (pr & 1) ? (f32x2_t){a4[2], a4[3]} : (f32x2_t){a4[0], a4[1]};
                if (2 * pr > j) U2[pr] = U2[pr] - a2 * ujj; else U2[pr][1] -= a2[1] * uj; }
            __builtin_amdgcn_sched_barrier(0); }
#pragma unroll
        for (int i = 0; i < 64; ++i) Tm[i * 64 + c] = U2[i >> 1][i & 1];
    }
    __syncthreads();
    { const int wq = wid & 3, r = lane & 15, kg = lane >> 4; const bool isu = wq < 2;
        int rstep = dir ? -132 : 132; asm volatile("" : "+v"(rstep));
        const float* src = (isu ? vs + wq * 64 : ks + (wq - 2) * 64) + (dir ? 63 * 132 : 0) + r;
        const float* scl = isu ? btd : wscS + dir * 64;
        bf16x8 Ahi[4][2], Alo[4][2];
#pragma unroll
        for (int m = 0; m < 4; ++m)
#pragma unroll
            for (int kx = 0; kx < 2; ++kx) split8(Tm + (16 * m + r) * 64 + 32 * kx + 8 * kg, Ahi[m][kx], Alo[m][kx]);
        float* ut = (float*)(rec + DN_UT); bf16_t* nw = (bf16_t*)(rec + DN_NEGW);
#pragma unroll
        for (int nt = 0; nt < 4; ++nt) { bf16x8 Bf[2];
#pragma unroll
            for (int kx = 0; kx < 2; ++kx) { const int j0 = 32 * kx + 8 * kg; const f32x4 s0 = *(const f32x4*)(scl + j0), s1 = *(const f32x4*)(scl + j0 + 4);
                u32x4 o;
#pragma unroll
                for (int e2 = 0; e2 < 4; ++e2) { const float x0 = src[(j0 + 2 * e2) * rstep + 16 * nt] * (e2 < 2 ? s0[2 * e2] : s1[2 * e2 - 4]), x1 = src[(j0 + 2 * e2 + 1) * rstep + 16 * nt] * (e2 < 2 ? s0[2 * e2 + 1] : s1[2 * e2 - 3]);
                    o[e2] = pk2(x0, x1); }
                Bf[kx] = __builtin_bit_cast(bf16x8, o); }
#pragma unroll
            for (int m = 0; m < 4; ++m) { f32x4 acc = (f32x4){0.f, 0.f, 0.f, 0.f};
#pragma unroll
                for (int kx = 0; kx < 2; ++kx) { acc = __builtin_amdgcn_mfma_f32_16x16x32_bf16(Ahi[m][kx], Bf[kx], acc, 0, 0, 0); acc = __builtin_amdgcn_mfma_f32_16x16x32_bf16(Alo[m][kx], Bf[kx], acc, 0, 0, 0); }
                const int i0 = 16 * m + 4 * kg, cc = 16 * nt + r;
                if (isu) { u32x2 o2; o2[0] = pk2(acc[0], acc[1]); o2[1] = pk2(acc[2], acc[3]); *(u32x2*)((bf16_t*)ut + (wq * 64 + cc) * 64 + i0) = o2; }
                else {
#pragma unroll
                    for (int jj = 0; jj < 4; ++jj) nw[(i0 + jj) * 128 + (wq - 2) * 64 + cc] = (bf16_t)f2bf(-acc[jj]); } }
        }
    }
    __syncthreads();
}

__device__ __forceinline__ void pc_phase(const Params& p, int l, float* lds) {
    const int tid = opaque_tid();
    const bf16_t* P = (const bf16_t*)(pws(p) + WS_P);
    bf16_t* Y = (bf16_t*)(pws(p) + WS_Y);
    const float* cw = pin(p, 9) + (size_t)l * 31 * 1024;
    const float* cb = pin(p, 10) + l * 1024;
    const bool g256 = (int)gridDim.x == 256;
    for (int kk = 0;; ++kk) {
        int it = (int)blockIdx.x + kk * (int)gridDim.x;
        if (g256 && kk == 5) it = (int)blockIdx.x >= 192 ? 1280 + (int)blockIdx.x - 192 : (1 << 30);
        if (it >= 1024 + 320) break;
#ifndef NO_DN
        if (it < 1024) { for (int rd = 0; rd < REP_DN; ++rd) dn_precompute(p, l, it >> 3, it & 7, lds); continue; }
#endif
#ifndef NO_CONV
        for (int rcv = 0; rcv < REP_CONV; ++rcv) {
        int r = it - 1024;
        int tl = opaque_tid();
        if (r < 192) { int base, L, p0, ch;
            if (r < 128) { const int tile = r & 7, bb = r >> 3; ch = 2 * tl; base = bb * 256; L = 256; p0 = tile * 32; }
            else { r -= 128; const int row = r & 15, bb = r >> 4; ch = 2 * (tl & 255); base = NCTX + bb * 1024 + row * 64; L = 64; p0 = (tl >> 8) * 32; }
            int st = 1; asm volatile("" : "+s"(st));
            conv_line<32>(P, Y, base, st, L, p0, ch, cw, cb);
        } else {
            r -= 192; const int col = 2 * (r & 31) + (tl >> 8), bb = r >> 5; const int ch = 512 + 2 * (tl & 255);
            int st = 64; asm volatile("" : "+s"(st));
            conv_line<16>(P, Y, NCTX + bb * 1024 + col, st, 16, 0, ch, cw, cb);
        }
        }
#endif
    }
}

__device__ __forceinline__ bf16x8 pack8(const f32x4& a, const f32x4& b) {
    u32x4 r; r[0] = pk2(a[0], a[1]); r[1] = pk2(a[2], a[3]); r[2] = pk2(b[0], b[1]); r[3] = pk2(b[2], b[3]);
    return __builtin_bit_cast(bf16x8, r);
}
__device__ __forceinline__ bf16x8 lds_afrag(const unsigned char* base) {
    const u32x2 lo = *(const u32x2*)base, hi = *(const u32x2*)(base + 32);
    u32x4 r; r[0] = lo[0]; r[1] = lo[1]; r[2] = hi[0]; r[3] = hi[1];
    return __builtin_bit_cast(bf16x8, r);
}
#define MFMA16(a, b, c) __builtin_amdgcn_mfma_f32_16x16x32_bf16((a), (b), (c), 0, 0, 0)

#define SCAN_IMG 67584
__device__ __forceinline__ const unsigned char* dn_rec(const Params& p, int gc, int h, int dir) { return pws(p) + WS_DN + (size_t)((gc * 8 + h) * 2 + dir) * DN_REC; }
__device__ __forceinline__ void scan_item(const Params& p, int l, int sq, int h, int dir, unsigned char* lds) {
    const int tid = opaque_tid(), lane = tid & 63, wid = __builtin_amdgcn_readfirstlane(tid >> 6), c = lane & 15, q = lane >> 4;
    const bool ctx = sq < 16;
    const int nc = ctx ? 4 : 16, gc0 = ctx ? sq * 4 : 64 + (sq - 16) * 16;
#define SCAN_GC(s_) (gc0 + (dir ? nc - 1 - (s_) : (s_)))
    if (wid >= 4) {
        const int tl = tid - 256;
        u32x4 Ra[14], Rb[14];
#define SCAN_LOAD(R_, s_) do { const unsigned char* r_ = dn_rec(p, SCAN_GC((s_) < nc ? (s_) : nc - 1), h, dir); _Pragma("unroll") for (int k = 0; k < 14; ++k) R_[k] = *(const u32x4*)(r_ + (size_t)(tl + 256 * k) * 16); } while (0)
#define SCAN_WRITE(R_, buf_) do { unsigned char* b_ = lds + (buf_) * SCAN_IMG; _Pragma("unroll") for (int k = 0; k < 14; ++k) { const int ch = tl + 256 * k; unsigned char* dst; \
            if (k < 4) dst = b_ + (ch >> 4) * 288 + (ch & 15) * 16; \
            else if (k < 8) { const int x = ch - 1024; dst = b_ + 18432 + (x >> 4) * 288 + (x & 15) * 16; } \
            else if (k < 12) { const int x = ch - 2048; dst = b_ + 36864 + (x >> 3) * 160 + (x & 7) * 16; } \
            else { const int x = ch - 3072; dst = b_ + 57344 + (x >> 3) * 160 + (x & 7) * 16; } \
            *(u32x4*)dst = R_[k]; } } while (0)
        SCAN_LOAD(Ra, 0); SCAN_LOAD(Rb, 1);
        SCAN_WRITE(Ra, 0);
        __syncthreads();
        for (int s = 0; s < nc; s += 2) {
            SCAN_LOAD(Ra, s + 2);
            SCAN_WRITE(Rb, 1);
            __syncthreads();
            SCAN_LOAD(Rb, s + 3);
            SCAN_WRITE(Ra, 0);
            __syncthreads();
        }
#undef SCAN_LOAD
#undef SCAN_WRITE
    } else {
        const int dv0 = wid * 32;
        bf16_t* O = (bf16_t*)(pws(p) + WS_R1) + (size_t)dir * NTOK * 1024;
        f32x4 S[2][8];
#pragma unroll
        for (int t = 0; t < 2; ++t)
#pragma unroll
            for (int m = 0; m < 8; ++m) S[t][m] = (f32x4){0.f, 0.f, 0.f, 0.f};
        if (!ctx) { const float* sd = pin(p, 2) + ((size_t)(((sq - 16) * 2 + l) * 2 + dir) * 8 + h) * 16384;
#pragma unroll
            for (int t = 0; t < 2; ++t)
#pragma unroll
                for (int m = 0; m < 8; ++m)
#pragma unroll
                    for (int j = 0; j < 4; ++j) S[t][m][j] = sd[(16 * m + 4 * q + j) * 128 + dv0 + 16 * t + c]; }
        u32x2 utn[2][4]; float egl;
        { const unsigned char* rec0 = dn_rec(p, SCAN_GC(0), h, dir);
#pragma unroll
            for (int t = 0; t < 2; ++t)
#pragma unroll
                for (int m = 0; m < 4; ++m) utn[t][m] = *(const u32x2*)((const bf16_t*)(rec0 + DN_UT) + (dv0 + 16 * t + c) * 64 + 16 * m + 4 * q);
            egl = *(const float*)(rec0 + DN_EGL); }
        __syncthreads();
        for (int s = 0; s < nc; ++s) {
            const int gc = SCAN_GC(s);
            const unsigned char* recn = dn_rec(p, SCAN_GC(s + 1 < nc ? s + 1 : s), h, dir);
            const unsigned char* L_negw = lds + (s & 1) * SCAN_IMG;
            const unsigned char* L_qdec = L_negw + 18432;
            const unsigned char* L_kdt = L_negw + 36864;
            const unsigned char* L_qkm = L_negw + 57344;
            f32x4 vn[2][4];
#pragma unroll
            for (int t = 0; t < 2; ++t)
#pragma unroll
                for (int m = 0; m < 4; ++m) vn[t][m] = bf4_to_f32(utn[t][m]);
            bf16x8 Bs[2][4];
#pragma unroll
            for (int t = 0; t < 2; ++t)
#pragma unroll
                for (int kb = 0; kb < 4; ++kb) Bs[t][kb] = pack8(S[t][2 * kb], S[t][2 * kb + 1]);
            const unsigned char* aN = L_negw + c * 288 + 8 * q;
            const unsigned char* aQ = L_qdec + c * 288 + 8 * q;
            const unsigned char* aM = L_qkm + c * 160 + 8 * q;
            const unsigned char* aK = L_kdt + c * 160 + 8 * q;
#define SB_ __builtin_amdgcn_sched_barrier(0)
#define LD_N(F, m) do { _Pragma("unroll") for (int kb = 0; kb < 4; ++kb) F[kb] = lds_afrag(aN + (m) * 16 * 288 + 64 * kb); } while (0)
#define LD_Q(F, m) do { _Pragma("unroll") for (int kb = 0; kb < 4; ++kb) F[kb] = lds_afrag(aQ + (m) * 16 * 288 + 64 * kb); } while (0)
#define LD_M(F, m) do { _Pragma("unroll") for (int kb = 0; kb < 2; ++kb) F[kb] = lds_afrag(aM + (m) * 16 * 160 + 64 * kb); } while (0)
#define LD_K(F, m2) do { _Pragma("unroll") for (int mm = 0; mm < 2; ++mm) _Pragma("unroll") for (int kb = 0; kb < 2; ++kb) F[mm * 2 + kb] = lds_afrag(aK + (2 * (m2) + mm) * 16 * 160 + 64 * kb); } while (0)
#define MF_N(F, m) do { _Pragma("unroll") for (int kb = 0; kb < 4; ++kb) { vn[0][m] = MFMA16(F[kb], Bs[0][kb], vn[0][m]); vn[1][m] = MFMA16(F[kb], Bs[1][kb], vn[1][m]); } } while (0)
#define MF_Q(F, m) do { oa0 = (f32x4){0.f, 0.f, 0.f, 0.f}; oa1 = oa0; \
            _Pragma("unroll") for (int kb = 0; kb < 4; ++kb) { oa0 = MFMA16(F[kb], Bs[0][kb], oa0); oa1 = MFMA16(F[kb], Bs[1][kb], oa1); } } while (0)
#define MF_M(F, m) do { f32x4 a0 = oa0, a1 = oa1; \
            _Pragma("unroll") for (int kb = 0; kb < 2; ++kb) { a0 = MFMA16(F[kb], Bv[0][kb], a0); a1 = MFMA16(F[kb], Bv[1][kb], a1); } \
            _Pragma("unroll") for (int j = 0; j < 4; ++j) { const int i = 16 * (m) + 4 * q + j; const int tok = gc * 64 + (dir ? 63 - i : i); \
                bf16_t* op = O + (size_t)tok * 1024 + h * 128 + dv0 + c; op[0] = (bf16_t)f2bf(a0[j]); op[16] = (bf16_t)f2bf(a1[j]); } } while (0)
#define MF_K(F, m2) do { _Pragma("unroll") for (int mm = 0; mm < 2; ++mm) { f32x4 a0 = S[0][2 * (m2) + mm] * egl, a1 = S[1][2 * (m2) + mm] * egl; \
            _Pragma("unroll") for (int kb = 0; kb < 2; ++kb) { a0 = MFMA16(F[mm * 2 + kb], Bv[0][kb], a0); a1 = MFMA16(F[mm * 2 + kb], Bv[1][kb], a1); } \
            S[0][2 * (m2) + mm] = a0; S[1][2 * (m2) + mm] = a1; } } while (0)
            bf16x8 X[4], Y[4]; f32x4 oa0, oa1;
            LD_N(X, 0); SB_;
            LD_N(Y, 1); SB_; MF_N(X, 0); SB_;
            LD_N(X, 2); SB_; MF_N(Y, 1); SB_;
            LD_N(Y, 3); SB_; MF_N(X, 2); SB_;
            LD_Q(X, 0); SB_; MF_N(Y, 3); SB_;
            bf16x8 Bv[2][2];
#pragma unroll
            for (int t = 0; t < 2; ++t)
#pragma unroll
                for (int kb = 0; kb < 2; ++kb) Bv[t][kb] = pack8(vn[t][2 * kb], vn[t][2 * kb + 1]);
#pragma unroll
            for (int t = 0; t < 2; ++t)
#pragma unroll
                for (int m = 0; m < 4; ++m) utn[t][m] = *(const u32x2*)((const bf16_t*)(recn + DN_UT) + (dv0 + 16 * t + c) * 64 + 16 * m + 4 * q);
            SB_;
            LD_M(Y, 0); SB_; MF_Q(X, 0); SB_;
            LD_Q(X, 1); SB_; MF_M(Y, 0); SB_;
            LD_M(Y, 1); SB_; MF_Q(X, 1); SB_;
            LD_Q(X, 2); SB_; MF_M(Y, 1); SB_;
            LD_M(Y, 2); SB_; MF_Q(X, 2); SB_;
            LD_Q(X, 3); SB_; MF_M(Y, 2); SB_;
            LD_M(Y, 3); SB_; MF_Q(X, 3); SB_;
            LD_K(X, 0); SB_; MF_M(Y, 3); SB_;
            LD_K(Y, 1); SB_; MF_K(X, 0); SB_;
            LD_K(X, 2); SB_; MF_K(Y, 1); SB_;
            LD_K(Y, 3); SB_; MF_K(X, 2); SB_;
            MF_K(Y, 3);
#undef SB_
#undef LD_N
#undef LD_Q
#undef LD_M
#undef LD_K
#undef MF_N
#undef MF_Q
#undef MF_M
#undef MF_K
            egl = *(const float*)(recn + DN_EGL);
            __syncthreads();
        }
        if (ctx) { float* so = pout(p) + (size_t)NTOK * DM + ((size_t)((sq * 2 + l) * 2 + dir) * 8 + h) * 16384;
#pragma unroll
            for (int t = 0; t < 2; ++t)
#pragma unroll
                for (int m = 0; m < 8; ++m)
#pragma unroll
                    for (int j = 0; j < 4; ++j) so[(16 * m + 4 * q + j) * 128 + dv0 + 16 * t + c] = S[t][m][j]; }
    }
#undef SCAN_GC
}

__device__ __forceinline__ void lna_group(const Params& p, int l, int grp) {
    const int tid = opaque_tid(), lane = tid & 63, wid = tid >> 6;
    const int tok = grp * 8 + wid;
    const bf16_t* y = (const bf16_t*)(pws(p) + WS_Y) + (size_t)tok * 1024;
    const bf16_t* az = (const bf16_t*)(pws(p) + WS_P) + (size_t)tok * NP + C_AZ;
    bf16_t* U = (bf16_t*)(pws(p) + WS_U) + (size_t)tok * 2048;
    const float* lg = pin(p, 11) + l * 1024; const float* lb = pin(p, 12) + l * 1024;
    f32x4 v[4]; float s = 0.f;
#pragma unroll
    for (int i = 0; i < 4; ++i) { v[i] = bf4_to_f32(*(const u32x2*)(y + (lane + 64 * i) * 4)); s += v[i][0] + v[i][1] + v[i][2] + v[i][3]; }
    const float mu = wave_sum(s) * (1.0f / 1024.0f);
    float s2 = 0.f;
#pragma unroll
    for (int i = 0; i < 4; ++i) { v[i] -= mu; s2 += v[i][0] * v[i][0] + v[i][1] * v[i][1] + v[i][2] * v[i][2] + v[i][3] * v[i][3]; }
    const float rstd = rsqrtf(wave_sum(s2) * (1.0f / 1024.0f) + EPS);
#pragma unroll
    for (int i = 0; i < 4; ++i) { const int cc = (lane + 64 * i) * 4; const f32x4 g = *(const f32x4*)(lg + cc), bb = *(const f32x4*)(lb + cc);
        const u32x2 zz = *(const u32x2*)(az + cc);
        f32x4 o = v[i] * rstd * g + bb;
        const float z0 = __uint_as_float(zz[0] << 16), z1 = __uint_as_float(zz[0] & 0xffff0000u), z2 = __uint_as_float(zz[1] << 16), z3 = __uint_as_float(zz[1] & 0xffff0000u);
        u32x2 ov; ov[0] = pk2(siluf_(o[0]) * siluf_(z0), siluf_(o[1]) * siluf_(z1)); ov[1] = pk2(siluf_(o[2]) * siluf_(z2), siluf_(o[3]) * siluf_(z3));
        *(u32x2*)(U + cc) = ov; }
}

__device__ __forceinline__ void ps_phase(const Params& p, int l, unsigned char* lds) {
    const int b = blockIdx.x, G = gridDim.x;
    for (int r = 0;; ++r) { const int id = r * G + (r == 0 ? b : (b + 64 * G - 64) % G); if (id >= 320) break;
        const int sq = id < 64 ? 16 + (id >> 4) : ((id - 64) >> 4);
        for (int rsc = 0; rsc < REP_SCAN; ++rsc) scan_item(p, l, sq, (id >> 1) & 7, id & 1, lds); }
    const int gs = G == 256 ? (b >= 64 ? b - 64 : 1024) : b, gst = G == 256 ? 192 : G;
    for (int rl = 0; rl < REP_LNA; ++rl) for (int g = gs; g < 1024; g += gst) lna_group(p, l, g);
    if (l == 0) drain_tiles(p, 1 << 20, lds);
}

__device__ __forceinline__ void pnb_phase(const Params& p, int l) {
    const int tid = opaque_tid(), lane = tid & 63, wid = tid >> 6;
    const bf16_t* Of = (const bf16_t*)(pws(p) + WS_R1); const bf16_t* Ob = Of + (size_t)NTOK * 1024;
    const float* hg = pin(p, 17) + l * 128;
    for (int tok = blockIdx.x * 8 + wid; tok < NTOK; tok += gridDim.x * 8) {
        const int cb = lane * 16;
        f32x4 v[4]; float ss = 0.f;
#pragma unroll
        for (int i = 0; i < 4; ++i) { v[i] = bf4_to_f32(*(const u32x2*)(Of + (size_t)tok * 1024 + cb + 4 * i)) + bf4_to_f32(*(const u32x2*)(Ob + (size_t)tok * 1024 + cb + 4 * i));
            ss += v[i][0] * v[i][0] + v[i][1] * v[i][1] + v[i][2] * v[i][2] + v[i][3] * v[i][3]; }
        ss += __shfl_xor(ss, 1); ss += __shfl_xor(ss, 2); ss += __shfl_xor(ss, 4);
        const float rstd = rsqrtf(ss * (1.0f / 128.0f) + EPS);
        const bf16_t* zb = (const bf16_t*)(pws(p) + WS_P) + (size_t)tok * NP + C_ZB + cb;
        bf16_t* U = (bf16_t*)(pws(p) + WS_U) + (size_t)tok * 2048 + 1024 + cb;
        const u32x4 z0 = *(const u32x4*)zb, z1 = *(const u32x4*)(zb + 8);
        float o[16];
#pragma unroll
        for (int i = 0; i < 4; ++i) { const f32x4 g = *(const f32x4*)(hg + ((cb + 4 * i) & 127));
#pragma unroll
            for (int e = 0; e < 4; ++e) o[4 * i + e] = v[i][e] * rstd * g[e]; }
        u32x4 r0, r1;
#pragma unroll
        for (int w2 = 0; w2 < 4; ++w2) { const unsigned za = z0[w2], zc = z1[w2];
            r0[w2] = pk2(o[2 * w2] * siluf_(__uint_as_float(za << 16)), o[2 * w2 + 1] * siluf_(__uint_as_float(za & 0xffff0000u)));
            r1[w2] = pk2(o[8 + 2 * w2] * siluf_(__uint_as_float(zc << 16)), o[8 + 2 * w2 + 1] * siluf_(__uint_as_float(zc & 0xffff0000u))); }
        *(u32x4*)U = r0; *(u32x4*)(U + 8) = r1;
    }
}

#define XB_TMO      128
#define XB_XCNT(j)  (256  + 64 * (j))
#define XB_XSUB(j)  (1280 + 64 * (j))
#define XB_XGEN(j)  (2304 + 64 * (j))
#define XB_TOP      3328
#define XB_TOPGEN   3392
#define XCD_BAR_WORDS 3456
#define XB_SPIN_CAP (1u << 18)

__device__ __forceinline__ unsigned xb_ld(unsigned* p)              { return __hip_atomic_load(p, __ATOMIC_RELAXED, __HIP_MEMORY_SCOPE_AGENT); }
__device__ __forceinline__ unsigned xb_add(unsigned* p, unsigned v) { return __hip_atomic_fetch_add(p, v, __ATOMIC_RELAXED, __HIP_MEMORY_SCOPE_AGENT); }
__device__ __forceinline__ unsigned xb_xcc_id() { return (unsigned)__builtin_amdgcn_s_getreg((3 << 11) | 20) & 0xFu; }
#define XB_SPIN(cond, bar) do { unsigned _sp = 0; while (cond) { __builtin_amdgcn_s_sleep(1); \
    if ((++_sp & 255u) == 0u) { if (xb_ld(&(bar)[XB_TMO])) break; if (_sp > XB_SPIN_CAP) { atomicAdd(&(bar)[XB_TMO], 1u); break; } } } } while (0)

struct XcdBarrier {
    unsigned* bar; unsigned x;
    volatile LAS unsigned* st;
};

__device__ __forceinline__ XcdBarrier xcd_barrier_post(unsigned* bar, volatile LAS unsigned* st) {
    XcdBarrier b; b.bar = bar; b.x = xb_xcc_id(); b.st = st;
    if (threadIdx.x == 0) (void)xb_add(&bar[XB_XCNT(b.x)], 1u);
    return b;
}
__device__ __forceinline__ void xcd_barrier_complete(unsigned* bar, unsigned x, unsigned& nloc, unsigned& nx) {
    const unsigned G = gridDim.x * gridDim.y * gridDim.z;
    unsigned sum, cnt, mine, sp = 0u;
    for (;;) {
        sum = 0u; cnt = 0u; mine = 0u;
#pragma unroll
        for (unsigned j = 0; j < 16; ++j) { const unsigned c = xb_ld(&bar[XB_XCNT(j)]); sum += c; cnt += (c > 0u) ? 1u : 0u; mine = (j == x) ? c : mine; }
        if (sum == G) break;
        __builtin_amdgcn_s_sleep(1);
        if ((++sp & 255u) == 0u) { if (xb_ld(&bar[XB_TMO])) break; if (sp > XB_SPIN_CAP) { atomicAdd(&bar[XB_TMO], 1u); break; } }
    }
    nloc = mine > 0u ? mine : 1u; nx = cnt > 0u ? cnt : 1u;
}

__device__ __forceinline__ void xcd_barrier(const XcdBarrier& b) {
    asm volatile("s_waitcnt vmcnt(0)" ::: "memory");
    __syncthreads();
    if (threadIdx.x == 0) {
        unsigned* bar = b.bar;
        __builtin_amdgcn_s_waitcnt(0);
        unsigned nloc = b.st[0], nx = b.st[1];
        if (nloc == 0u) { xcd_barrier_complete(bar, b.x, nloc, nx); b.st[0] = nloc; b.st[1] = nx; }
        const unsigned old = xb_add(&bar[XB_XSUB(b.x)], 1u);
        const unsigned gen = old / nloc;
        if (old + 1u == (gen + 1u) * nloc) {
            __builtin_amdgcn_fence(__ATOMIC_RELEASE, "agent");
            asm volatile("s_waitcnt vmcnt(0)" ::: "memory");
            const unsigned og = xb_add(&bar[XB_TOP], 1u);
            const unsigned tg = og / nx;
            if (og + 1u == (tg + 1u) * nx) xb_add(&bar[XB_TOPGEN], 1u);
            else XB_SPIN(xb_ld(&bar[XB_TOPGEN]) == tg, bar);
            __builtin_amdgcn_fence(__ATOMIC_ACQUIRE, "agent");
            xb_add(&bar[XB_XGEN(b.x)], 1u);
            asm volatile("s_waitcnt vmcnt(0)" ::: "memory");
        } else {
            XB_SPIN(xb_ld(&bar[XB_XGEN(b.x)]) == gen, bar);
            __builtin_amdgcn_fence(__ATOMIC_ACQUIRE, "agent");
            asm volatile("s_waitcnt vmcnt(0)" ::: "memory");
        }
    }
    __syncthreads();
}

#ifndef REP0
#define REP0 1
#endif
#ifndef REP1
#define REP1 1
#endif
#ifndef REP2
#define REP2 1
#endif
#ifndef REP3
#define REP3 1
#endif
#ifndef REP4
#define REP4 1
#endif
#ifndef REP5
#define REP5 1
#endif
#ifndef REP6
#define REP6 1
#endif
#ifndef REP7
#define REP7 1
#endif
__global__ void __launch_bounds__(NTHR) fwd_megakernel(Params p) {
    extern __shared__ __attribute__((aligned(16))) unsigned char lds[];
    cg::grid_group grid = cg::this_grid();
    const int lo = p.ph_lo, hi = p.ph_hi;
    if (lo < 0) grid.sync();
    if (threadIdx.x < 2) ((volatile LAS unsigned*)((LAS unsigned char*)lds + LDS_BARST))[threadIdx.x] = 0u;
    __syncthreads();
    const XcdBarrier xbar = xcd_barrier_post((unsigned*)(pws(p) + WS_BARW), (volatile LAS unsigned*)((LAS unsigned char*)lds + LDS_BARST));
#define IN(k) (lo <= (k) && (k) < hi)
#ifndef SYNC_REP
#define SYNC_REP 1
#endif
#define SEAM(k) do { if (IN(k) && IN((k) + 1)) for (int sr = 0; sr < SYNC_REP; ++sr) { xcd_barrier(xbar); } } while (0)
#if (!defined(ONLY) || ONLY == 0) && !defined(SKIP0)
    if (IN(0)) for (int rp = 0; rp < REP0; ++rp) p0_prologue(p, (float*)lds);
#endif
    SEAM(0);
    for (int l = 0; l < 2; ++l) {
        const int pb = 1 + 7 * l;
        unsigned char* ws = pws(p);
#if (!defined(ONLY) || ONLY == 1) && !defined(SKIP1)
        if (IN(pb)) for (int rp = 0; rp < REP1; ++rp) pn_norm(p, l);
#endif
        SEAM(pb);
#if (!defined(ONLY) || ONLY == 2) && !defined(SKIP2)
        if (IN(pb + 1)) for (int rp = 0; rp < REP2; ++rp) {
            pg8::Gemm g{(const bf16_t*)(ws + WS_R1), (const bf16_t*)(ws + WS_WIN + l * SZ_WIN1), NTOK, NP, DM, DM};
            pg8::StaticOrder S; S.init(NTOK, NP, (int)gridDim.x, (int)blockIdx.x);
            EpiP E{(bf16_t*)(ws + WS_P), (float*)(ws + WS_BA)};
            pg8::gemm_phase<EpiP, pg8::StaticOrder, false, GEMM_ALIGN, GEMM_SP2>((LAS unsigned char*)lds, g, S, E, nullptr);
            if (l == 0 && (int)gridDim.x == 256 && (int)blockIdx.x >= 160) drain_tiles(p, PG1_TILES, lds);
        }
#endif
        SEAM(pb + 1);
#if (!defined(ONLY) || ONLY == 3) && !defined(SKIP3)
        if (IN(pb + 2)) for (int rp = 0; rp < REP3; ++rp) pc_phase(p, l, (float*)lds);
#endif
        SEAM(pb + 2);
#if (!defined(ONLY) || ONLY == 4) && !defined(SKIP4)
        if (IN(pb + 3)) for (int rp = 0; rp < REP4; ++rp) ps_phase(p, l, lds);
#endif
        SEAM(pb + 3);
#if (!defined(ONLY) || ONLY == 5) && !defined(SKIP5)
        if (IN(pb + 4)) for (int rp = 0; rp < REP5; ++rp) pnb_phase(p, l);
#endif
        SEAM(pb + 4);
#if (!defined(ONLY) || ONLY == 6) && !defined(SKIP6)
        if (IN(pb + 5)) for (int rp = 0; rp < REP6; ++rp) {
            pg8::Gemm g{(const bf16_t*)(ws + WS_U), (const bf16_t*)(ws + WS_WP2 + l * SZ_SQ), NTOK, DM, 1024, DM};
            ChainOrder S; S.init(NTOK, DM, (int)gridDim.x, (int)blockIdx.x);
            EpiMG E{(const bf16_t*)(ws + WS_P), (bf16_t*)(ws + WS_R1)};
            pg8::gemm_phase<EpiMG, ChainOrder, false, GEMM_ALIGN, GEMM_SP2>((LAS unsigned char*)lds, g, S, E, nullptr);
        }
#endif
        SEAM(pb + 5);
#if (!defined(ONLY) || ONLY == 7) && !defined(SKIP7)
        if (IN(pb + 6)) for (int rp = 0; rp < REP7; ++rp) {
            pg8::Gemm g{(const bf16_t*)(ws + WS_R1), (const bf16_t*)(ws + WS_WO + l * SZ_SQ), NTOK, DM, DM, DM};
            pg8::StaticOrder S; S.init(NTOK, DM, (int)gridDim.x, (int)blockIdx.x);
            EpiX E{pin(p, 0), pin(p, 1), l == 0 ? nullptr : (const bf16_t*)(ws + WS_X1), (const float*)(ws + WS_MOD) + (size_t)l * 5 * 6144 + 4096, l == 0 ? (bf16_t*)(ws + WS_X1) : (bf16_t*)(ws + WS_P)};
            pg8::gemm_phase<EpiX, pg8::StaticOrder, false, GEMM_ALIGN, GEMM_SP2>((LAS unsigned char*)lds, g, S, E, nullptr);
        }
#endif
        SEAM(pb + 6);
    }
#if (!defined(ONLY) || ONLY == 8) && !defined(SKIP8)
    if (IN(15)) pf_final(p);
#endif
}

#ifndef MK_N_LAUNCHES
#define MK_N_LAUNCHES 1
#endif
extern "C" void kernel_launch(void* const* d_in, const int* in_sizes, int n_in, void* d_out, int out_size, void* d_ws, size_t ws_size, hipStream_t stream) {
    static int grid = 0;
    if (grid == 0) {
        int dev = 0, cus = 0, per_cu = 0;
        hipGetDevice(&dev);
        hipDeviceGetAttribute(&cus, hipDeviceAttributeMultiprocessorCount, dev);
        if (hipFuncSetAttribute((const void*)fwd_megakernel, hipFuncAttributeMaxDynamicSharedMemorySize, LDS_BYTES) != hipSuccess) { fprintf(stderr, "kernel_launch: hipFuncSetAttribute failed\n"); grid = -1; return; }
        if (hipOccupancyMaxActiveBlocksPerMultiprocessor(&per_cu, (const void*)fwd_megakernel, NTHR, LDS_BYTES) != hipSuccess || per_cu < 1) { fprintf(stderr, "kernel_launch: occupancy query says %d blocks per CU\n", per_cu); grid = -1; return; }
        grid = cus * 1;
        if (n_in != 21 || ws_size < WS_END2) { fprintf(stderr, "kernel_launch: unexpected n_in %d / ws %zu\n", n_in, ws_size); grid = -1; return; }
    }
    if (grid < 0) return;
    if (hipMemsetAsync((char*)d_ws + WS_BARW, 0, 16384, stream) != hipSuccess) { fprintf(stderr, "kernel_launch: memset failed\n"); return; }
    Params p{};
    for (int i = 0; i < 21; ++i) p.in[i] = (const float*)d_in[i];
    p.out = (float*)d_out; p.ws = (unsigned char*)d_ws;
#if MK_N_LAUNCHES == 1
    p.ph_lo = 0; p.ph_hi = 16;
    void* args[] = {&p};
    hipError_t e = hipLaunchCooperativeKernel((const void*)fwd_megakernel, dim3(grid), dim3(NTHR), args, LDS_BYTES, stream);
    if (e != hipSuccess) fprintf(stderr, "cooperative launch failed: %s (grid %d)\n", hipGetErrorString(e), grid);
#else
    for (int ph = 0; ph < 16; ++ph) { p.ph_lo = ph; p.ph_hi = ph + 1;
        hipLaunchKernelGGL(fwd_megakernel, dim3(grid), dim3(NTHR), LDS_BYTES, stream, p); }
#endif
}
```

```cpp
#include <hip/hip_runtime.h>
#include <hip/hip_cooperative_groups.h>
#include <cstdio>
#include <cstdint>
namespace cg = cooperative_groups;
namespace pg8 {
#define PG8_LAS __attribute__((address_space(3)))
typedef unsigned short bf16_t;
typedef short bf16x8 __attribute__((ext_vector_type(8)));
typedef float f32x4 __attribute__((ext_vector_type(4)));
typedef unsigned u32x4 __attribute__((ext_vector_type(4)));
constexpr int BM = 256, BK = 64, HALF = 128, HTB = HALF * BK * 2  , STAGE_BYTES = 8 * HTB, NXCD = 8, WGM = 8;

__host__ __device__ __forceinline__ int lds_byte(int r, int c) { const int st = (r >> 4) * 2 + (c >> 5), rr = r & 15, cc = c & 31, ob = rr * 64 + cc * 2; return st * 1024 + (ob ^ (((ob >> 9) & 1) << 5)); }
__host__ __device__ __forceinline__ void stage_rc(int b, int& R, int& C) { const int st = b / 1024, sb = b % 1024, swz = sb ^ (((sb >> 9) & 1) << 5); R = (st >> 1) * 16 + swz / 64; C = (st & 1) * 32 + (swz % 64) / 2; }
__host__ __device__ __forceinline__ int perm32(int rho) { const int n = rho >> 4, i = rho & 15; return 8 * (i >> 2) + 4 * n + (i & 3); }

struct Unit { int pm, pn, kh; };
struct Gemm { const bf16_t* A; const bf16_t* Bt; int M, N, K, lda; };

struct StaticOrder {
    int nM, nN, nwg, G, c;
    __host__ __device__ void init(int M, int N, int G_, int c_) { nM = M / BM; nN = N / BM; nwg = nM * nN; G = G_; c = c_; }
    __host__ __device__ bool next(int i, Unit& u) const {
        const long L = (long)i * G + c; if (L >= nwg) return false;
        int wgid = (int)L; { const int q = nwg / NXCD, r = nwg % NXCD, xcd = wgid % NXCD, off = wgid / NXCD; wgid = (xcd < r ? xcd * (q + 1) : r * (q + 1) + (xcd - r) * q) + off; }
        const int nig = WGM * nN, gid = wgid / nig, fm = gid * WGM, gsz = (nM - fm) < WGM ? (nM - fm) : WGM;
        u.pm = fm + ((wgid % nig) % gsz); u.pn = (wgid % nig) / gsz; u.kh = 0; return true;
    }
    __device__ __forceinline__ void a_ready(const Unit&) const {}
    __device__ __forceinline__ void done(const Unit&) const {}
};
__device__ __forceinline__ unsigned cvt_pk_bf16(float lo, float hi) { unsigned r; asm volatile("v_cvt_pk_bf16_f32 %0, %1, %2" : "=v"(r) : "v"(lo), "v"(hi)); return r; }
template <class Epi, class Sched, bool STAMP = false, bool ALIGN_EPI = false, bool SP2 = false>
__device__ __forceinline__ void gemm_phase(PG8_LAS unsigned char* lds, const Gemm g, const Sched& S, const Epi& E, unsigned long long* stamps) {
    int tid_ = threadIdx.x; asm volatile("" : "+v"(tid_)); const int tid = tid_, wid = __builtin_amdgcn_readfirstlane(tid >> 6), lane = tid & 63, wr = wid >> 2, wc = wid & 3, fr = lane & 15, fq = lane >> 4;
    const int K = g.K, nt = K / BK;
    int ts_lo = 0, ts_hi = 0, nts = 0; const unsigned long long rt_entry = STAMP ? (unsigned long long)wall_clock64() : 0ull;
#define PG8_STAMP() do { if (STAMP && wid == 0 && nts < 64) { const unsigned long long _c = (unsigned long long)clock64(); \
        ts_lo = (lane == nts) ? (int)(unsigned)_c : ts_lo; ts_hi = (lane == nts) ? (int)(unsigned)(_c >> 32) : ts_hi; ++nts; } } while (0)
    PG8_STAMP();
    unsigned voffA[2], voffB[2];
#pragma unroll
    for (int i = 0; i < 2; ++i) { int R, C; stage_rc(tid * 16 + i * 8192, R, C); const int Rb = Epi::PERM ? ((R & ~31) + perm32(R & 31)) : R;
        voffA[i] = (unsigned)(R * g.lda + C) * 2u; voffB[i] = (unsigned)(Rb * g.lda + C) * 2u; }
    const size_t kstep = (size_t)(BK * 2);
    const size_t hstep = (size_t)HALF * g.lda * 2; const size_t khstep = (size_t)K * 2;
    const size_t tstep = 2 * hstep;
    const unsigned ldsw = (unsigned)wid * 1024u;
    const int aoff = lds_byte(wr * 64 + fr, fq * 8), boff = lds_byte(wc * 32 + fr, fq * 8);
#define PG8_SA(b, h) (((b) * 2 + (h)) * HTB)
#define PG8_SB(b, h) ((4 + (b) * 2 + (h)) * HTB)
#define PG8_STAGE(bufoff, gbase, voff) do { _Pragma("unroll") for (int _i = 0; _i < 2; ++_i) \
        __builtin_amdgcn_global_load_lds((const unsigned*)((const char*)(gbase) + (voff)[_i]), (PG8_LAS unsigned*)(lds + (bufoff) + ldsw + _i * 8192), 16, 0, 0); } while (0)
#define PG8_LDA(dst, b, h) do { _Pragma("unroll") for (int m = 0; m < 4; ++m) _Pragma("unroll") for (int k = 0; k < 2; ++k) dst[m][k] = *(const PG8_LAS bf16x8*)(lds + PG8_SA(b, h) + aoff + m * 2048 + k * 1024); } while (0)
#define PG8_LDB(dst, b, h) do { _Pragma("unroll") for (int n = 0; n < 2; ++n) _Pragma("unroll") for (int k = 0; k < 2; ++k) dst[n][k] = *(const PG8_LAS bf16x8*)(lds + PG8_SB(b, h) + boff + n * 2048 + k * 1024); } while (0)
#define PG8_MMA(ai, bj, At, Bt) do { __builtin_amdgcn_s_setprio(1); _Pragma("unroll") for (int m = 0; m < 4; ++m) _Pragma("unroll") for (int n = 0; n < 2; ++n) _Pragma("unroll") for (int k = 0; k < 2; ++k) \
        acc[ai][bj][m][n] = __builtin_amdgcn_mfma_f32_16x16x32_bf16(Bt[n][k], At[m][k], acc[ai][bj][m][n], 0, 0, 0); __builtin_amdgcn_s_setprio(0); } while (0)
#define PG8_WAIT_V(n) asm volatile("s_waitcnt vmcnt(" #n ")" ::: "memory")
#define PG8_WAIT_L(n) asm volatile("s_waitcnt lgkmcnt(" #n ")" ::: "memory")
#define PG8_BAR __builtin_amdgcn_s_barrier()
#define PG8_SCHED __builtin_amdgcn_sched_barrier(0)
    Unit cur, nxt; int ui = 0;
    if (!S.next(0, cur)) return;
    f32x4 acc[2][2][4][2];
#pragma unroll
    for (int a = 0; a < 2; ++a)
#pragma unroll
        for (int b = 0; b < 2; ++b)
#pragma unroll
            for (int m = 0; m < 4; ++m)
#pragma unroll
                for (int n = 0; n < 2; ++n) acc[a][b][m][n] = (f32x4){0.f, 0.f, 0.f, 0.f};
    bf16x8 At[4][2], B0[2][2], B1[2][2];
    const char* cA = (const char*)g.A + (size_t)cur.pm * tstep + cur.kh * khstep; const char* cB = (const char*)g.Bt + (size_t)cur.pn * tstep + cur.kh * khstep;
    S.a_ready(cur);
    if constexpr (SP2) {
        PG8_STAGE(PG8_SB(0, 0), cB, voffB); PG8_STAGE(PG8_SB(0, 1), cB + hstep, voffB); PG8_STAGE(PG8_SA(0, 0), cA, voffA); PG8_STAGE(PG8_SA(0, 1), cA + hstep, voffA);
        if (wr == 1) PG8_BAR;
        PG8_WAIT_V(2); PG8_BAR;
        PG8_STAGE(PG8_SB(1, 0), cB + kstep, voffB); PG8_STAGE(PG8_SA(1, 0), cA + kstep, voffA); PG8_STAGE(PG8_SB(1, 1), cB + hstep + kstep, voffB);
        PG8_WAIT_V(6); PG8_BAR;
    } else {
    PG8_STAGE(PG8_SB(0, 0), cB, voffB); PG8_STAGE(PG8_SA(0, 0), cA, voffA); PG8_STAGE(PG8_SB(0, 1), cB + hstep, voffB); PG8_STAGE(PG8_SA(0, 1), cA + hstep, voffA);
    if (wr == 1) PG8_BAR;
    PG8_WAIT_V(4); PG8_BAR;
    PG8_STAGE(PG8_SB(1, 0), cB + kstep, voffB); PG8_STAGE(PG8_SA(1, 0), cA + kstep, voffA); PG8_STAGE(PG8_SB(1, 1), cB + hstep + kstep, voffB);
    PG8_WAIT_V(6); PG8_BAR;
    }
    PG8_STAMP();
    for (;;) {
        const bool has_next = S.next(ui + 1, nxt);
        const char* nA = has_next ? (const char*)g.A + (size_t)nxt.pm * tstep + nxt.kh * khstep : cA; const char* nB = has_next ? (const char*)g.Bt + (size_t)nxt.pn * tstep + nxt.kh * khstep : cB;
        for (int t = 0; t < nt; t += 2) {
            const bool last = (t == nt - 2);
            const char* a1 = cA + (size_t)(t + 1) * kstep;
            const char* a2 = last ? nA : cA + (size_t)(t + 2) * kstep; const char* b2 = last ? nB : cB + (size_t)(t + 2) * kstep;
            const char* a3 = a2 + kstep; const char* b3 = b2 + kstep;
            if (last && has_next) S.a_ready(nxt);
            if constexpr (SP2) {
            PG8_LDB(B0, 0, 0); PG8_LDB(B1, 0, 1); PG8_SCHED; PG8_LDA(At, 0, 0); PG8_STAGE(PG8_SA(1, 1), a1 + hstep, voffA);
            PG8_WAIT_V(8); PG8_WAIT_L(0); PG8_BAR; PG8_MMA(0, 0, At, B0); PG8_MMA(0, 1, At, B1); PG8_BAR; PG8_SCHED;
            PG8_LDA(At, 0, 1); PG8_STAGE(PG8_SB(0, 0), b2, voffB); PG8_STAGE(PG8_SB(0, 1), b2 + hstep, voffB); PG8_STAGE(PG8_SA(0, 0), a2, voffA);
            PG8_WAIT_V(8); PG8_WAIT_L(0); PG8_BAR; PG8_MMA(1, 0, At, B0); PG8_MMA(1, 1, At, B1); PG8_BAR; PG8_SCHED;
            PG8_LDB(B0, 1, 0); PG8_LDB(B1, 1, 1); PG8_SCHED; PG8_LDA(At, 1, 0); PG8_STAGE(PG8_SA(0, 1), a2 + hstep, voffA);
            PG8_WAIT_V(8); PG8_WAIT_L(0); PG8_BAR; PG8_MMA(0, 0, At, B0); PG8_MMA(0, 1, At, B1); PG8_BAR; PG8_SCHED;
            PG8_LDA(At, 1, 1); PG8_STAGE(PG8_SB(1, 0), b3, voffB); PG8_STAGE(PG8_SB(1, 1), b3 + hstep, voffB); PG8_STAGE(PG8_SA(1, 0), a3, voffA);
            PG8_WAIT_V(8); PG8_WAIT_L(0); PG8_BAR; PG8_MMA(1, 0, At, B0); PG8_MMA(1, 1, At, B1); PG8_BAR; PG8_SCHED;
            } else {
            PG8_LDB(B0, 0, 0); PG8_SCHED; PG8_LDA(At, 0, 0); PG8_STAGE(PG8_SA(1, 1), a1 + hstep, voffA);
            PG8_WAIT_L(8); PG8_BAR; PG8_WAIT_L(0); PG8_MMA(0, 0, At, B0); PG8_BAR; PG8_SCHED;
            PG8_LDB(B1, 0, 1); PG8_STAGE(PG8_SB(0, 0), b2, voffB);
            PG8_BAR; PG8_WAIT_L(0); PG8_MMA(0, 1, At, B1); PG8_BAR;
            PG8_LDA(At, 0, 1); PG8_STAGE(PG8_SA(0, 0), a2, voffA);
            PG8_BAR; PG8_WAIT_L(0); PG8_MMA(1, 0, At, B0); PG8_BAR; PG8_SCHED;
            PG8_STAGE(PG8_SB(0, 1), b2 + hstep, voffB);
            PG8_WAIT_V(6); PG8_BAR; PG8_MMA(1, 1, At, B1); PG8_BAR;
            PG8_LDB(B0, 1, 0); PG8_SCHED; PG8_LDA(At, 1, 0); PG8_STAGE(PG8_SA(0, 1), a2 + hstep, voffA);
            PG8_WAIT_L(8); PG8_BAR; PG8_WAIT_L(0); PG8_MMA(0, 0, At, B0); PG8_BAR; PG8_SCHED;
            PG8_LDB(B1, 1, 1); PG8_STAGE(PG8_SB(1, 0), b3, voffB);
            PG8_BAR; PG8_WAIT_L(0); PG8_MMA(0, 1, At, B1); PG8_BAR;
            PG8_LDA(At, 1, 1); PG8_STAGE(PG8_SA(1, 0), a3, voffA);
            PG8_BAR; PG8_WAIT_L(0); PG8_MMA(1, 0, At, B0); PG8_BAR; PG8_SCHED;
            PG8_STAGE(PG8_SB(1, 1), b3 + hstep, voffB);
            PG8_WAIT_V(6); PG8_BAR; PG8_MMA(1, 1, At, B1); PG8_BAR;
            }
        }
        PG8_STAMP();
        if constexpr (ALIGN_EPI) { if (wr == 0) PG8_BAR; }
        if constexpr (!Epi::AFTER_DRAIN) { E(acc, cur, wr, wc, fr, fq); S.done(cur); }
        PG8_STAMP();
        if (!has_next) break;
        if (!(Epi::CHAIN && cur.kh == 0))
#pragma unroll
        for (int a = 0; a < 2; ++a)
#pragma unroll
            for (int b = 0; b < 2; ++b)
#pragma unroll
                for (int m = 0; m < 4; ++m)
#pragma unroll
                    for (int n = 0; n < 2; ++n) acc[a][b][m][n] = (f32x4){0.f, 0.f, 0.f, 0.f};
        cur = nxt; cA = nA; cB = nB; ++ui;
        if constexpr (ALIGN_EPI) { if (wr == 1) PG8_BAR; }
    }
    PG8_WAIT_V(0);
    if constexpr (!ALIGN_EPI) { if (wr == 0) PG8_BAR; }
    PG8_BAR;
    if constexpr (Epi::AFTER_DRAIN) { E.fused(acc, cur, wr, wc, fr, fq, lds, wid, lane); S.done(cur); }
    PG8_STAMP();
    if (STAMP && wid == 0) { stamps[lane] = lane < nts ? (((unsigned long long)(unsigned)ts_hi << 32) | (unsigned)ts_lo) : 0ull;
        if (lane == 62) stamps[62] = rt_entry; if (lane == 63) stamps[63] = (unsigned long long)wall_clock64(); }
#undef PG8_STAMP
#undef PG8_SA
#undef PG8_SB
#undef PG8_STAGE
#undef PG8_LDA
#undef PG8_LDB
#undef PG8_MMA
#undef PG8_WAIT_V
#undef PG8_WAIT_L
#undef PG8_BAR
#undef PG8_SCHED
}
}
#ifndef GEMM_SP2
#define GEMM_SP2 true
#endif
#ifndef GEMM_ALIGN
#define GEMM_ALIGN true
#endif
#ifndef REP_DN
#define REP_DN 1
#endif
#ifndef REP_CONV
#define REP_CONV 1
#endif
#ifndef PG1_TILES
#define PG1_TILES 6
#endif
#ifndef REP_SCAN
#define REP_SCAN 1
#endif
#ifndef REP_TILES
#define REP_TILES 1
#endif
#ifndef REP_LNA
#define REP_LNA 1
#endif
#ifndef REP_GRAM
#define REP_GRAM 1
#endif
#ifndef REP_E
#define REP_E 1
#endif
#ifndef REP_SOLVE
#define REP_SOLVE 1
#endif

#define LAS __attribute__((address_space(3)))
typedef unsigned short bf16_t;
typedef short bf16x8 __attribute__((ext_vector_type(8)));
typedef float f32x4 __attribute__((ext_vector_type(4)));
typedef unsigned u32x4 __attribute__((ext_vector_type(4)));
typedef unsigned u32x2 __attribute__((ext_vector_type(2)));

constexpr int NTOK = 8192, DM = 2048, NCTX = 4096, NP = 11520, NTHR = 512;
constexpr int C_AVAL = 0, C_AGLU = 1024, C_AZ = 2048, C_Q = 3072, C_ZB = 6144, C_GA = 7168, C_GB = 9216, C_BA = 11264;
constexpr float EPS = 1e-6f;
constexpr int LDS_BYTES = 139264;
constexpr int LDS_TQ = LDS_BYTES - 8;
constexpr int LDS_BARST = LDS_BYTES - 16;
constexpr int XCD_BAR_BYTES = 3456 * 4;

constexpr size_t WS_WIN = 256;
constexpr size_t SZ_WIN1 = (size_t)NP * DM * 2;
constexpr size_t WS_WP2 = WS_WIN + 2 * SZ_WIN1;
constexpr size_t SZ_SQ = (size_t)DM * DM * 2;
constexpr size_t WS_WO = WS_WP2 + 2 * SZ_SQ;
constexpr size_t WS_MOD = WS_WO + 2 * SZ_SQ;
constexpr size_t WS_R1 = WS_MOD + 2 * 5 * 6144 * 4;
constexpr size_t WS_P = WS_R1 + (size_t)2 * NTOK * 1024 * 4;
constexpr size_t WS_BA = WS_P + (size_t)NTOK * NP * 2;
constexpr size_t WS_Y = WS_BA + (size_t)NTOK * 32 * 4;
constexpr size_t WS_U = WS_Y + (size_t)NTOK * 1024 * 4;
constexpr size_t WS_DN = WS_U + (size_t)NTOK * 2048 * 2;
constexpr int DN_NEGW = 0, DN_QDEC = 16384, DN_KDT = 32768, DN_QKM = 49152, DN_UT = 57344, DN_EGL = 90112, DN_REC = 90368;
constexpr size_t WS_X1 = WS_DN + (size_t)2048 * DN_REC;
constexpr size_t WS_END = WS_X1 + (size_t)NTOK * DM * 4;
constexpr size_t WS_BARW = WS_END;
constexpr size_t WS_TQ = WS_BARW + 15360;
constexpr size_t WS_END2 = WS_BARW + 16384;
static_assert(WS_END2 <= 740294656ull && XCD_BAR_BYTES <= 16384, "workspace");

__device__ __forceinline__ int opaque_tid() { int t = threadIdx.x; asm volatile("" : "+v"(t)); return t; }
struct Params { const float* in[21]; float* out; unsigned char* ws; int ph_lo, ph_hi; };
#define KA_ __attribute__((address_space(4)))
__device__ __forceinline__ const float* pin(const Params&, int k) { const KA_ char* ka = (const KA_ char*)__builtin_amdgcn_kernarg_segment_ptr(); return *(const float* const volatile KA_*)(ka + 8 * k); }
__device__ __forceinline__ unsigned char* pws(const Params&) { const KA_ char* ka = (const KA_ char*)__builtin_amdgcn_kernarg_segment_ptr(); return *(unsigned char* const volatile KA_*)(ka + 8 * 22); }
__device__ __forceinline__ float* pout(const Params&) { const KA_ char* ka = (const KA_ char*)__builtin_amdgcn_kernarg_segment_ptr(); return *(float* const volatile KA_*)(ka + 8 * 21); }

__device__ __forceinline__ float bf2f(unsigned short b) { return __uint_as_float(((unsigned)b) << 16); }
__device__ __forceinline__ unsigned f2bf(float f) { unsigned u = __float_as_uint(f); u += 0x7fffu + ((u >> 16) & 1u); return u >> 16; }
typedef float f32x2_t __attribute__((ext_vector_type(2)));
typedef __bf16 bf16x2_t __attribute__((ext_vector_type(2)));
__device__ __forceinline__ unsigned pk2(float lo, float hi) { const f32x2_t v = {lo, hi}; return __builtin_bit_cast(unsigned, __builtin_convertvector(v, bf16x2_t)); }
__device__ __forceinline__ float sigmoidf_(float x) { return __builtin_amdgcn_rcpf(1.0f + __expf(-x)); }
__device__ __forceinline__ float siluf_(float x) { return x * __builtin_amdgcn_rcpf(1.0f + __expf(-x)); }
__device__ __forceinline__ f32x4 bf4_to_f32(u32x2 w) { return (f32x4){__uint_as_float(w[0] << 16), __uint_as_float(w[0] & 0xffff0000u), __uint_as_float(w[1] << 16), __uint_as_float(w[1] & 0xffff0000u)}; }
__device__ __forceinline__ float wave_sum(float v) {
#pragma unroll
    for (int o = 32; o > 0; o >>= 1) v += __shfl_xor(v, o);
    return v;
}
__device__ __forceinline__ const float* xrow0(const Params& p, int tok) { return tok < NCTX ? pin(p, 0) + (size_t)tok * DM : pin(p, 1) + (size_t)(tok - NCTX) * DM; }
__device__ __forceinline__ int cvec_of(int tok) { return tok < NCTX ? 0 : 1 + ((tok - NCTX) >> 10); }

__device__ __forceinline__ void tr_tile(const float* __restrict__ src, int ldsrc, int k0, int n0, int mode, bf16_t* __restrict__ dst, int lddst, int koff, float* lds) {
    const int tid = opaque_tid();
    { const int c4 = tid & 31, rr = tid >> 5; const int np = n0 + c4 * 4; int sc = np;
        if (mode == 1) {
            if (np < 2048) { const int T = np >> 8, w = np & 255; sc = w < 128 ? 128 * T + w : 1024 + 128 * T + (w - 128); }
            else if (np < 7168) sc = np; else if (np < 11264) { const int off = np - 7168, T = off >> 8, w = off & 255; sc = w < 128 ? 7200 + 128 * T + w : 9248 + 128 * T + (w - 128); }
            else sc = np < 11296 ? np - 11264 + 7168 : -1; }
#pragma unroll
        for (int i = 0; i < 8; ++i) { const int r = rr + 16 * i;
            *(f32x4*)(lds + r * 132 + c4 * 4) = sc >= 0 ? __builtin_nontemporal_load((const f32x4*)(src + (size_t)(k0 + r) * ldsrc + sc)) : (f32x4){0.f, 0.f, 0.f, 0.f}; } }
    __syncthreads();
#pragma unroll
    for (int i = 0; i < 4; ++i) { const int u = tid + 512 * i, nn = u & 127, kg = u >> 7;
        u32x4 o;
#pragma unroll
        for (int j = 0; j < 4; ++j) o[j] = pk2(lds[(kg * 8 + 2 * j) * 132 + nn], lds[(kg * 8 + 2 * j + 1) * 132 + nn]);
        *(u32x4*)(dst + (size_t)(n0 + nn) * lddst + koff + k0 + kg * 8) = o; }
    __syncthreads();
}
__device__ __forceinline__ void weight_tile(const Params& p, int it, float* lds) {
    unsigned char* ws = pws(p);
    const int l = it / 1952; int r = it % 1952;
    const float* src; int ldsrc, kt, ntile, mode = 0, koff = 0; bf16_t* dst;
    if (r < 1440) { kt = r / 90; ntile = r % 90; src = pin(p, 8) + (size_t)l * 2048 * 11296; ldsrc = 11296; mode = 1; dst = (bf16_t*)(ws + WS_WIN + l * SZ_WIN1); }
    else if (r < 1440 + 256) { r -= 1440; const int which = r / 128; r %= 128; kt = r / 16; ntile = r % 16;
        src = pin(p, which ? 18 : 13) + (size_t)l * 1024 * 2048; ldsrc = 2048; dst = (bf16_t*)(ws + WS_WP2 + l * SZ_SQ); koff = which * 1024; }
    else { r -= 1696; kt = r / 16; ntile = r % 16; src = pin(p, 19) + (size_t)l * 2048 * 2048; ldsrc = 2048; dst = (bf16_t*)(ws + WS_WO + l * SZ_SQ); }
    tr_tile(src, ldsrc, kt * 128, ntile * 128, mode, dst, 2048, koff, lds);
}

__device__ __forceinline__ void drain_tiles(const Params& p, int max_tiles, unsigned char* lds) {
    volatile LAS unsigned* slot = (volatile LAS unsigned*)((LAS unsigned char*)lds + LDS_TQ);
    __syncthreads();
    for (int n = 0; n < max_tiles; ++n) {
        if (threadIdx.x == 0) *slot = __hip_atomic_fetch_add((unsigned*)(pws(p) + WS_TQ), 1u, __ATOMIC_RELAXED, __HIP_MEMORY_SCOPE_AGENT);
        __syncthreads();
        const unsigned it = *slot;
        if (it >= 2u * 1952u - 1440u) break;
        weight_tile(p, 1440 + (int)it, (float*)lds);
    }
}
__device__ __forceinline__ void p0_prologue(const Params& p, float* lds) {
    const int tid = opaque_tid(), G = gridDim.x, b = blockIdx.x;
    unsigned char* ws = pws(p);
    for (int it = b; it < 1440; it += G) weight_tile(p, it, lds);
    float* sc = lds;
    float* red = lds + 5 * 2048;
    __syncthreads();
    for (int i = tid; i < 5 * 2048; i += NTHR) { const int v = i >> 11, k = i & 2047; const float x = v == 0 ? pin(p, 4)[k] : pin(p, 3)[(v - 1) * 2048 + k]; sc[i] = siluf_(x); }
    __syncthreads();
    for (int it = b; it < 192; it += G) {
        const int l = it / 96, col0 = (it % 96) * 64;
        const int kq = tid >> 4, c4 = tid & 15;
        f32x4 acc[5];
#pragma unroll
        for (int v = 0; v < 5; ++v) acc[v] = (f32x4){0.f, 0.f, 0.f, 0.f};
        const float* wp = pin(p, 5) + (size_t)l * 2048 * 6144 + col0 + c4 * 4;
#pragma unroll 8
        for (int i = 0; i < 64; ++i) { const int k = kq + 32 * i; const f32x4 w = __builtin_nontemporal_load((const f32x4*)(wp + (size_t)k * 6144));
#pragma unroll
            for (int v = 0; v < 5; ++v) acc[v] += w * sc[v * 2048 + k]; }
#pragma unroll
        for (int v = 0; v < 5; ++v) *(f32x4*)(red + (kq * 5 + v) * 64 + c4 * 4) = acc[v];
        __syncthreads();
        if (tid < 320) { const int v = tid >> 6, c = tid & 63; float s = 0.f;
            for (int q = 0; q < 32; ++q) s += red[(q * 5 + v) * 64 + c];
            ((float*)(ws + WS_MOD))[(size_t)(l * 5 + v) * 6144 + col0 + c] = s + pin(p, 6)[l * 6144 + col0 + c]; }
        __syncthreads();
    }
}

__device__ __forceinline__ void pn_norm(const Params& p, int l) {
    const int tid = opaque_tid(), lane = tid & 63, wid = tid >> 6;
    bf16_t* XN = (bf16_t*)(pws(p) + WS_R1);
    const float* MOD = (const float*)(pws(p) + WS_MOD);
    const float* ng = pin(p, 7) + l * DM;
    for (int tok = blockIdx.x * 8 + wid; tok < NTOK; tok += gridDim.x * 8) {
        const float* xr = xrow0(p, tok); const bf16_t* xb = (const bf16_t*)(pws(p) + WS_X1) + (size_t)tok * DM;
        f32x4 v[8]; float ss = 0.f;
#pragma unroll
        for (int i = 0; i < 8; ++i) { v[i] = l == 0 ? *(const f32x4*)(xr + (lane + 64 * i) * 4) : bf4_to_f32(*(const u32x2*)(xb + (lane + 64 * i) * 4)); ss += v[i][0] * v[i][0] + v[i][1] * v[i][1] + v[i][2] * v[i][2] + v[i][3] * v[i][3]; }
        ss = wave_sum(ss);
        const float rstd = rsqrtf(ss * (1.0f / DM) + EPS);
        const float* md = MOD + (size_t)(l * 5 + cvec_of(tok)) * 6144;
#pragma unroll
        for (int i = 0; i < 8; ++i) { const int c = (lane + 64 * i) * 4;
            const f32x4 g = *(const f32x4*)(ng + c), sh = *(const f32x4*)(md + c), scl = *(const f32x4*)(md + 2048 + c);
            const f32x4 h = (v[i] * rstd * g) * (scl + 1.0f) + sh;
            u32x2 o; o[0] = pk2(h[0], h[1]); o[1] = pk2(h[2], h[3]);
            *(u32x2*)(XN + (size_t)tok * DM + c) = o; }
    }
}
__device__ __forceinline__ void pf_final(const Params& p) {
    const int tid = opaque_tid(), lane = tid & 63, wid = tid >> 6;
    const bf16_t* X2 = (const bf16_t*)(pws(p) + WS_P);
    const float* fg = pin(p, 20);
    for (int tok = blockIdx.x * 8 + wid; tok < NTOK; tok += gridDim.x * 8) {
        const bf16_t* xr = X2 + (size_t)tok * DM;
        f32x4 v[8]; float ss = 0.f;
#pragma unroll
        for (int i = 0; i < 8; ++i) { v[i] = bf4_to_f32(*(const u32x2*)(xr + (lane + 64 * i) * 4)); ss += v[i][0] * v[i][0] + v[i][1] * v[i][1] + v[i][2] * v[i][2] + v[i][3] * v[i][3]; }
        ss = wave_sum(ss);
        const float rstd = rsqrtf(ss * (1.0f / DM) + EPS);
#pragma unroll
        for (int i = 0; i < 8; ++i) { const int c = (lane + 64 * i) * 4; const f32x4 g = *(const f32x4*)(fg + c);
            *(f32x4*)(pout(p) + (size_t)tok * DM + c) = v[i] * rstd * g; }
    }
}

struct ChainOrder : pg8::StaticOrder {
    __device__ bool next(int i, pg8::Unit& u) const { const bool ok = pg8::StaticOrder::next(i >> 1, u); u.kh = i & 1; return ok; }
};
struct EpiP {
    static constexpr bool PERM = true, AFTER_DRAIN = false, CHAIN = false;
    bf16_t* P; float* BA;
    __device__ __forceinline__ void operator()(f32x4 (&acc)[2][2][4][2], const pg8::Unit& u, int wr, int wc, int fr, int fq) const {
        const int row0 = u.pm * 256 + wr * 64 + fr, col0 = u.pn * 256 + wc * 32 + 8 * fq;
#pragma unroll
        for (int ai = 0; ai < 2; ++ai)
#pragma unroll
            for (int m = 0; m < 4; ++m) { const int row = row0 + ai * 128 + m * 16; bf16_t* rowp = P + (size_t)row * NP + col0;
                if (u.pn < 8) {
                    f32x4 G[2];
#pragma unroll
                    for (int n = 0; n < 2; ++n)
#pragma unroll
                        for (int e = 0; e < 4; ++e) G[n][e] = acc[ai][0][m][n][e] * sigmoidf_(acc[ai][1][m][n][e]);
                    u32x4 o; o[0] = pk2(G[0][0], G[0][1]); o[1] = pk2(G[0][2], G[0][3]); o[2] = pk2(G[1][0], G[1][1]); o[3] = pk2(G[1][2], G[1][3]);
                    *(u32x4*)rowp = o;
                } else if (u.pn >= 28 && u.pn < 44) {
                    f32x4 R[2], Sg[2];
#pragma unroll
                    for (int n = 0; n < 2; ++n)
#pragma unroll
                        for (int e = 0; e < 4; ++e) { const float ea = __expf(-acc[ai][0][m][n][e]), eb = __expf(-acc[ai][1][m][n][e]);
                            R[n][e] = (1.0f + eb) * __builtin_amdgcn_rcpf(1.0f + ea); Sg[n][e] = __builtin_amdgcn_rcpf(1.0f + eb); }
                    u32x4 o; o[0] = pk2(R[0][0], R[0][1]); o[1] = pk2(R[0][2], R[0][3]); o[2] = pk2(R[1][0], R[1][1]); o[3] = pk2(R[1][2], R[1][3]);
                    *(u32x4*)rowp = o;
                    o[0] = pk2(Sg[0][0], Sg[0][1]); o[1] = pk2(Sg[0][2], Sg[0][3]); o[2] = pk2(Sg[1][0], Sg[1][1]); o[3] = pk2(Sg[1][2], Sg[1][3]);
                    *(u32x4*)(rowp + 128) = o;
                } else
#pragma unroll
                for (int bj = 0; bj < 2; ++bj) { const f32x4 v0 = acc[ai][bj][m][0], v1 = acc[ai][bj][m][1];
                    u32x4 o; o[0] = pg8::cvt_pk_bf16(v0[0], v0[1]); o[1] = pg8::cvt_pk_bf16(v0[2], v0[3]); o[2] = pg8::cvt_pk_bf16(v1[0], v1[1]); o[3] = pg8::cvt_pk_bf16(v1[2], v1[3]);
                    *(u32x4*)(rowp + bj * 128) = o; }
                if (u.pn == 44 && wc == 0) { *(f32x4*)(BA + (size_t)row * 32 + 8 * fq) = acc[ai][0][m][0]; *(f32x4*)(BA + (size_t)row * 32 + 8 * fq + 4) = acc[ai][0][m][1]; }
            }
    }
};
struct EpiMG {
    static constexpr bool PERM = true, AFTER_DRAIN = false, CHAIN = true;
    const bf16_t* P; bf16_t* MG;
    __device__ __forceinline__ void operator()(f32x4 (&acc)[2][2][4][2], const pg8::Unit& u, int wr, int wc, int fr, int fq) const {
        const int row0 = u.pm * 256 + wr * 64 + fr, w0 = wc * 32 + 8 * fq, col0 = u.pn * 256 + w0;
        const int goff = u.kh == 0 ? 0 : 128;
#pragma unroll
        for (int ai = 0; ai < 2; ++ai) { u32x4 gv[4][2];
#pragma unroll
            for (int m = 0; m < 4; ++m) { const bf16_t* rowp = P + (size_t)(row0 + ai * 128 + m * 16) * NP + C_GA + w0 + goff;
#pragma unroll
                for (int bj = 0; bj < 2; ++bj) gv[m][bj] = *(const u32x4*)(rowp + (2 * u.pn + bj) * 256); }
#pragma unroll
            for (int m = 0; m < 4; ++m) { const int row = row0 + ai * 128 + m * 16;
#pragma unroll
                for (int bj = 0; bj < 2; ++bj) { float o[8];
#pragma unroll
                    for (int e = 0; e < 8; ++e) { const unsigned wv = gv[m][bj][e >> 1]; const float gvv = __uint_as_float((e & 1) ? (wv & 0xffff0000u) : (wv << 16));
                        o[e] = acc[ai][bj][m][e >> 2][e & 3] * gvv; }
                    if (u.kh == 0) {
#pragma unroll
                        for (int e = 0; e < 8; ++e) acc[ai][bj][m][e >> 2][e & 3] = o[e];
                    } else { u32x4 ov; ov[0] = pk2(o[0], o[1]); ov[1] = pk2(o[2], o[3]); ov[2] = pk2(o[4], o[5]); ov[3] = pk2(o[6], o[7]);
                        *(u32x4*)(MG + (size_t)row * DM + col0 + bj * 128) = ov; } } }
            __builtin_amdgcn_sched_barrier(0); }
    }
};
struct EpiX {
    static constexpr bool PERM = false, AFTER_DRAIN = false, CHAIN = false;
    const float* x0a; const float* x0b; const bf16_t* x1; const float* gate; bf16_t* out;
    __device__ __forceinline__ void operator()(f32x4 (&acc)[2][2][4][2], const pg8::Unit& u, int wr, int wc, int fr, int fq) const {
        const int row0 = u.pm * 256 + wr * 64 + fr, col0 = u.pn * 256 + wc * 32 + 4 * fq;
#pragma unroll
        for (int ai = 0; ai < 2; ++ai)
#pragma unroll
            for (int m = 0; m < 4; ++m) { const int row = row0 + ai * 128 + m * 16;
                const float* xr = row < NCTX ? x0a + (size_t)row * DM : x0b + (size_t)(row - NCTX) * DM;
                const float* gr = gate + (size_t)cvec_of(row) * 6144;
#pragma unroll
                for (int bj = 0; bj < 2; ++bj)
#pragma unroll
                    for (int n = 0; n < 2; ++n) { const int col = col0 + bj * 128 + n * 16;
                        const f32x4 xv = x1 ? bf4_to_f32(*(const u32x2*)(x1 + (size_t)row * DM + col)) : *(const f32x4*)(xr + col), gv = *(const f32x4*)(gr + col);
                        const f32x4 r4 = xv + gv * acc[ai][bj][m][n];
                        u32x2 o2; o2[0] = pk2(r4[0], r4[1]); o2[1] = pk2(r4[2], r4[3]); *(u32x2*)(out + (size_t)row * DM + col) = o2; }
            }
    }
};

template <int T>
__device__ __forceinline__ void conv_line(const bf16_t* __restrict__ P, bf16_t* __restrict__ Y, int base, int stride, int L, int p0, int ch, const float* __restrict__ w, const float* __restrict__ cb) {
    const int ucol = (ch >> 7) * 256 + (ch & 127);
    f32x2_t ua[T + 30];
#pragma unroll
    for (int i = 0; i < T + 30; ++i) { const int pos = p0 - 15 + i; f32x2_t v = {0.f, 0.f};
        if (pos >= 0 && pos < L) { const unsigned a = *(const unsigned*)(P + (size_t)(base + pos * stride) * NP + ucol);
            v[0] = __uint_as_float(a << 16); v[1] = __uint_as_float(a & 0xffff0000u); }
        ua[i] = v; }
    f32x2_t wk[31];
#pragma unroll
    for (int k = 0; k < 31; ++k) wk[k] = *(const f32x2_t*)(w + k * 1024 + ch);
    const f32x2_t bias = *(const f32x2_t*)(cb + ch);
#pragma unroll
    for (int j = 0; j < T; ++j) { f32x2_t a = bias;
#pragma unroll
        for (int k = 0; k < 31; ++k) a += wk[k] * ua[j + k];
        *(unsigned*)(Y + (size_t)(base + (p0 + j) * stride) * 1024 + ch) = pk2(a[0], a[1]); }
}

__device__ __forceinline__ void split8(const float* p, bf16x8& hi, bf16x8& lo) {
    const f32x4 a = *(const f32x4*)p, b2 = *(const f32x4*)(p + 4);
    u32x4 h, l2;
    h[0] = pk2(a[0], a[1]); h[1] = pk2(a[2], a[3]); h[2] = pk2(b2[0], b2[1]); h[3] = pk2(b2[2], b2[3]);
    l2[0] = pk2(a[0] - __uint_as_float(h[0] << 16), a[1] - __uint_as_float(h[0] & 0xffff0000u));
    l2[1] = pk2(a[2] - __uint_as_float(h[1] << 16), a[3] - __uint_as_float(h[1] & 0xffff0000u));
    l2[2] = pk2(b2[0] - __uint_as_float(h[2] << 16), b2[1] - __uint_as_float(h[2] & 0xffff0000u));
    l2[3] = pk2(b2[2] - __uint_as_float(h[3] << 16), b2[3] - __uint_as_float(h[3] & 0xffff0000u));
    hi = __builtin_bit_cast(bf16x8, h); lo = __builtin_bit_cast(bf16x8, l2);
}
__device__ __forceinline__ void dn_precompute(const Params& p, int l, int gc, int h, float* lds) {
    const int tid = opaque_tid(), lane = tid & 63, wid = tid >> 6;
    float* qs = lds;
    float* ks = lds + 8448;
    float* vs = lds + 2 * 8448;
    float* Gm = lds + 3 * 8448;
    float* QKm = Gm + 4160;
    float* betaS = QKm + 4160;
    float* gcS = betaS + 128;
    float* wscS = gcS + 128;
    const bf16_t* P = (const bf16_t*)(pws(p) + WS_P);
    const float* BA = (const float*)(pws(p) + WS_BA);
    int n, nc; if (gc < 64) { n = gc & 3; nc = 4; } else { n = (gc - 64) & 15; nc = 16; }
    const int tok0 = gc * 64;
    const float* cw = pin(p, 14) + (size_t)l * 3 * 3072;
    if (tid < 384) { const int cg = tid % 48, run = tid / 48, which = cg >> 4, d0 = (cg & 15) * 8;
        const int wch = which * 1024 + h * 128 + d0;
        const bf16_t* pc = P + (long)(tok0 + run * 8 - 1) * NP + C_Q + wch;
        u32x4 rows[10];
#pragma unroll
        for (int r = 0; r < 10; ++r) { const int t = run * 8 - 1 + r; const bool valid = (t >= 0 || n > 0) && (t < 64 || n < nc - 1);
            rows[r] = valid ? *(const u32x4*)(pc + (long)r * NP) : (u32x4){0u, 0u, 0u, 0u}; }
        f32x4 w[3][2];
#pragma unroll
        for (int j = 0; j < 3; ++j) { w[j][0] = *(const f32x4*)(cw + j * 3072 + wch); w[j][1] = *(const f32x4*)(cw + j * 3072 + wch + 4); }
        float* dst = (which == 0 ? qs : (which == 1 ? ks : vs)) + d0;
#pragma unroll
        for (int o = 0; o < 8; ++o) { f32x4 r2[2];
#pragma unroll
            for (int e = 0; e < 8; ++e) { const unsigned a = rows[o][e >> 1], bq = rows[o + 1][e >> 1], cq = rows[o + 2][e >> 1];
                const float xm = __uint_as_float((e & 1) ? (a & 0xffff0000u) : (a << 16)), x0 = __uint_as_float((e & 1) ? (bq & 0xffff0000u) : (bq << 16)), xp = __uint_as_float((e & 1) ? (cq & 0xffff0000u) : (cq << 16));
                r2[e >> 2][e & 3] = siluf_(w[0][e >> 2][e & 3] * xm + w[1][e >> 2][e & 3] * x0 + w[2][e >> 2][e & 3] * xp); }
            *(f32x4*)(dst + (run * 8 + o) * 132) = r2[0]; *(f32x4*)(dst + (run * 8 + o) * 132 + 4) = r2[1]; }
    }
    if (tid < 128) { const int dir = tid >> 6, i = tid & 63, tl = dir ? 63 - i : i;
        const float* ba = BA + (size_t)(tok0 + tl) * 32;
        const float bl = ba[dir * 8 + h], al = ba[16 + dir * 8 + h];
        const float xx = al + pin(p, 16)[(l * 2 + dir) * 8 + h];
        const float sp = xx > 20.f ? xx : log1pf(__expf(xx));
        float g = -__expf(pin(p, 15)[(l * 2 + dir) * 8 + h]) * sp;
#pragma unroll
        for (int o = 1; o < 64; o <<= 1) { const float t2 = __shfl_up(g, o); if (i >= o) g += t2; }
        const float bt = sigmoidf_(bl); betaS[dir * 64 + i] = bt; gcS[dir * 64 + i] = g; wscS[dir * 64 + i] = bt * __expf(g); }
    __syncthreads();
    { float a[16], b2[16], ss[16];
#pragma unroll
        for (int k = 0; k < 16; ++k) { const int r = wid + 8 * k; const float* row = (r < 64 ? qs + r * 132 : ks + (r - 64) * 132); a[k] = row[lane]; b2[k] = row[lane + 64]; ss[k] = a[k] * a[k] + b2[k] * b2[k]; }
#pragma unroll
        for (int o = 32; o > 0; o >>= 1) {
#pragma unroll
            for (int k = 0; k < 16; ++k) ss[k] += __shfl_xor(ss[k], o); }
#pragma unroll
        for (int k = 0; k < 16; ++k) { const int r = wid + 8 * k; float* row = (r < 64 ? qs + r * 132 : ks + (r - 64) * 132);
            const float sc = rsqrtf(ss[k] + EPS) * (r < 64 ? 0.08838834764831845f : 1.0f); row[lane] = a[k] * sc; row[lane + 64] = b2[k] * sc; } }
    __syncthreads();
    for (int rg = 0; rg < REP_GRAM; ++rg) { const int mat = wid >> 2, ti = wid & 3, r = lane & 15, q4 = lane >> 4;
        const float* Ar = mat ? qs : ks;
        bf16x8 Ahi[4], Alo[4];
#pragma unroll
        for (int k4 = 0; k4 < 4; ++k4) split8(Ar + (16 * ti + r) * 132 + 32 * k4 + 8 * q4, Ahi[k4], Alo[k4]);
        float* M = mat ? QKm : Gm;
#pragma unroll
        for (int tj = 0; tj < 4; ++tj) { f32x4 acc = (f32x4){0.f, 0.f, 0.f, 0.f};
#pragma unroll
            for (int k4 = 0; k4 < 4; ++k4) { bf16x8 Bhi, Blo; split8(ks + (16 * tj + r) * 132 + 32 * k4 + 8 * q4, Bhi, Blo);
                acc = __builtin_amdgcn_mfma_f32_16x16x32_bf16(Ahi[k4], Bhi, acc, 0, 0, 0);
                acc = __builtin_amdgcn_mfma_f32_16x16x32_bf16(Ahi[k4], Blo, acc, 0, 0, 0);
                acc = __builtin_amdgcn_mfma_f32_16x16x32_bf16(Alo[k4], Bhi, acc, 0, 0, 0); }
#pragma unroll
            for (int j = 0; j < 4; ++j) M[(16 * ti + 4 * q4 + j) * 65 + 16 * tj + r] = acc[j]; } }
    __syncthreads();
    const int dir = tid >> 8, tl = tid & 255;
    unsigned char* rec = pws(p) + WS_DN + (size_t)((gc * 8 + h) * 2 + dir) * DN_REC;
    const float* gcd = gcS + dir * 64; const float* btd = betaS + dir * 64;
    const float gl = gcd[63];
    { bf16_t* qd = (bf16_t*)(rec + DN_QDEC);
        for (int e = tl; e < 64 * 64; e += 256) { const int i = e >> 6, d2 = (e & 63) * 2; const int t = dir ? 63 - i : i; const float eg = __expf(gcd[i]);
            *(unsigned*)(qd + i * 128 + d2) = pk2(qs[t * 132 + d2] * eg, qs[t * 132 + d2 + 1] * eg); } }
    __syncthreads();
    float* Am = qs + dir * 4096;
    for (int e = tl; e < 4096; e += 256) { const int j = e >> 6, i = e & 63; const int ti = dir ? 63 - i : i, tj = dir ? 63 - j : j;
        Am[e] = j < i ? btd[i] * Gm[ti * 65 + tj] * __expf(gcd[i] - gcd[j]) : 0.f; }
    __syncthreads();
    if (tl >= 64) { const int t2 = tl - 64;
        bf16_t* kd = (bf16_t*)(rec + DN_KDT);
        for (int e = t2; e < 128 * 32; e += 192) { const int dk = e >> 5, j2 = (e & 31) * 2; const int t0 = dir ? 63 - j2 : j2, t1 = dir ? 62 - j2 : j2 + 1;
            *(unsigned*)(kd + dk * 64 + j2) = pk2(ks[t0 * 132 + dk] * __expf(gl - gcd[j2]), ks[t1 * 132 + dk] * __expf(gl - gcd[j2 + 1])); }
        bf16_t* qk = (bf16_t*)(rec + DN_QKM);
        for (int e = t2; e < 64 * 32; e += 192) { const int i = e >> 5, j2 = (e & 31) * 2; const int ti = dir ? 63 - i : i, t0 = dir ? 63 - j2 : j2, t1 = dir ? 62 - j2 : j2 + 1;
            const float v0 = j2 <= i ? QKm[ti * 65 + t0] * __expf(gcd[i] - gcd[j2]) : 0.f;
            const float v1 = j2 + 1 <= i ? QKm[ti * 65 + t1] * __expf(gcd[i] - gcd[j2 + 1]) : 0.f;
            *(unsigned*)(qk + i * 64 + j2) = pk2(v0, v1); }
        if (t2 == 0) *(float*)(rec + DN_EGL) = __expf(gl);
    }
    float* Tm = Am;
    if (tl < 64) { const int c = tl;
        f32x2_t U2[32];
#pragma unroll
        for (int i = 0; i < 64; ++i) U2[i >> 1][i & 1] = (i == c) ? 1.f : 0.f;
        f32x4 av[2][16];
#pragma unroll
        for (int i4 = 0; i4 < 16; ++i4) av[0][i4] = *(const f32x4*)(Am + i4 * 4);
        __builtin_amdgcn_sched_barrier(0);
#pragma unroll
        for (int j = 0; j < 63; ++j) {
            if (j + 1 < 63) {
#pragma unroll
                for (int i4 = (j + 2) / 4; i4 < 16; ++i4) av[(j + 1) & 1][i4] = *(const f32x4*)(Am + (j + 1) * 64 + i4 * 4); }
            const float uj = U2[j >> 1][j & 1]; const f32x2_t ujj = {uj, uj};
#pragma unroll
            for (int pr = (j + 1) / 2; pr < 32; ++pr) { const f32x4 a4 = av[j & 1][pr >> 1]; const f32x2_t a2 = (pr & 1) ? (f32x2_t){a4[2], a4[3]} : (f32x2_t){a4[0], a4[1]};
                if (2 * pr > j) U2[pr] = U2[pr] - a2 * ujj; else U2[pr][1] -= a2[1] * uj; }
            __builtin_amdgcn_sched_barrier(0); }
#pragma unroll
        for (int i = 0; i < 64; ++i) Tm[i * 64 + c] = U2[i >> 1][i & 1];
    }
    __syncthreads();
    { const int wq = wid & 3, r = lane & 15, kg = lane >> 4; const bool isu = wq < 2;
        int rstep = dir ? -132 : 132; asm volatile("" : "+v"(rstep));
        const float* src = (isu ? vs + wq * 64 : ks + (wq - 2) * 64) + (dir ? 63 * 132 : 0) + r;
        const float* scl = isu ? btd : wscS + dir * 64;
        bf16x8 Ahi[4][2], Alo[4][2];
#pragma unroll
        for (int m = 0; m < 4; ++m)
#pragma unroll
            for (int kx = 0; kx < 2; ++kx) split8(Tm + (16 * m + r) * 64 + 32 * kx + 8 * kg, Ahi[m][kx], Alo[m][kx]);
        float* ut = (float*)(rec + DN_UT); bf16_t* nw = (bf16_t*)(rec + DN_NEGW);
#pragma unroll
        for (int nt = 0; nt < 4; ++nt) { bf16x8 Bf[2];
#pragma unroll
            for (int kx = 0; kx < 2; ++kx) { const int j0 = 32 * kx + 8 * kg; const f32x4 s0 = *(const f32x4*)(scl + j0), s1 = *(const f32x4*)(scl + j0 + 4);
                u32x4 o;
#pragma unroll
                for (int e2 = 0; e2 < 4; ++e2) { const float x0 = src[(j0 + 2 * e2) * rstep + 16 * nt] * (e2 < 2 ? s0[2 * e2] : s1[2 * e2 - 4]), x1 = src[(j0 + 2 * e2 + 1) * rstep + 16 * nt] * (e2 < 2 ? s0[2 * e2 + 1] : s1[2 * e2 - 3]);
                    o[e2] = pk2(x0, x1); }
                Bf[kx] = __builtin_bit_cast(bf16x8, o); }
#pragma unroll
            for (int m = 0; m < 4; ++m) { f32x4 acc = (f32x4){0.f, 0.f, 0.f, 0.f};
#pragma unroll
                for (int kx = 0; kx < 2; ++kx) { acc = __builtin_amdgcn_mfma_f32_16x16x32_bf16(Ahi[m][kx], Bf[kx], acc, 0, 0, 0); acc = __builtin_amdgcn_mfma_f32_16x16x32_bf16(Alo[m][kx], Bf[kx], acc, 0, 0, 0); }
                const int i0 = 16 * m + 4 * kg, cc = 16 * nt + r;
                if (isu) { u32x2 o2; o2[0] = pk2(acc[0], acc[1]); o2[1] = pk2(acc[2], acc[3]); *(u32x2*)((bf16_t*)ut + (wq * 64 + cc) * 64 + i0) = o2; }
                else {
#pragma unroll
                    for (int jj = 0; jj < 4; ++jj) nw[(i0 + jj) * 128 + (wq - 2) * 64 + cc] = (bf16_t)f2bf(-acc[jj]); } }
        }
    }
    __syncthreads();
}

__device__ __forceinline__ void pc_phase(const Params& p, int l, float* lds) {
    const int tid = opaque_tid();
    const bf16_t* P = (const bf16_t*)(pws(p) + WS_P);
    bf16_t* Y = (bf16_t*)(pws(p) + WS_Y);
    const float* cw = pin(p, 9) + (size_t)l * 31 * 1024;
    const float* cb = pin(p, 10) + l * 1024;
    const bool g256 = (int)gridDim.x == 256;
    for (int kk = 0;; ++kk) {
        int it = (int)blockIdx.x + kk * (int)gridDim.x;
        if (g256 && kk == 5) it = (int)blockIdx.x >= 192 ? 1280 + (int)blockIdx.x - 192 : (1 << 30);
        if (it >= 1024 + 320) break;
#ifndef NO_DN
        if (it < 1024) { for (int rd = 0; rd < REP_DN; ++rd) dn_precompute(p, l, it >> 3, it & 7, lds); continue; }
#endif
#ifndef NO_CONV
        for (int rcv = 0; rcv < REP_CONV; ++rcv) {
        int r = it - 1024;
        int tl = opaque_tid();
        if (r < 192) { int base, L, p0, ch;
            if (r < 128) { const int tile = r & 7, bb = r >> 3; ch = 2 * tl; base = bb * 256; L = 256; p0 = tile * 32; }
            else { r -= 128; const int row = r & 15, bb = r >> 4; ch = 2 * (tl & 255); base = NCTX + bb * 1024 + row * 64; L = 64; p0 = (tl >> 8) * 32; }
            int st = 1; asm volatile("" : "+s"(st));
            conv_line<32>(P, Y, base, st, L, p0, ch, cw, cb);
        } else {
            r -= 192; const int col = 2 * (r & 31) + (tl >> 8), bb = r >> 5; const int ch = 512 + 2 * (tl & 255);
            int st = 64; asm volatile("" : "+s"(st));
            conv_line<16>(P, Y, NCTX + bb * 1024 + col, st, 16, 0, ch, cw, cb);
        }
        }
#endif
    }
}

__device__ __forceinline__ bf16x8 pack8(const f32x4& a, const f32x4& b) {
    u32x4 r; r[0] = pk2(a[0], a[1]); r[1] = pk2(a[2], a[3]); r[2] = pk2(b[0], b[1]); r[3] = pk2(b[2], b[3]);
    return __builtin_bit_cast(bf16x8, r);
}
__device__ __forceinline__ bf16x8 lds_afrag(const unsigned char* base) {
    const u32x2 lo = *(const u32x2*)base, hi = *(const u32x2*)(base + 32);
    u32x4 r; r[0] = lo[0]; r[1] = lo[1]; r[2] = hi[0]; r[3] = hi[1];
    return __builtin_bit_cast(bf16x8, r);
}
#define MFMA16(a, b, c) __builtin_amdgcn_mfma_f32_16x16x32_bf16((a), (b), (c), 0, 0, 0)

#define SCAN_IMG 67584
__device__ __forceinline__ const unsigned char* dn_rec(const Params& p, int gc, int h, int dir) { return pws(p) + WS_DN + (size_t)((gc * 8 + h) * 2 + dir) * DN_REC; }
__device__ __forceinline__ void scan_item(const Params& p, int l, int sq, int h, int dir, unsigned char* lds) {
    const int tid = opaque_tid(), lane = tid & 63, wid = __builtin_amdgcn_readfirstlane(tid >> 6), c = lane & 15, q = lane >> 4;
    const bool ctx = sq < 16;
    const int nc = ctx ? 4 : 16, gc0 = ctx ? sq * 4 : 64 + (sq - 16) * 16;
#define SCAN_GC(s_) (gc0 + (dir ? nc - 1 - (s_) : (s_)))
    if (wid >= 4) {
        const int tl = tid - 256;
        u32x4 Ra[14], Rb[14];
#define SCAN_LOAD(R_, s_) do { const unsigned char* r_ = dn_rec(p, SCAN_GC((s_) < nc ? (s_) : nc - 1), h, dir); _Pragma("unroll") for (int k = 0; k < 14; ++k) R_[k] = *(const u32x4*)(r_ + (size_t)(tl + 256 * k) * 16); } while (0)
#define SCAN_WRITE(R_, buf_) do { unsigned char* b_ = lds + (buf_) * SCAN_IMG; _Pragma("unroll") for (int k = 0; k < 14; ++k) { const int ch = tl + 256 * k; unsigned char* dst; \
            if (k < 4) dst = b_ + (ch >> 4) * 288 + (ch & 15) * 16; \
            else if (k < 8) { const int x = ch - 1024; dst = b_ + 18432 + (x >> 4) * 288 + (x & 15) * 16; } \
            else if (k < 12) { const int x = ch - 2048; dst = b_ + 36864 + (x >> 3) * 160 + (x & 7) * 16; } \
            else { const int x = ch - 3072; dst = b_ + 57344 + (x >> 3) * 160 + (x & 7) * 16; } \
            *(u32x4*)dst = R_[k]; } } while (0)
        SCAN_LOAD(Ra, 0); SCAN_LOAD(Rb, 1);
        SCAN_WRITE(Ra, 0);
        __syncthreads();
        for (int s = 0; s < nc; s += 2) {
            SCAN_LOAD(Ra, s + 2);
            SCAN_WRITE(Rb, 1);
            __syncthreads();
            SCAN_LOAD(Rb, s + 3);
            SCAN_WRITE(Ra, 0);
            __syncthreads();
        }
#undef SCAN_LOAD
#undef SCAN_WRITE
    } else {
        const int dv0 = wid * 32;
        bf16_t* O = (bf16_t*)(pws(p) + WS_R1) + (size_t)dir * NTOK * 1024;
        f32x4 S[2][8];
#pragma unroll
        for (int t = 0; t < 2; ++t)
#pragma unroll
            for (int m = 0; m < 8; ++m) S[t][m] = (f32x4){0.f, 0.f, 0.f, 0.f};
        if (!ctx) { const float* sd = pin(p, 2) + ((size_t)(((sq - 16) * 2 + l) * 2 + dir) * 8 + h) * 16384;
#pragma unroll
            for (int t = 0; t < 2; ++t)
#pragma unroll
                for (int m = 0; m < 8; ++m)
#pragma unroll
                    for (int j = 0; j < 4; ++j) S[t][m][j] = sd[(16 * m + 4 * q + j) * 128 + dv0 + 16 * t + c]; }
        u32x2 utn[2][4]; float egl;
        { const unsigned char* rec0 = dn_rec(p, SCAN_GC(0), h, dir);
#pragma unroll
            for (int t = 0; t < 2; ++t)
#pragma unroll
                for (int m = 0; m < 4; ++m) utn[t][m] = *(const u32x2*)((const bf16_t*)(rec0 + DN_UT) + (dv0 + 16 * t + c) * 64 + 16 * m + 4 * q);
            egl = *(const float*)(rec0 + DN_EGL); }
        __syncthreads();
        for (int s = 0; s < nc; ++s) {
            const int gc = SCAN_GC(s);
            const unsigned char* recn = dn_rec(p, SCAN_GC(s + 1 < nc ? s + 1 : s), h, dir);
            const unsigned char* L_negw = lds + (s & 1) * SCAN_IMG;
            const unsigned char* L_qdec = L_negw + 18432;
            const unsigned char* L_kdt = L_negw + 36864;
            const unsigned char* L_qkm = L_negw + 57344;
            f32x4 vn[2][4];
#pragma unroll
            for (int t = 0; t < 2; ++t)
#pragma unroll
                for (int m = 0; m < 4; ++m) vn[t][m] = bf4_to_f32(utn[t][m]);
            bf16x8 Bs[2][4];
#pragma unroll
            for (int t = 0; t < 2; ++t)
#pragma unroll
                for (int kb = 0; kb < 4; ++kb) Bs[t][kb] = pack8(S[t][2 * kb], S[t][2 * kb + 1]);
            const unsigned char* aN = L_negw + c * 288 + 8 * q;
            const unsigned char* aQ = L_qdec + c * 288 + 8 * q;
            const unsigned char* aM = L_qkm + c * 160 + 8 * q;
            const unsigned char* aK = L_kdt + c * 160 + 8 * q;
#define SB_ __builtin_amdgcn_sched_barrier(0)
#define LD_N(F, m) do { _Pragma("unroll") for (int kb = 0; kb < 4; ++kb) F[kb] = lds_afrag(aN + (m) * 16 * 288 + 64 * kb); } while (0)
#define LD_Q(F, m) do { _Pragma("unroll") for (int kb = 0; kb < 4; ++kb) F[kb] = lds_afrag(aQ + (m) * 16 * 288 + 64 * kb); } while (0)
#define LD_M(F, m) do { _Pragma("unroll") for (int kb = 0; kb < 2; ++kb) F[kb] = lds_afrag(aM + (m) * 16 * 160 + 64 * kb); } while (0)
#define LD_K(F, m2) do { _Pragma("unroll") for (int mm = 0; mm < 2; ++mm) _Pragma("unroll") for (int kb = 0; kb < 2; ++kb) F[mm * 2 + kb] = lds_afrag(aK + (2 * (m2) + mm) * 16 * 160 + 64 * kb); } while (0)
#define MF_N(F, m) do { _Pragma("unroll") for (int kb = 0; kb < 4; ++kb) { vn[0][m] = MFMA16(F[kb], Bs[0][kb], vn[0][m]); vn[1][m] = MFMA16(F[kb], Bs[1][kb], vn[1][m]); } } while (0)
#define MF_Q(F, m) do { oa0 = (f32x4){0.f, 0.f, 0.f, 0.f}; oa1 = oa0; \
            _Pragma("unroll") for (int kb = 0; kb < 4; ++kb) { oa0 = MFMA16(F[kb], Bs[0][kb], oa0); oa1 = MFMA16(F[kb], Bs[1][kb], oa1); } } while (0)
#define MF_M(F, m) do { f32x4 a0 = oa0, a1 = oa1; \
            _Pragma("unroll") for (int kb = 0; kb < 2; ++kb) { a0 = MFMA16(F[kb], Bv[0][kb], a0); a1 = MFMA16(F[kb], Bv[1][kb], a1); } \
            _Pragma("unroll") for (int j = 0; j < 4; ++j) { const int i = 16 * (m) + 4 * q + j; const int tok = gc * 64 + (dir ? 63 - i : i); \
                bf16_t* op = O + (size_t)tok * 1024 + h * 128 + dv0 + c; op[0] = (bf16_t)f2bf(a0[j]); op[16] = (bf16_t)f2bf(a1[j]); } } while (0)
#define MF_K(F, m2) do { _Pragma("unroll") for (int mm = 0; mm < 2; ++mm) { f32x4 a0 = S[0][2 * (m2) + mm] * egl, a1 = S[1][2 * (m2) + mm] * egl; \
            _Pragma("unroll") for (int kb = 0; kb < 2; ++kb) { a0 = MFMA16(F[mm * 2 + kb], Bv[0][kb], a0); a1 = MFMA16(F[mm * 2 + kb], Bv[1][kb], a1); } \
            S[0][2 * (m2) + mm] = a0; S[1][2 * (m2) + mm] = a1; } } while (0)
            bf16x8 X[4], Y[4]; f32x4 oa0, oa1;
            LD_N(X, 0); SB_;
            LD_N(Y, 1); SB_; MF_N(X, 0); SB_;
            LD_N(X, 2); SB_; MF_N(Y, 1); SB_;
            LD_N(Y, 3); SB_; MF_N(X, 2); SB_;
            LD_Q(X, 0); SB_; MF_N(Y, 3); SB_;
            bf16x8 Bv[2][2];
#pragma unroll
            for (int t = 0; t < 2; ++t)
#pragma unroll
                for (int kb = 0; kb < 2; ++kb) Bv[t][kb] = pack8(vn[t][2 * kb], vn[t][2 * kb + 1]);
#pragma unroll
            for (int t = 0; t < 2; ++t)
#pragma unroll
                for (int m = 0; m < 4; ++m) utn[t][m] = *(const u32x2*)((const bf16_t*)(recn + DN_UT) + (dv0 + 16 * t + c) * 64 + 16 * m + 4 * q);
            SB_;
            LD_M(Y, 0); SB_; MF_Q(X, 0); SB_;
            LD_Q(X, 1); SB_; MF_M(Y, 0); SB_;
            LD_M(Y, 1); SB_; MF_Q(X, 1); SB_;
            LD_Q(X, 2); SB_; MF_M(Y, 1); SB_;
            LD_M(Y, 2); SB_; MF_Q(X, 2); SB_;
            LD_Q(X, 3); SB_; MF_M(Y, 2); SB_;
            LD_M(Y, 3); SB_; MF_Q(X, 3); SB_;
            LD_K(X, 0); SB_; MF_M(Y, 3); SB_;
            LD_K(Y, 1); SB_; MF_K(X, 0); SB_;
            LD_K(X, 2); SB_; MF_K(Y, 1); SB_;
            LD_K(Y, 3); SB_; MF_K(X, 2); SB_;
            MF_K(Y, 3);
#undef SB_
#undef LD_N
#undef LD_Q
#undef LD_M
#undef LD_K
#undef MF_N
#undef MF_Q
#undef MF_M
#undef MF_K
            egl = *(const float*)(recn + DN_EGL);
            __syncthreads();
        }
        if (ctx) { float* so = pout(p) + (size_t)NTOK * DM + ((size_t)((sq * 2 + l) * 2 + dir) * 8 + h) * 16384;
#pragma unroll
            for (int t = 0; t < 2; ++t)
#pragma unroll
                for (int m = 0; m < 8; ++m)
#pragma unroll
                    for (int j = 0; j < 4; ++j) so[(16 * m + 4 * q + j) * 128 + dv0 + 16 * t + c] = S[t][m][j]; }
    }
#undef SCAN_GC
}

__device__ __forceinline__ void lna_group(const Params& p, int l, int grp) {
    const int tid = opaque_tid(), lane = tid & 63, wid = tid >> 6;
    const int tok = grp * 8 + wid;
    const bf16_t* y = (const bf16_t*)(pws(p) + WS_Y) + (size_t)tok * 1024;
    const bf16_t* az = (const bf16_t*)(pws(p) + WS_P) + (size_t)tok * NP + C_AZ;
    bf16_t* U = (bf16_t*)(pws(p) + WS_U) + (size_t)tok * 2048;
    const float* lg = pin(p, 11) + l * 1024; const float* lb = pin(p, 12) + l * 1024;
    f32x4 v[4]; float s = 0.f;
#pragma unroll
    for (int i = 0; i < 4; ++i) { v[i] = bf4_to_f32(*(const u32x2*)(y + (lane + 64 * i) * 4)); s += v[i][0] + v[i][1] + v[i][2] + v[i][3]; }
    const float mu = wave_sum(s) * (1.0f / 1024.0f);
    float s2 = 0.f;
#pragma unroll
    for (int i = 0; i < 4; ++i) { v[i] -= mu; s2 += v[i][0] * v[i][0] + v[i][1] * v[i][1] + v[i][2] * v[i][2] + v[i][3] * v[i][3]; }
    const float rstd = rsqrtf(wave_sum(s2) * (1.0f / 1024.0f) + EPS);
#pragma unroll
    for (int i = 0; i < 4; ++i) { const int cc = (lane + 64 * i) * 4; const f32x4 g = *(const f32x4*)(lg + cc), bb = *(const f32x4*)(lb + cc);
        const u32x2 zz = *(const u32x2*)(az + cc);
        f32x4 o = v[i] * rstd * g + bb;
        const float z0 = __uint_as_float(zz[0] << 16), z1 = __uint_as_float(zz[0] & 0xffff0000u), z2 = __uint_as_float(zz[1] << 16), z3 = __uint_as_float(zz[1] & 0xffff0000u);
        u32x2 ov; ov[0] = pk2(siluf_(o[0]) * siluf_(z0), siluf_(o[1]) * siluf_(z1)); ov[1] = pk2(siluf_(o[2]) * siluf_(z2), siluf_(o[3]) * siluf_(z3));
        *(u32x2*)(U + cc) = ov; }
}

__device__ __forceinline__ void ps_phase(const Params& p, int l, unsigned char* lds) {
    const int b = blockIdx.x, G = gridDim.x;
    for (int r = 0;; ++r) { const int id = r * G + (r == 0 ? b : (b + 64 * G - 64) % G); if (id >= 320) break;
        const int sq = id < 64 ? 16 + (id >> 4) : ((id - 64) >> 4);
        for (int rsc = 0; rsc < REP_SCAN; ++rsc) scan_item(p, l, sq, (id >> 1) & 7, id & 1, lds); }
    const int gs = G == 256 ? (b >= 64 ? b - 64 : 1024) : b, gst = G == 256 ? 192 : G;
    for (int rl = 0; rl < REP_LNA; ++rl) for (int g = gs; g < 1024; g += gst) lna_group(p, l, g);
    if (l == 0) drain_tiles(p, 1 << 20, lds);
}

__device__ __forceinline__ void pnb_phase(const Params& p, int l) {
    const int tid = opaque_tid(), lane = tid & 63, wid = tid >> 6;
    const bf16_t* Of = (const bf16_t*)(pws(p) + WS_R1); const bf16_t* Ob = Of + (size_t)NTOK * 1024;
    const float* hg = pin(p, 17) + l * 128;
    for (int tok = blockIdx.x * 8 + wid; tok < NTOK; tok += gridDim.x * 8) {
        const int cb = lane * 16;
        f32x4 v[4]; float ss = 0.f;
#pragma unroll
        for (int i = 0; i < 4; ++i) { v[i] = bf4_to_f32(*(const u32x2*)(Of + (size_t)tok * 1024 + cb + 4 * i)) + bf4_to_f32(*(const u32x2*)(Ob + (size_t)tok * 1024 + cb + 4 * i));
            ss += v[i][0] * v[i][0] + v[i][1] * v[i][1] + v[i][2] * v[i][2] + v[i][3] * v[i][3]; }
        ss += __shfl_xor(ss, 1); ss += __shfl_xor(ss, 2); ss += __shfl_xor(ss, 4);
        const float rstd = rsqrtf(ss * (1.0f / 128.0f) + EPS);
        const bf16_t* zb = (const bf16_t*)(pws(p) + WS_P) + (size_t)tok * NP + C_ZB + cb;
        bf16_t* U = (bf16_t*)(pws(p) + WS_U) + (size_t)tok * 2048 + 1024 + cb;
        const u32x4 z0 = *(const u32x4*)zb, z1 = *(const u32x4*)(zb + 8);
        float o[16];
#pragma unroll
        for (int i = 0; i < 4; ++i) { const f32x4 g = *(const f32x4*)(hg + ((cb + 4 * i) & 127));
#pragma unroll
            for (int e = 0; e < 4; ++e) o[4 * i + e] = v[i][e] * rstd * g[e]; }
        u32x4 r0, r1;
#pragma unroll
        for (int w2 = 0; w2 < 4; ++w2) { const unsigned za = z0[w2], zc = z1[w2];
            r0[w2] = pk2(o[2 * w2] * siluf_(__uint_as_float(za << 16)), o[2 * w2 + 1] * siluf_(__uint_as_float(za & 0xffff0000u)));
            r1[w2] = pk2(o[8 + 2 * w2] * siluf_(__uint_as_float(zc << 16)), o[8 + 2 * w2 + 1] * siluf_(__uint_as_float(zc & 0xffff0000u))); }
        *(u32x4*)U = r0; *(u32x4*)(U + 8) = r1;
    }
}

#define XB_TMO      128
#define XB_XCNT(j)  (256  + 64 * (j))
#define XB_XSUB(j)  (1280 + 64 * (j))
#define XB_XGEN(j)  (2304 + 64 * (j))
#define XB_TOP      3328
#define XB_TOPGEN   3392
#define XCD_BAR_WORDS 3456
#define XB_SPIN_CAP (1u << 18)

__device__ __forceinline__ unsigned xb_ld(unsigned* p)              { return __hip_atomic_load(p, __ATOMIC_RELAXED, __HIP_MEMORY_SCOPE_AGENT); }
__device__ __forceinline__ unsigned xb_add(unsigned* p, unsigned v) { return __hip_atomic_fetch_add(p, v, __ATOMIC_RELAXED, __HIP_MEMORY_SCOPE_AGENT); }
__device__ __forceinline__ unsigned xb_xcc_id() { return (unsigned)__builtin_amdgcn_s_getreg((3 << 11) | 20) & 0xFu; }
#define XB_SPIN(cond, bar) do { unsigned _sp = 0; while (cond) { __builtin_amdgcn_s_sleep(1); \
    if ((++_sp & 255u) == 0u) { if (xb_ld(&(bar)[XB_TMO])) break; if (_sp > XB_SPIN_CAP) { atomicAdd(&(bar)[XB_TMO], 1u); break; } } } } while (0)

struct XcdBarrier {
    unsigned* bar; unsigned x;
    volatile LAS unsigned* st;
};

__device__ __forceinline__ XcdBarrier xcd_barrier_post(unsigned* bar, volatile LAS unsigned* st) {
    XcdBarrier b; b.bar = bar; b.x = xb_xcc_id(); b.st = st;
    if (threadIdx.x == 0) (void)xb_add(&bar[XB_XCNT(b.x)], 1u);
    return b;
}
__device__ __forceinline__ void xcd_barrier_complete(unsigned* bar, unsigned x, unsigned& nloc, unsigned& nx) {
    const unsigned G = gridDim.x * gridDim.y * gridDim.z;
    unsigned sum, cnt, mine, sp = 0u;
    for (;;) {
        sum = 0u; cnt = 0u; mine = 0u;
#pragma unroll
        for (unsigned j = 0; j < 16; ++j) { const unsigned c = xb_ld(&bar[XB_XCNT(j)]); sum += c; cnt += (c > 0u) ? 1u : 0u; mine = (j == x) ? c : mine; }
        if (sum == G) break;
        __builtin_amdgcn_s_sleep(1);
        if ((++sp & 255u) == 0u) { if (xb_ld(&bar[XB_TMO])) break; if (sp > XB_SPIN_CAP) { atomicAdd(&bar[XB_TMO], 1u); break; } }
    }
    nloc = mine > 0u ? mine : 1u; nx = cnt > 0u ? cnt : 1u;
}

__device__ __forceinline__ void xcd_barrier(const XcdBarrier& b) {
    asm volatile("s_waitcnt vmcnt(0)" ::: "memory");
    __syncthreads();
    if (threadIdx.x == 0) {
        unsigned* bar = b.bar;
        __builtin_amdgcn_s_waitcnt(0);
        unsigned nloc = b.st[0], nx = b.st[1];
        if (nloc == 0u) { xcd_barrier_complete(bar, b.x, nloc, nx); b.st[0] = nloc; b.st[1] = nx; }
        const unsigned old = xb_add(&bar[XB_XSUB(b.x)], 1u);
        const unsigned gen = old / nloc;
        if (old + 1u == (gen + 1u) * nloc) {
            __builtin_amdgcn_fence(__ATOMIC_RELEASE, "agent");
            asm volatile("s_waitcnt vmcnt(0)" ::: "memory");
            const unsigned og = xb_add(&bar[XB_TOP], 1u);
            const unsigned tg = og / nx;
            if (og + 1u == (tg + 1u) * nx) xb_add(&bar[XB_TOPGEN], 1u);
            else XB_SPIN(xb_ld(&bar[XB_TOPGEN]) == tg, bar);
            __builtin_amdgcn_fence(__ATOMIC_ACQUIRE, "agent");
            xb_add(&bar[XB_XGEN(b.x)], 1u);
            asm volatile("s_waitcnt vmcnt(0)" ::: "memory");
        } else {
            XB_SPIN(xb_ld(&bar[XB_XGEN(b.x)]) == gen, bar);
            __builtin_amdgcn_fence(__ATOMIC_ACQUIRE, "agent");
            asm volatile("s_waitcnt vmcnt(0)" ::: "memory");
        }
    }
    __syncthreads();
}

#ifndef REP0
#define REP0 1
#endif
#ifndef REP1
#define REP1 1
#endif
#ifndef REP2
#define REP2 1
#endif
#ifndef REP3
#define REP3 1
#endif
#ifndef REP4
#define REP4 1
#endif
#ifndef REP5
#define REP5 1
#endif
#ifndef REP6
#define REP6 1
#endif
#ifndef REP7
#define REP7 1
#endif
__global__ void __launch_bounds__(NTHR) fwd_megakernel(Params p) {
    extern __shared__ __attribute__((aligned(16))) unsigned char lds[];
    cg::grid_group grid = cg::this_grid();
    const int lo = p.ph_lo, hi = p.ph_hi;
    if (lo < 0) grid.sync();
    if (threadIdx.x < 2) ((volatile LAS unsigned*)((LAS unsigned char*)lds + LDS_BARST))[threadIdx.x] = 0u;
    __syncthreads();
    const XcdBarrier xbar = xcd_barrier_post((unsigned*)(pws(p) + WS_BARW), (volatile LAS unsigned*)((LAS unsigned char*)lds + LDS_BARST));
#define IN(k) (lo <= (k) && (k) < hi)
#ifndef SYNC_REP
#define SYNC_REP 1
#endif
#define SEAM(k) do { if (IN(k) && IN((k) + 1)) for (int sr = 0; sr < SYNC_REP; ++sr) { xcd_barrier(xbar); } } while (0)
#if (!defined(ONLY) || ONLY == 0) && !defined(SKIP0)
    if (IN(0)) for (int rp = 0; rp < REP0; ++rp) p0_prologue(p, (float*)lds);
#endif
    SEAM(0);
    for (int l = 0; l < 2; ++l) {
        const int pb = 1 + 7 * l;
        unsigned char* ws = pws(p);
#if (!defined(ONLY) || ONLY == 1) && !defined(SKIP1)
        if (IN(pb)) for (int rp = 0; rp < REP1; ++rp) pn_norm(p, l);
#endif
        SEAM(pb);
#if (!defined(ONLY) || ONLY == 2) && !defined(SKIP2)
        if (IN(pb + 1)) for (int rp = 0; rp < REP2; ++rp) {
            pg8::Gemm g{(const bf16_t*)(ws + WS_R1), (const bf16_t*)(ws + WS_WIN + l * SZ_WIN1), NTOK, NP, DM, DM};
            pg8::StaticOrder S; S.init(NTOK, NP, (int)gridDim.x, (int)blockIdx.x);
            EpiP E{(bf16_t*)(ws + WS_P), (float*)(ws + WS_BA)};
            pg8::gemm_phase<EpiP, pg8::StaticOrder, false, GEMM_ALIGN, GEMM_SP2>((LAS unsigned char*)lds, g, S, E, nullptr);
            if (l == 0 && (int)gridDim.x == 256 && (int)blockIdx.x >= 160) drain_tiles(p, PG1_TILES, lds);
        }
#endif
        SEAM(pb + 1);
#if (!defined(ONLY) || ONLY == 3) && !defined(SKIP3)
        if (IN(pb + 2)) for (int rp = 0; rp < REP3; ++rp) pc_phase(p, l, (float*)lds);
#endif
        SEAM(pb + 2);
#if (!defined(ONLY) || ONLY == 4) && !defined(SKIP4)
        if (IN(pb + 3)) for (int rp = 0; rp < REP4; ++rp) ps_phase(p, l, lds);
#endif
        SEAM(pb + 3);
#if (!defined(ONLY) || ONLY == 5) && !defined(SKIP5)
        if (IN(pb + 4)) for (int rp = 0; rp < REP5; ++rp) pnb_phase(p, l);
#endif
        SEAM(pb + 4);
#if (!defined(ONLY) || ONLY == 6) && !defined(SKIP6)
        if (IN(pb + 5)) for (int rp = 0; rp < REP6; ++rp) {
            pg8::Gemm g{(const bf16_t*)(ws + WS_U), (const bf16_t*)(ws + WS_WP2 + l * SZ_SQ), NTOK, DM, 1024, DM};
            ChainOrder S; S.init(NTOK, DM, (int)gridDim.x, (int)blockIdx.x);
            EpiMG E{(const bf16_t*)(ws + WS_P), (bf16_t*)(ws + WS_R1)};
            pg8::gemm_phase<EpiMG, ChainOrder, false, GEMM_ALIGN, GEMM_SP2>((LAS unsigned char*)lds, g, S, E, nullptr);
        }
#endif
        SEAM(pb + 5);
#if (!defined(ONLY) || ONLY == 7) && !defined(SKIP7)
        if (IN(pb + 6)) for (int rp = 0; rp < REP7; ++rp) {
            pg8::Gemm g{(const bf16_t*)(ws + WS_R1), (const bf16_t*)(ws + WS_WO + l * SZ_SQ), NTOK, DM, DM, DM};
            pg8::StaticOrder S; S.init(NTOK, DM, (int)gridDim.x, (int)blockIdx.x);
            EpiX E{pin(p, 0), pin(p, 1), l == 0 ? nullptr : (const bf16_t*)(ws + WS_X1), (const float*)(ws + WS_MOD) + (size_t)l * 5 * 6144 + 4096, l == 0 ? (bf16_t*)(ws + WS_X1) : (bf16_t*)(ws + WS_P)};
            pg8::gemm_phase<EpiX, pg8::StaticOrder, false, GEMM_ALIGN, GEMM_SP2>((LAS unsigned char*)lds, g, S, E, nullptr);
        }
#endif
        SEAM(pb + 6);
    }
#if (!defined(ONLY) || ONLY == 8) && !defined(SKIP8)
    if (IN(15)) pf_final(p);
#endif
}

#ifndef MK_N_LAUNCHES
#define MK_N_LAUNCHES 1
#endif
extern "C" void kernel_launch(void* const* d_in, const int* in_sizes, int n_in, void* d_out, int out_size, void* d_ws, size_t ws_size, hipStream_t stream) {
    static int grid = 0;
    if (grid == 0) {
        int dev = 0, cus = 0, per_cu = 0;
        hipGetDevice(&dev);
        hipDeviceGetAttribute(&cus, hipDeviceAttributeMultiprocessorCount, dev);
        if (hipFuncSetAttribute((const void*)fwd_megakernel, hipFuncAttributeMaxDynamicSharedMemorySize, LDS_BYTES) != hipSuccess) { fprintf(stderr, "kernel_launch: hipFuncSetAttribute failed\n"); grid = -1; return; }
        if (hipOccupancyMaxActiveBlocksPerMultiprocessor(&per_cu, (const void*)fwd_megakernel, NTHR, LDS_BYTES) != hipSuccess || per_cu < 1) { fprintf(stderr, "kernel_launch: occupancy query says %d blocks per CU\n", per_cu); grid = -1; return; }
        grid = cus * 1;
        if (n_in != 21 || ws_size < WS_END2) { fprintf(stderr, "kernel_launch: unexpected n_in %d / ws %zu\n", n_in, ws_size); grid = -1; return; }
    }
    if (grid < 0) return;
    if (hipMemsetAsync((char*)d_ws + WS_BARW, 0, 16384, stream) != hipSuccess) { fprintf(stderr, "kernel_launch: memset failed\n"); return; }
    Params p{};
    for (int i = 0; i < 21; ++i) p.in[i] = (const float*)d_in[i];
    p.out = (float*)d_out; p.ws = (unsigned char*)d_ws;
#if MK_N_LAUNCHES == 1
    p.ph_lo = 0; p.ph_hi = 16;
    void* args[] = {&p};
    hipError_t e = hipLaunchCooperativeKernel((const void*)fwd_megakernel, dim3(grid), dim3(NTHR), args, LDS_BYTES, stream);
    if (e != hipSuccess) fprintf(stderr, "cooperative launch failed: %s (grid %d)\n", hipGetErrorString(e), grid);
#else
    for (int ph = 0; ph < 16; ++ph) { p.ph_lo = ph; p.ph_hi = ph + 1;
        hipLaunchKernelGGL(fwd_megakernel, dim3(grid), dim3(NTHR), LDS_BYTES, stream, p); }
#endif
}
```
